# Optimizing an MI355X kernel written in HIP

```python
import math
import jax, jax.numpy as jnp
from jax import lax
import numpy as np

D_MODEL = 1024
BATCH = 4
SEQ = 4096
DEPTH = 4

GRID_W = 64
CTX_LEN = 256
HEAD_DIM = 64
A_HEADS = 4
A_KV_HEADS = 2
B_HEADS = 4
B_QK_DIM = HEAD_DIM // 2
C_HEADS = 4
NA_KH = 8
NA_KW = 16
S5_GROUPS = 16
S5_GROUP_CH = 16
S5_STATE = 64
S5_DT_MIN = 1e-3
S5_DT_MAX = 1e-1

A_WIDTH = A_HEADS * HEAD_DIM
A_KV_WIDTH = A_KV_HEADS * HEAD_DIM
B_WIDTH = B_HEADS * HEAD_DIM
C_WIDTH = C_HEADS * HEAD_DIM
S5_WIDTH = S5_GROUPS * S5_GROUP_CH
MIX_WIDTH = A_WIDTH + B_WIDTH + C_WIDTH + S5_WIDTH
IN_SIZES = (A_WIDTH, A_KV_WIDTH, A_KV_WIDTH, A_WIDTH,
            B_WIDTH, B_WIDTH, B_WIDTH, B_WIDTH,
            C_WIDTH, C_WIDTH, C_WIDTH, C_WIDTH,
            S5_WIDTH, S5_WIDTH)
IN_WIDTH = sum(IN_SIZES)
IN_SPLITS = tuple(int(s) for s in np.cumsum(IN_SIZES)[:-1])

Q_BLOCK = 128
ROPE_BASE = 10000.0
RMS_EPS = 1e-6
LN_EPS = 1e-5
DEEPNORM_ALPHA = (2 * DEPTH) ** 0.25
DEEPNORM_BETA = (8 * DEPTH) ** -0.25

kernel_name = "hybrid_parallel_heads_dit_block"


def rms_norm(x, g):
    xf = x.astype(jnp.float32)
    y = xf * lax.rsqrt(jnp.mean(xf * xf, axis=-1, keepdims=True) + RMS_EPS)
    return (y * g).astype(x.dtype)


def layer_norm(x, g, b):
    xf = x.astype(jnp.float32)
    mu = jnp.mean(xf, axis=-1, keepdims=True)
    var = jnp.mean(jnp.square(xf - mu), axis=-1, keepdims=True)
    return ((xf - mu) * lax.rsqrt(var + LN_EPS) * g + b).astype(x.dtype)


def softmax32(s):
    return jax.nn.softmax(s.astype(jnp.float32), axis=-1)


def rope_1d(x, pos):
    half = x.shape[-1] // 2
    inv = ROPE_BASE ** (-jnp.arange(half, dtype=jnp.float32) / half)
    ang = pos.astype(jnp.float32)[:, None] * inv
    cos, sin = jnp.cos(ang).astype(x.dtype), jnp.sin(ang).astype(x.dtype)
    x1, x2 = x[..., :half], x[..., half:]
    return jnp.concatenate([x1 * cos - x2 * sin, x1 * sin + x2 * cos], axis=-1)


def rope_2d(x, row, col):
    h = x.shape[-1] // 2
    return jnp.concatenate([rope_1d(x[..., :h], row), rope_1d(x[..., h:], col)], axis=-1)


def split_heads(t, n):
    b, s, _ = t.shape
    return t.reshape(b, s, n, -1).transpose(0, 2, 1, 3)


def merge_heads(t):
    b, n, s, d = t.shape
    return t.transpose(0, 2, 1, 3).reshape(b, s, n * d)


def sweep_query_blocks(fn, qs):
    def to_blocks(q):
        qb = q.reshape(q.shape[:-2] + (q.shape[-2] // Q_BLOCK, Q_BLOCK, q.shape[-1]))
        return jnp.moveaxis(qb, -3, 0)
    out = lax.map(fn, tuple(to_blocks(q) for q in qs))
    out = jnp.moveaxis(out, 0, -3)
    return out.reshape(out.shape[:-3] + (-1, out.shape[-1]))


def attend(q, k, v, scale):
    p = softmax32(jnp.einsum('bkrqd,bktd->bkrqt', q, k) * scale).astype(v.dtype)
    return jnp.einsum('bkrqt,bktd->bkrqd', p, v)


def gqa_mixer(q_l, k_l, v_l, q_c, k_c, v_c, qn_g, kn_g, row, col, need_ctx):
    rep = A_HEADS // A_KV_HEADS
    scale = HEAD_DIM ** -0.5
    q = rope_2d(rms_norm(split_heads(q_l, A_HEADS), qn_g), row, col)
    k = rope_2d(rms_norm(split_heads(k_l, A_KV_HEADS), kn_g), row, col)
    v = split_heads(v_l, A_KV_HEADS)
    kc = rms_norm(split_heads(k_c, A_KV_HEADS), kn_g)
    vc = split_heads(v_c, A_KV_HEADS)
    k_all = jnp.concatenate([k, kc], axis=2)
    v_all = jnp.concatenate([v, vc], axis=2)

    def group(t):
        b, _, s, d = t.shape
        return t.reshape(b, A_KV_HEADS, rep, s, d)

    def ungroup(o):
        return o.reshape(o.shape[0], A_HEADS, o.shape[3], o.shape[4])

    o = sweep_query_blocks(lambda qs: attend(qs[0], k_all, v_all, scale), (group(q),))
    y_lat = merge_heads(ungroup(o))
    y_ctx = None
    if need_ctx:
        qc = group(rms_norm(split_heads(q_c, A_HEADS), qn_g))
        y_ctx = merge_heads(ungroup(attend(qc, kc, vc, scale)))
    return y_lat, y_ctx


def diff_attend(q1, q2, k1, k2, v, lam, scale):
    p1 = softmax32(jnp.einsum('bhqd,bhtd->bhqt', q1, k1) * scale)
    p2 = softmax32(jnp.einsum('bhqd,bhtd->bhqt', q2, k2) * scale)
    return jnp.einsum('bhqt,bhtd->bhqd', (p1 - lam * p2).astype(v.dtype), v)


def diff_mixer(q_l, k_l, v_l, q_c, k_c, v_c, lq1, lk1, lq2, lk2, subln_g, lam_init, row, col, need_ctx):
    scale = B_QK_DIM ** -0.5
    f32 = jnp.float32
    q = split_heads(q_l, B_HEADS)
    k = split_heads(k_l, B_HEADS)
    v = split_heads(v_l, B_HEADS)
    q1, q2 = rope_2d(q[..., :B_QK_DIM], row, col), rope_2d(q[..., B_QK_DIM:], row, col)
    k1, k2 = rope_2d(k[..., :B_QK_DIM], row, col), rope_2d(k[..., B_QK_DIM:], row, col)
    qc = split_heads(q_c, B_HEADS)
    kc = split_heads(k_c, B_HEADS)
    vc = split_heads(v_c, B_HEADS)
    kc1, kc2 = kc[..., :B_QK_DIM], kc[..., B_QK_DIM:]
    k1_all = jnp.concatenate([k1, kc1], axis=2)
    k2_all = jnp.concatenate([k2, kc2], axis=2)
    v_all = jnp.concatenate([v, vc], axis=2)
    lam = (jnp.exp(jnp.sum(lq1.astype(f32) * lk1.astype(f32)))
           - jnp.exp(jnp.sum(lq2.astype(f32) * lk2.astype(f32))) + lam_init)

    def post(o):
        return merge_heads(rms_norm(o, subln_g) * (1.0 - lam_init))

    o = sweep_query_blocks(
        lambda qs: diff_attend(qs[0], qs[1], k1_all, k2_all, v_all, lam, scale), (q1, q2))
    y_lat = post(o)
    y_ctx = None
    if need_ctx:
        y_ctx = post(diff_attend(qc[..., :B_QK_DIM], qc[..., B_QK_DIM:], kc1, kc2, vc, lam, scale))
    return y_lat, y_ctx


def na_mixer(q_l, k_l, v_l, q_c, k_c, v_c, rpb, need_ctx):
    bsz, seq, _ = q_l.shape
    rows = seq // GRID_W
    kh = min(NA_KH, rows)
    scale = HEAD_DIM ** -0.5
    q = split_heads(q_l, C_HEADS)
    k = split_heads(k_l, C_HEADS)
    v = split_heads(v_l, C_HEADS)
    kc = split_heads(k_c, C_HEADS)
    vc = split_heads(v_c, C_HEADS)

    def grid(t):
        return t.reshape(t.shape[0], t.shape[1], rows, GRID_W, t.shape[-1])

    qg, kg, vg = grid(q), grid(k), grid(v)
    wcol = jnp.arange(GRID_W)
    col_start = jnp.clip(wcol - NA_KW // 2, 0, GRID_W - NA_KW)
    col_idx = col_start[:, None] + jnp.arange(NA_KW)[None, :]
    dc_idx = col_idx - wcol[:, None] + (NA_KW - 1)

    def row_fn(args):
        r, q_row = args
        rs = jnp.clip(r - kh // 2, 0, rows - kh)
        k_win = lax.dynamic_slice_in_dim(kg, rs, kh, axis=2)[:, :, :, col_idx]
        v_win = lax.dynamic_slice_in_dim(vg, rs, kh, axis=2)[:, :, :, col_idx]
        dr_idx = rs + jnp.arange(kh) - r + (NA_KH - 1)
        bias = rpb[:, dr_idx[None, :, None], dc_idx[:, None, :]]
        s_win = jnp.einsum('bhwd,bhiwjd->bhwij', q_row, k_win) * scale + bias
        s_ctx = jnp.einsum('bhwd,bhtd->bhwt', q_row, kc) * scale
        b_, h_, w_ = s_win.shape[:3]
        p = softmax32(jnp.concatenate([s_win.reshape(b_, h_, w_, kh * NA_KW), s_ctx], axis=-1)).astype(v.dtype)
        p_win = p[..., :kh * NA_KW].reshape(b_, h_, w_, kh, NA_KW)
        p_ctx = p[..., kh * NA_KW:]
        return (jnp.einsum('bhwij,bhiwjd->bhwd', p_win, v_win)
                + jnp.einsum('bhwt,bhtd->bhwd', p_ctx, vc))

    out = lax.map(row_fn, (jnp.arange(rows), jnp.moveaxis(qg, 2, 0)))
    out = jnp.moveaxis(out, 0, 2).reshape(q.shape)
    y_lat = merge_heads(out)
    y_ctx = None
    if need_ctx:
        y_ctx = merge_heads(attend(split_heads(q_c, C_HEADS)[:, :, None], kc, vc, scale)[:, :, 0])
    return y_lat, y_ctx


def s5_discretise(a_re, a_im, log_dt, b_re, b_im):
    f32 = jnp.float32
    lam = lax.complex(a_re.astype(f32), a_im.astype(f32))
    dt = jnp.exp(log_dt.astype(f32))[:, None]
    lam_bar = jnp.exp(lam * dt)
    b = lax.complex(b_re.astype(f32), b_im.astype(f32))
    b_bar = ((lam_bar - 1.0) / lam)[..., None] * b
    return lam_bar, b_bar


def _ssm_combine(e1, e2):
    a1, b1 = e1
    a2, b2 = e2
    return a1 * a2, a2 * b1 + b2


def s5_scan(u, lam_bar, b_bar, h0, reverse):
    bu = jnp.einsum('gpc,blgc->blgp', b_bar, u.astype(jnp.complex64))
    if reverse:
        bu = jnp.flip(bu, axis=1)
    if h0 is not None:
        bu = bu.at[:, 0].add(lam_bar * h0)
    a = jnp.broadcast_to(lam_bar, bu.shape)
    _, h = lax.associative_scan(_ssm_combine, (a, bu), axis=1)
    h_last = h[:, -1]
    if reverse:
        h = jnp.flip(h, axis=1)
    return h, h_last


def s5_mixer(u_l, u_c, a_re, a_im, log_dt, b_re, b_im, c_re, c_im, d_skip, w_glu, need_ctx):
    f32 = jnp.float32

    def to_groups(u):
        return u.reshape(u.shape[0], u.shape[1], S5_GROUPS, S5_GROUP_CH)

    ug, ucg = to_groups(u_l), to_groups(u_c)
    disc_f = s5_discretise(a_re[0], a_im[0], log_dt[0], b_re[0], b_im[0])
    disc_b = s5_discretise(a_re[1], a_im[1], log_dt[1], b_re[1], b_im[1])
    c_f = lax.complex(c_re[0].astype(f32), c_im[0].astype(f32))
    c_b = lax.complex(c_re[1].astype(f32), c_im[1].astype(f32))

    def readout(h_f, h_b, u):
        y = (jnp.einsum('gcp,blgp->blgc', c_f, h_f).real
             + jnp.einsum('gcp,blgp->blgc', c_b, h_b).real)
        y = y.reshape(u.shape).astype(u.dtype) + d_skip * u
        z = jax.nn.gelu(y) @ w_glu
        z_val, z_gate = jnp.split(z, 2, axis=-1)
        return z_val * jax.nn.sigmoid(z_gate)

    hc_f, hf_last = s5_scan(ucg, disc_f[0], disc_f[1], None, False)
    hc_b, hb_last = s5_scan(ucg, disc_b[0], disc_b[1], None, True)
    hl_f, _ = s5_scan(ug, disc_f[0], disc_f[1], hf_last, False)
    hl_b, _ = s5_scan(ug, disc_b[0], disc_b[1], hb_last, True)
    y_lat = readout(hl_f, hl_b, u_l)
    y_ctx = readout(hc_f, hc_b, u_c) if need_ctx else None
    return y_lat, y_ctx


def hybrid_layer(x, ctx, c, c_ctx, row, col, layer_idx, need_ctx,
                 w_ada, b_ada, w_in, w_out, ln_g, ln_b, qn_g, kn_g,
                 lq1, lk1, lq2, lk2, subln_g, rpb,
                 a_re, a_im, log_dt, b_re, b_im, c_re, c_im, d_skip, w_glu):
    silu = jax.nn.silu
    shift, scale, gate = jnp.split(silu(c) @ w_ada + b_ada, 3, axis=-1)
    shift_c, scale_c, gate_c = jnp.split(silu(c_ctx) @ w_ada + b_ada, 3, axis=-1)
    h = x * (1.0 + scale[:, None]) + shift[:, None]
    hc = ctx * (1.0 + scale_c) + shift_c
    (aq, ak, av, ag, bq, bk, bv, bg, cq, ck, cv, cg, du, dg) = jnp.split(h @ w_in, IN_SPLITS, axis=-1)
    (aqc, akc, avc, agc, bqc, bkc, bvc, bgc, cqc, ckc, cvc, cgc, duc, dgc) = jnp.split(
        hc @ w_in, IN_SPLITS, axis=-1)
    lam_init = 0.8 - 0.6 * math.exp(-0.3 * layer_idx)

    ya, ya_c = gqa_mixer(aq, ak, av, aqc, akc, avc, qn_g, kn_g, row, col, need_ctx)
    yb, yb_c = diff_mixer(bq, bk, bv, bqc, bkc, bvc, lq1, lk1, lq2, lk2, subln_g, lam_init, row, col, need_ctx)
    yc, yc_c = na_mixer(cq, ck, cv, cqc, ckc, cvc, rpb, need_ctx)
    yd, yd_c = s5_mixer(du, duc, a_re, a_im, log_dt, b_re, b_im, c_re, c_im, d_skip, w_glu, need_ctx)

    y = jnp.concatenate([ya * silu(ag), yb * silu(bg), yc * silu(cg), yd * silu(dg)], axis=-1) @ w_out
    x_new = layer_norm(DEEPNORM_ALPHA * x + gate[:, None] * y, ln_g, ln_b)
    ctx_new = None
    if need_ctx:
        y_c = jnp.concatenate([ya_c * silu(agc), yb_c * silu(bgc), yc_c * silu(cgc), yd_c * silu(dgc)],
                              axis=-1) @ w_out
        ctx_new = layer_norm(DEEPNORM_ALPHA * ctx + gate_c * y_c, ln_g, ln_b)
    return x_new, ctx_new


def setup_inputs(seed: int = 0) -> dict:
    key = jax.random.key(seed)
    ks = jax.random.split(key, 27)
    f32 = jnp.float32

    def nrm(k, shape, s):
        return s * jax.random.normal(k, shape, f32)

    G, P, CH = S5_GROUPS, S5_STATE, S5_GROUP_CH
    return {
        "x": nrm(ks[0], (BATCH, SEQ, D_MODEL), 1.0),
        "c": nrm(ks[1], (BATCH, D_MODEL), 1.0),
        "ctx": nrm(ks[2], (BATCH, CTX_LEN, D_MODEL), 1.0),
        "c_ctx": nrm(ks[3], (D_MODEL,), 1.0),
        "w_ada": nrm(ks[4], (DEPTH, D_MODEL, 3 * D_MODEL), 0.5 * D_MODEL ** -0.5),
        "b_ada": nrm(ks[5], (DEPTH, 3 * D_MODEL), 0.01),
        "w_in": nrm(ks[6], (DEPTH, D_MODEL, IN_WIDTH), D_MODEL ** -0.5),
        "w_out": nrm(ks[7], (DEPTH, MIX_WIDTH, D_MODEL), DEEPNORM_BETA * MIX_WIDTH ** -0.5),
        "ln_g": 1.0 + nrm(ks[8], (DEPTH, D_MODEL), 0.01),
        "ln_b": nrm(ks[9], (DEPTH, D_MODEL), 0.01),
        "qn_g": 1.0 + nrm(ks[10], (DEPTH, HEAD_DIM), 0.01),
        "kn_g": 1.0 + nrm(ks[11], (DEPTH, HEAD_DIM), 0.01),
        "lam_q1": nrm(ks[12], (DEPTH, B_QK_DIM), 0.1),
        "lam_k1": nrm(ks[13], (DEPTH, B_QK_DIM), 0.1),
        "lam_q2": nrm(ks[14], (DEPTH, B_QK_DIM), 0.1),
        "lam_k2": nrm(ks[15], (DEPTH, B_QK_DIM), 0.1),
        "subln_g": 1.0 + nrm(ks[16], (DEPTH, HEAD_DIM), 0.01),
        "na_rpb": nrm(ks[17], (DEPTH, C_HEADS, 2 * NA_KH - 1, 2 * NA_KW - 1), 0.02),
        "s5_a_re": -0.5 + nrm(ks[18], (DEPTH, 2, G, P), 0.01),
        "s5_a_im": math.pi * jnp.arange(P, dtype=f32) + nrm(ks[19], (DEPTH, 2, G, P), 0.01),
        "s5_log_dt": jax.random.uniform(ks[20], (DEPTH, 2, G), f32,
                                        math.log(S5_DT_MIN), math.log(S5_DT_MAX)),
        "s5_b_re": nrm(ks[21], (DEPTH, 2, G, P, CH), (2 * CH) ** -0.5),
        "s5_b_im": nrm(ks[22], (DEPTH, 2, G, P, CH), (2 * CH) ** -0.5),
        "s5_c_re": nrm(ks[23], (DEPTH, 2, G, CH, P), (2 * P) ** -0.5),
        "s5_c_im": nrm(ks[24], (DEPTH, 2, G, CH, P), (2 * P) ** -0.5),
        "s5_d": nrm(ks[25], (DEPTH, S5_WIDTH), 0.5),
        "w_glu": nrm(ks[26], (DEPTH, S5_WIDTH, 2 * S5_WIDTH), S5_WIDTH ** -0.5),
    }


def reference(x, c, ctx, c_ctx, w_ada, b_ada, w_in, w_out, ln_g, ln_b, qn_g, kn_g,
              lam_q1, lam_k1, lam_q2, lam_k2, subln_g, na_rpb,
              s5_a_re, s5_a_im, s5_log_dt, s5_b_re, s5_b_im, s5_c_re, s5_c_im, s5_d, w_glu):
    seq = x.shape[1]
    t = jnp.arange(seq, dtype=jnp.int32)
    row, col = t // GRID_W, t % GRID_W
    for l in range(DEPTH):
        x, ctx = hybrid_layer(
            x, ctx, c, c_ctx, row, col, l, l < DEPTH - 1,
            w_ada[l], b_ada[l], w_in[l], w_out[l], ln_g[l], ln_b[l], qn_g[l], kn_g[l],
            lam_q1[l], lam_k1[l], lam_q2[l], lam_k2[l], subln_g[l], na_rpb[l],
            s5_a_re[l], s5_a_im[l], s5_log_dt[l], s5_b_re[l], s5_b_im[l], s5_c_re[l], s5_c_im[l],
            s5_d[l], w_glu[l])
    return x
```

```cpp
#include <hip/hip_runtime.h>
#include <hip/hip_cooperative_groups.h>
#include <cstdint>
#include <cstdio>
#include <math.h>
namespace cg = cooperative_groups;

constexpr int D = 1024, NB = 4, S = 4096, NL = 4, GW = 64, CT = 256;
constexpr int T = S + CT;
constexpr int MT = NB * T;
constexpr int NP = 3328;
constexpr int AQ = 0, AK = 256, AV = 384, AG = 512, BQ = 768, BK = 1024, BV = 1280, BG = 1536, CQ = 1792, CK = 2048, CV = 2304, CG = 2560, DU = 2816, DG = 3072;
constexpr float RMS_EPS = 1e-6f, LN_EPS = 1e-5f;
constexpr float ALPHA = 1.681792830507429f;
constexpr float LOG2E = 1.4426950408889634f;
constexpr float C2A = 0.125f * LOG2E;
constexpr float C2B = 0.17677669529663687f * LOG2E;
constexpr int NCH = T / 64;
constexpr int NWAVES = 8, NTHR = 512;

typedef unsigned short bf16_t;
typedef float f32x4 __attribute__((ext_vector_type(4)));
typedef unsigned u32x4 __attribute__((ext_vector_type(4)));
typedef unsigned u32x2 __attribute__((ext_vector_type(2)));
#define LAS __attribute__((address_space(3)))
__device__ __forceinline__ float bf2f(bf16_t v) { return __uint_as_float(((unsigned)v) << 16); }
__device__ __forceinline__ unsigned f2bf_u(float f) { unsigned u = __float_as_uint(f); return (u + 0x7fffu + ((u >> 16) & 1u)) >> 16; }
__device__ __forceinline__ bf16_t f2bf(float f) { return (bf16_t)f2bf_u(f); }
__device__ __forceinline__ unsigned pk2(float lo, float hi) { return f2bf_u(lo) | (f2bf_u(hi) << 16); }
__device__ __forceinline__ float silu_f(float v) { return v / (1.f + __expf(-v)); }
__device__ __forceinline__ float sigm_f(float v) { return 1.f / (1.f + __expf(-v)); }
__device__ __forceinline__ float gelu_tanh(float v) { return 0.5f * v * (1.f + tanhf(0.7978845608028654f * (v + 0.044715f * v * v * v))); }

__device__ __forceinline__ int opaque_v(int x) { asm volatile("" : "+v"(x)); return x; }
__device__ __forceinline__ int opaque_s(int x) { asm volatile("" : "+s"(x)); return x; }
struct Params {
    const float *x, *c, *ctx, *c_ctx, *w_ada, *b_ada, *w_in, *w_out, *ln_g, *ln_b, *qn_g, *kn_g, *lq1, *lk1, *lq2, *lk2, *subln_g, *rpb;
    const float *a_re, *a_im, *log_dt, *b_re, *b_im, *c_re, *c_im, *s5_d, *w_glu;
    float* xl;
    float* xc;
    float* mod;
    float* tabA;
    float* tabB;
    bf16_t* Win_t;
    bf16_t* Wout_t;
    bf16_t* Wglu_t;
    bf16_t* A;
    bf16_t* P;
    bf16_t* ys5;
    float* Sst;
    float* Hin;
    unsigned* ctl;
    float* disc;
};
struct KArgs { const float* in[27]; float* out; unsigned char* ws; };
constexpr size_t al256(size_t x) { return (x + 255) & ~(size_t)255; }
constexpr size_t O_CTL = 0, O_XC = O_CTL + (1 << 20), O_MOD = O_XC + al256((size_t)NB * CT * D * 4), O_TABA = O_MOD + al256((size_t)NL * 5 * 3 * D * 4), O_TABB = O_TABA + 8192,
    O_WIN = O_TABB + 4096, O_WOUT = O_WIN + al256((size_t)NL * NP * D * 2), O_WGLU = O_WOUT + al256((size_t)NL * D * D * 2), O_A = O_WGLU + al256((size_t)NL * 512 * 256 * 2),
    O_P = O_A + al256((size_t)MT * D * 2), O_YS5 = O_P + al256((size_t)MT * NP * 2), O_SST = O_YS5 + al256((size_t)MT * 256 * 2), O_HIN = O_SST + al256((size_t)NB * 2 * 16 * NCH * 64 * 2 * 4),
    O_SMALL = O_HIN + al256((size_t)NB * 2 * 16 * NCH * 64 * 2 * 4);
constexpr int SM_N[18] = {NL * D, NL * D, NL * 64, NL * 64, NL * 32, NL * 32, NL * 32, NL * 32, NL * 64, NL * 4 * 15 * 31, NL * 2 * 16 * 64, NL * 2 * 16 * 64, NL * 2 * 16, NL * 2 * 16 * 64 * 16, NL * 2 * 16 * 64 * 16, NL * 2 * 16 * 16 * 64, NL * 2 * 16 * 16 * 64, NL * 256};
constexpr int sm_off(int i) { int o = 0; for (int k = 0; k < i; ++k) o += (SM_N[k] + 63) & ~63; return o; }
constexpr size_t O_DISC = O_SMALL + al256((size_t)sm_off(18) * 4);
constexpr size_t O_END = O_DISC + al256((size_t)NL * 2 * 16 * 64 * 34 * 4);
template <class Tp> __device__ __forceinline__ Tp* opaque_p(Tp* x) { asm volatile("" : "+s"(x)); return x; }
__device__ __forceinline__ Params make_params(const KArgs& ka, bool prologue) {
    Params p;
    const float** f = (const float**)&p;
    if (prologue) { for (int i = 0; i < 27; ++i) f[i] = ka.in[i]; }
    else {
        for (int i = 0; i < 27; ++i) f[i] = nullptr;
        const float* sm = (const float*)(opaque_p(ka.ws) + O_SMALL);
        p.ln_g = sm + sm_off(0); p.ln_b = sm + sm_off(1); p.qn_g = sm + sm_off(2); p.kn_g = sm + sm_off(3); p.lq1 = sm + sm_off(4); p.lk1 = sm + sm_off(5); p.lq2 = sm + sm_off(6); p.lk2 = sm + sm_off(7);
        p.subln_g = sm + sm_off(8); p.rpb = sm + sm_off(9); p.a_re = sm + sm_off(10); p.a_im = sm + sm_off(11); p.log_dt = sm + sm_off(12); p.b_re = sm + sm_off(13); p.b_im = sm + sm_off(14);
        p.c_re = sm + sm_off(15); p.c_im = sm + sm_off(16); p.s5_d = sm + sm_off(17);
    }
    unsigned char* ws = opaque_p(ka.ws);
    p.xl = opaque_p(ka.out); p.xc = (float*)(ws + O_XC); p.mod = (float*)(ws + O_MOD); p.tabA = (float*)(ws + O_TABA); p.tabB = (float*)(ws + O_TABB);
    p.Win_t = (bf16_t*)(ws + O_WIN); p.Wout_t = (bf16_t*)(ws + O_WOUT); p.Wglu_t = (bf16_t*)(ws + O_WGLU); p.A = (bf16_t*)(ws + O_A); p.P = (bf16_t*)(ws + O_P);
    p.ys5 = (bf16_t*)(ws + O_YS5); p.Sst = (float*)(ws + O_SST); p.Hin = (float*)(ws + O_HIN); p.ctl = (unsigned*)(ws + O_CTL); p.disc = (float*)(ws + O_DISC);
    return p;
}
__device__ __forceinline__ float* xrow(const Params& p, int m) { const int b = m / T, t = m - b * T; return t < S ? p.xl + ((size_t)b * S + t) * D : p.xc + ((size_t)b * CT + (t - S)) * D; }
__device__ __forceinline__ int modrow(int m) { const int b = m / T, t = m - b * T; return t < S ? b : 4; }
namespace pg8 {
#define PG8_LAS __attribute__((address_space(3)))
typedef unsigned short bf16_t;
typedef short bf16x8 __attribute__((ext_vector_type(8)));
typedef float f32x4 __attribute__((ext_vector_type(4)));
typedef unsigned u32x4 __attribute__((ext_vector_type(4)));
constexpr int BM = 256, BK = 64, HALF = 128, HTB = HALF * BK * 2  , STAGE_BYTES = 8 * HTB, NXCD = 8, WGM = 8;

__host__ __device__ __forceinline__ int lds_byte(int r, int c) { const int st = (r >> 4) * 2 + (c >> 5), rr = r & 15, cc = c & 31, ob = rr * 64 + cc * 2; return st * 1024 + (ob ^ (((ob >> 9) & 1) << 5)); }
__host__ __device__ __forceinline__ void stage_rc(int b, int& R, int& C) { const int st = b / 1024, sb = b % 1024, swz = sb ^ (((sb >> 9) & 1) << 5); R = (st >> 1) * 16 + swz / 64; C = (st & 1) * 32 + (swz % 64) / 2; }
__host__ __device__ __forceinline__ int perm32(int rho) { const int n = rho >> 4, i = rho & 15; return 8 * (i >> 2) + 4 * n + (i & 3); }

struct Unit { int pm, pn; };
struct Gemm { const bf16_t* A; const bf16_t* Bt; int M, N, K; };

struct StaticOrder {
    int nM, nN, nwg, G, c;
    __host__ __device__ void init(int M, int N, int G_, int c_) { nM = M / BM; nN = N / BM; nwg = nM * nN; G = G_; c = c_; }
    __host__ __device__ bool next(int i, Unit& u) const {
        const long L = (long)i * G + c; if (L >= nwg) return false;
        int wgid = (int)L; { const int q = nwg / NXCD, r = nwg % NXCD, xcd = wgid % NXCD, off = wgid / NXCD; wgid = (xcd < r ? xcd * (q + 1) : r * (q + 1) + (xcd - r) * q) + off; }
        const int nig = WGM * nN, gid = wgid / nig, fm = gid * WGM, gsz = (nM - fm) < WGM ? (nM - fm) : WGM;
        u.pm = fm + ((wgid % nig) % gsz); u.pn = (wgid % nig) / gsz; return true;
    }
    __device__ __forceinline__ void a_ready(const Unit&) const {}
    __device__ __forceinline__ void done(const Unit&) const {}
};

__device__ __forceinline__ unsigned cvt_pk_bf16(float lo, float hi) { unsigned r; asm volatile("v_cvt_pk_bf16_f32 %0, %1, %2" : "=v"(r) : "v"(lo), "v"(hi)); return r; }
typedef float f32x2 __attribute__((ext_vector_type(2)));
template <class Epi, class Sched, bool ALIGN_EPI = false, bool SP2 = false>
__device__ __forceinline__ void gemm_phase(PG8_LAS unsigned char* lds, const Gemm g, const Sched& S, const Epi& E) {
    const int tid = opaque_v((int)threadIdx.x), wid = __builtin_amdgcn_readfirstlane(tid >> 6), lane = tid & 63, wr = wid >> 2, wc = wid & 3, fr = lane & 15, fq = lane >> 4;
    const int K = g.K, nt = K / BK;
    unsigned voffA[2], voffB[2];
#pragma unroll
    for (int i = 0; i < 2; ++i) { int R, C; stage_rc(tid * 16 + i * 8192, R, C); const int Rb = Epi::PERM ? ((R & ~31) + perm32(R & 31)) : R;
        voffA[i] = (unsigned)(R * K + C) * 2u; voffB[i] = (unsigned)(Rb * K + C) * 2u; }
    const size_t kstep = (size_t)(BK * 2);
    const size_t hstep = (size_t)HALF * K * 2;
    const size_t tstep = 2 * hstep;
    const unsigned ldsw = (unsigned)wid * 1024u;
    const int aoff = lds_byte(wr * 64 + fr, fq * 8), boff = lds_byte(wc * 32 + fr, fq * 8);
#define PG8_SA(b, h) (((b) * 2 + (h)) * HTB)
#define PG8_SB(b, h) ((4 + (b) * 2 + (h)) * HTB)
#define PG8_STAGE(bufoff, gbase, voff) do { _Pragma("unroll") for (int _i = 0; _i < 2; ++_i) \
        __builtin_amdgcn_global_load_lds((const unsigned*)((const char*)(gbase) + (voff)[_i]), (PG8_LAS unsigned*)(lds + (bufoff) + ldsw + _i * 8192), 16, 0, 0); } while (0)
#define PG8_LDA(dst, b, h) do { _Pragma("unroll") for (int m = 0; m < 4; ++m) _Pragma("unroll") for (int k = 0; k < 2; ++k) dst[m][k] = *(const PG8_LAS bf16x8*)(lds + PG8_SA(b, h) + aoff + m * 2048 + k * 1024); } while (0)
#define PG8_LDB(dst, b, h) do { _Pragma("unroll") for (int n = 0; n < 2; ++n) _Pragma("unroll") for (int k = 0; k < 2; ++k) dst[n][k] = *(const PG8_LAS bf16x8*)(lds + PG8_SB(b, h) + boff + n * 2048 + k * 1024); } while (0)
#define PG8_MMA(ai, bj, At, Bt) do { __builtin_amdgcn_s_setprio(1); _Pragma("unroll") for (int m = 0; m < 4; ++m) _Pragma("unroll") for (int n = 0; n < 2; ++n) _Pragma("unroll") for (int k = 0; k < 2; ++k) \
        acc[ai][bj][m][n] = __builtin_amdgcn_mfma_f32_16x16x32_bf16(Bt[n][k], At[m][k], acc[ai][bj][m][n], 0, 0, 0); __builtin_amdgcn_s_setprio(0); } while (0)
#define PG8_WAIT_V(n) asm volatile("s_waitcnt vmcnt(" #n ")" ::: "memory")
#define PG8_WAIT_L(n) asm volatile("s_waitcnt lgkmcnt(" #n ")" ::: "memory")
#define PG8_BAR __builtin_amdgcn_s_barrier()
#define PG8_SCHED __builtin_amdgcn_sched_barrier(0)
    Unit cur, nxt; int ui = 0;
    if (!S.next(0, cur)) return;
    f32x4 acc[2][2][4][2];
#pragma unroll
    for (int a = 0; a < 2; ++a)
#pragma unroll
        for (int b = 0; b < 2; ++b)
#pragma unroll
            for (int m = 0; m < 4; ++m)
#pragma unroll
                for (int n = 0; n < 2; ++n) acc[a][b][m][n] = (f32x4){0.f, 0.f, 0.f, 0.f};
    bf16x8 At[4][2], B0[2][2], B1[2][2];
    const char* cA = (const char*)g.A + (size_t)cur.pm * tstep; const char* cB = (const char*)g.Bt + (size_t)cur.pn * tstep;
    S.a_ready(cur);
    if constexpr (SP2) {
        PG8_STAGE(PG8_SB(0, 0), cB, voffB); PG8_STAGE(PG8_SB(0, 1), cB + hstep, voffB); PG8_STAGE(PG8_SA(0, 0), cA, voffA); PG8_STAGE(PG8_SA(0, 1), cA + hstep, voffA);
        if (wr == 1) PG8_BAR;
        PG8_WAIT_V(2); PG8_BAR;
        PG8_STAGE(PG8_SB(1, 0), cB + kstep, voffB); PG8_STAGE(PG8_SA(1, 0), cA + kstep, voffA); PG8_STAGE(PG8_SB(1, 1), cB + hstep + kstep, voffB);
        PG8_WAIT_V(6); PG8_BAR;
    } else {
        PG8_STAGE(PG8_SB(0, 0), cB, voffB); PG8_STAGE(PG8_SA(0, 0), cA, voffA); PG8_STAGE(PG8_SB(0, 1), cB + hstep, voffB); PG8_STAGE(PG8_SA(0, 1), cA + hstep, voffA);
        if (wr == 1) PG8_BAR;
        PG8_WAIT_V(4); PG8_BAR;
        PG8_STAGE(PG8_SB(1, 0), cB + kstep, voffB); PG8_STAGE(PG8_SA(1, 0), cA + kstep, voffA); PG8_STAGE(PG8_SB(1, 1), cB + hstep + kstep, voffB);
        PG8_WAIT_V(6); PG8_BAR;
    }
    for (;;) {
        const bool has_next = S.next(ui + 1, nxt);
        const char* nA = has_next ? (const char*)g.A + (size_t)nxt.pm * tstep : cA; const char* nB = has_next ? (const char*)g.Bt + (size_t)nxt.pn * tstep : cB;
        for (int t = 0; t < nt; t += 2) {
            const bool last = (t == nt - 2);
            const char* a1 = cA + (size_t)(t + 1) * kstep;
            const char* a2 = last ? nA : cA + (size_t)(t + 2) * kstep; const char* b2 = last ? nB : cB + (size_t)(t + 2) * kstep;
            const char* a3 = a2 + kstep; const char* b3 = b2 + kstep;
            if (last && has_next) S.a_ready(nxt);
            if constexpr (SP2) {
            PG8_LDB(B0, 0, 0); PG8_LDB(B1, 0, 1); PG8_SCHED; PG8_LDA(At, 0, 0); PG8_STAGE(PG8_SA(1, 1), a1 + hstep, voffA);
            PG8_WAIT_V(8); PG8_WAIT_L(0); PG8_BAR; PG8_MMA(0, 0, At, B0); PG8_MMA(0, 1, At, B1); PG8_BAR; PG8_SCHED;
            PG8_LDA(At, 0, 1); PG8_STAGE(PG8_SB(0, 0), b2, voffB); PG8_STAGE(PG8_SB(0, 1), b2 + hstep, voffB); PG8_STAGE(PG8_SA(0, 0), a2, voffA);
            PG8_WAIT_V(8); PG8_WAIT_L(0); PG8_BAR; PG8_MMA(1, 0, At, B0); PG8_MMA(1, 1, At, B1); PG8_BAR; PG8_SCHED;
            PG8_LDB(B0, 1, 0); PG8_LDB(B1, 1, 1); PG8_SCHED; PG8_LDA(At, 1, 0); PG8_STAGE(PG8_SA(0, 1), a2 + hstep, voffA);
            PG8_WAIT_V(8); PG8_WAIT_L(0); PG8_BAR; PG8_MMA(0, 0, At, B0); PG8_MMA(0, 1, At, B1); PG8_BAR; PG8_SCHED;
            PG8_LDA(At, 1, 1); PG8_STAGE(PG8_SB(1, 0), b3, voffB); PG8_STAGE(PG8_SB(1, 1), b3 + hstep, voffB); PG8_STAGE(PG8_SA(1, 0), a3, voffA);
            PG8_WAIT_V(8); PG8_WAIT_L(0); PG8_BAR; PG8_MMA(1, 0, At, B0); PG8_MMA(1, 1, At, B1); PG8_BAR; PG8_SCHED;
            } else {
            PG8_LDB(B0, 0, 0); PG8_SCHED; PG8_LDA(At, 0, 0); PG8_STAGE(PG8_SA(1, 1), a1 + hstep, voffA);
            PG8_WAIT_L(8); PG8_BAR; PG8_WAIT_L(0); PG8_MMA(0, 0, At, B0); PG8_BAR; PG8_SCHED;
            PG8_LDB(B1, 0, 1); PG8_STAGE(PG8_SB(0, 0), b2, voffB);
            PG8_BAR; PG8_WAIT_L(0); PG8_MMA(0, 1, At, B1); PG8_BAR;
            PG8_LDA(At, 0, 1); PG8_STAGE(PG8_SA(0, 0), a2, voffA);
            PG8_BAR; PG8_WAIT_L(0); PG8_MMA(1, 0, At, B0); PG8_BAR; PG8_SCHED;
            PG8_STAGE(PG8_SB(0, 1), b2 + hstep, voffB);
            PG8_WAIT_V(6); PG8_BAR; PG8_MMA(1, 1, At, B1); PG8_BAR;
            PG8_LDB(B0, 1, 0); PG8_SCHED; PG8_LDA(At, 1, 0); PG8_STAGE(PG8_SA(0, 1), a2 + hstep, voffA);
            PG8_WAIT_L(8); PG8_BAR; PG8_WAIT_L(0); PG8_MMA(0, 0, At, B0); PG8_BAR; PG8_SCHED;
            PG8_LDB(B1, 1, 1); PG8_STAGE(PG8_SB(1, 0), b3, voffB);
            PG8_BAR; PG8_WAIT_L(0); PG8_MMA(0, 1, At, B1); PG8_BAR;
            PG8_LDA(At, 1, 1); PG8_STAGE(PG8_SA(1, 0), a3, voffA);
            PG8_BAR; PG8_WAIT_L(0); PG8_MMA(1, 0, At, B0); PG8_BAR; PG8_SCHED;
            PG8_STAGE(PG8_SB(1, 1), b3 + hstep, voffB);
            PG8_WAIT_V(6); PG8_BAR; PG8_MMA(1, 1, At, B1); PG8_BAR;
            }
        }
        if constexpr (ALIGN_EPI) { if (wr == 0) PG8_BAR; }
        if constexpr (!Epi::AFTER_DRAIN) { E(acc, cur, wr, wc, fr, fq); S.done(cur); }
        if (!has_next) break;
#pragma unroll
        for (int a = 0; a < 2; ++a)
#pragma unroll
            for (int b = 0; b < 2; ++b)
#pragma unroll
                for (int m = 0; m < 4; ++m)
#pragma unroll
                    for (int n = 0; n < 2; ++n) acc[a][b][m][n] = (f32x4){0.f, 0.f, 0.f, 0.f};
        cur = nxt; cA = nA; cB = nB; ++ui;
        if constexpr (ALIGN_EPI) { if (wr == 1) PG8_BAR; }
    }
    PG8_WAIT_V(0);
    if constexpr (!ALIGN_EPI) { if (wr == 0) PG8_BAR; }
    PG8_BAR;
    if constexpr (Epi::AFTER_DRAIN) { E.fused(acc, cur, wr, wc, fr, fq, lds, wid, lane); S.done(cur); }
#undef PG8_SA
#undef PG8_SB
#undef PG8_STAGE
#undef PG8_LDA
#undef PG8_LDB
#undef PG8_MMA
#undef PG8_WAIT_V
#undef PG8_WAIT_L
#undef PG8_BAR
#undef PG8_SCHED
}
}
namespace pg8 {
struct EpiInProj {
    static constexpr bool PERM = true, AFTER_DRAIN = false;
    ::bf16_t* P; const float* tabA; const float* tabB; const float* qn_g; const float* kn_g;
    __device__ __forceinline__ void operator()(const f32x4 (&acc)[2][2][4][2], const Unit& u, int wr_, int wc_, int fr_, int fq_) const {
        const int fr = opaque_v(fr_), fq = opaque_v(fq_), wr = opaque_s(wr_), wc = opaque_s(wc_);
        const int pn = u.pn, m0 = u.pm * BM; const int t0 = m0 % T; const bool lat = t0 < S;
        int type = 0; float qs = 1.f; const float* g = nullptr;
        if (pn == 0) { type = 3; qs = C2A; g = qn_g; }
        else if (pn == 1) { if (wc < 2) { type = 3; g = kn_g; } }
        else if (pn == 2 || pn == 6 || pn == 10 || pn == 12) type = 1;
        else if (pn == 3) { type = 4; qs = C2B; }
        else if (pn == 4) type = 4;
        else if (pn == 7) { type = 2; qs = C2A; }
        ::bf16_t* base = P + (size_t)(m0 + wr * 64 + fr) * NP + 256 * pn + 64 * wc + 8 * fq;
        f32x4 gv[2][2];
        if (type == 3) {
#pragma unroll
            for (int bj = 0; bj < 2; ++bj)
#pragma unroll
                for (int n = 0; n < 2; ++n) gv[bj][n] = *(const f32x4*)(g + 32 * bj + 16 * n + 4 * fq);
        }
#pragma unroll
        for (int ai = 0; ai < 2; ++ai) {
            const int prow = (t0 >> 6) + 2 * ai + wr;
#pragma unroll
            for (int m = 0; m < 4; ++m) {
                f32x4 v[2][2];
#pragma unroll
                for (int bj = 0; bj < 2; ++bj)
#pragma unroll
                    for (int n = 0; n < 2; ++n) v[bj][n] = acc[ai][bj][m][n];
                const int pcol = 16 * m + fr;
                if (type == 1) {
#pragma unroll
                    for (int bj = 0; bj < 2; ++bj)
#pragma unroll
                        for (int n = 0; n < 2; ++n)
#pragma unroll
                            for (int e = 0; e < 4; ++e) v[bj][n][e] = silu_f(v[bj][n][e]);
                } else if (type == 2) {
#pragma unroll
                    for (int bj = 0; bj < 2; ++bj)
#pragma unroll
                        for (int n = 0; n < 2; ++n) v[bj][n] = v[bj][n] * qs;
                } else if (type == 3) {
                    float ss = 0.f;
#pragma unroll
                    for (int bj = 0; bj < 2; ++bj)
#pragma unroll
                        for (int n = 0; n < 2; ++n) ss += (v[bj][n][0] * v[bj][n][0] + v[bj][n][1] * v[bj][n][1]) + (v[bj][n][2] * v[bj][n][2] + v[bj][n][3] * v[bj][n][3]);
                    ss += __shfl_xor(ss, 16); ss += __shfl_xor(ss, 32);
                    const float rs = rsqrtf(ss * (1.f / 64.f) + RMS_EPS);
#pragma unroll
                    for (int bj = 0; bj < 2; ++bj)
#pragma unroll
                        for (int n = 0; n < 2; ++n) v[bj][n] = v[bj][n] * rs * gv[bj][n];
                    if (lat) {
#pragma unroll
                        for (int bj = 0; bj < 2; ++bj) {
                            const int pos = bj == 0 ? prow : pcol;
                            const f32x4 t0v = *(const f32x4*)(tabA + (pos * 16 + 4 * fq) * 2), t1v = *(const f32x4*)(tabA + (pos * 16 + 4 * fq) * 2 + 4);
                            const float cs[4] = {t0v[0], t0v[2], t1v[0], t1v[2]}, sn[4] = {t0v[1], t0v[3], t1v[1], t1v[3]};
#pragma unroll
                            for (int e = 0; e < 4; ++e) { const float x1 = v[bj][0][e], x2 = v[bj][1][e]; v[bj][0][e] = x1 * cs[e] - x2 * sn[e]; v[bj][1][e] = x1 * sn[e] + x2 * cs[e]; }
                        }
                    }
                    if (qs != 1.f) {
#pragma unroll
                        for (int bj = 0; bj < 2; ++bj)
#pragma unroll
                            for (int n = 0; n < 2; ++n) v[bj][n] = v[bj][n] * qs;
                    }
                } else if (type == 4) {
                    if (lat) {
                        const int pos = (fq >> 1) == 0 ? prow : pcol;
                        const f32x4 t0v = *(const f32x4*)(tabB + (pos * 8 + 4 * (fq & 1)) * 2), t1v = *(const f32x4*)(tabB + (pos * 8 + 4 * (fq & 1)) * 2 + 4);
                        const float cs[4] = {t0v[0], t0v[2], t1v[0], t1v[2]}, sn[4] = {t0v[1], t0v[3], t1v[1], t1v[3]};
#pragma unroll
                        for (int bj = 0; bj < 2; ++bj)
#pragma unroll
                            for (int e = 0; e < 4; ++e) { const float x1 = v[bj][0][e], x2 = v[bj][1][e]; v[bj][0][e] = x1 * cs[e] - x2 * sn[e]; v[bj][1][e] = x1 * sn[e] + x2 * cs[e]; }
                    }
                    if (qs != 1.f) {
#pragma unroll
                        for (int bj = 0; bj < 2; ++bj)
#pragma unroll
                            for (int n = 0; n < 2; ++n) v[bj][n] = v[bj][n] * qs;
                    }
                }
                ::bf16_t* rowp = base + (size_t)(ai * HALF + m * 16) * NP;
#pragma unroll
                for (int bj = 0; bj < 2; ++bj) {
                    u32x4 w; w.x = cvt_pk_bf16(v[bj][0][0], v[bj][0][1]); w.y = cvt_pk_bf16(v[bj][0][2], v[bj][0][3]); w.z = cvt_pk_bf16(v[bj][1][0], v[bj][1][1]); w.w = cvt_pk_bf16(v[bj][1][2], v[bj][1][3]);
                    *(u32x4*)(rowp + 32 * bj) = w;
                }
            }
        }
    }
};
struct EpiOutProj {
    static constexpr bool PERM = false, AFTER_DRAIN = false;
    float* xl; float* xc; const float* mod_l;
    __device__ __forceinline__ void operator()(const f32x4 (&acc)[2][2][4][2], const Unit& u, int wr_, int wc_, int fr_, int fq_) const {
        const int fr = opaque_v(fr_), fq = opaque_v(fq_), wr = opaque_s(wr_), wc = opaque_s(wc_);
        const int m0 = u.pm * BM; const int b = m0 / T, t0 = m0 - b * T;
        float* xb = t0 < S ? xl + ((size_t)b * S + t0) * D : xc + ((size_t)b * CT + (t0 - S)) * D;
        const float* gate = mod_l + (size_t)(t0 < S ? b : 4) * 3 * D + 2 * D;
        const int col0 = u.pn * BM + wc * 32 + 4 * fq;
        f32x4 gv[2][2];
#pragma unroll
        for (int bj = 0; bj < 2; ++bj)
#pragma unroll
            for (int n = 0; n < 2; ++n) gv[bj][n] = *(const f32x4*)(gate + col0 + bj * HALF + n * 16);
#pragma unroll
        for (int ai = 0; ai < 2; ++ai)
#pragma unroll
            for (int m = 0; m < 4; ++m) {
                float* xr = xb + (size_t)(ai * HALF + wr * 64 + m * 16 + fr) * D + col0;
#pragma unroll
                for (int bj = 0; bj < 2; ++bj)
#pragma unroll
                    for (int n = 0; n < 2; ++n) { const f32x4 xv = *(const f32x4*)(xr + bj * HALF + n * 16); *(f32x4*)(xr + bj * HALF + n * 16) = xv * ALPHA + gv[bj][n] * acc[ai][bj][m][n]; }
            }
    }
};
struct EpiGlu {
    static constexpr bool PERM = true, AFTER_DRAIN = false;
    ::bf16_t* Y; const ::bf16_t* P;
    __device__ __forceinline__ void operator()(const f32x4 (&acc)[2][2][4][2], const Unit& u, int wr_, int wc_, int fr_, int fq_) const {
        const int fr = opaque_v(fr_), fq = opaque_v(fq_), wr = opaque_s(wr_), wc = opaque_s(wc_);
        const int m0 = u.pm * BM, col8 = 128 * u.pn + 32 * wc + 8 * fq;
#pragma unroll
        for (int ai = 0; ai < 2; ++ai)
#pragma unroll
            for (int m = 0; m < 4; ++m) {
                const size_t row = (size_t)(m0 + ai * HALF + wr * 64 + m * 16 + fr);
                const u32x4 gt = *(const u32x4*)(P + row * NP + DG + col8);
                float o[8];
#pragma unroll
                for (int n = 0; n < 2; ++n)
#pragma unroll
                    for (int e = 0; e < 4; ++e) { const float v = acc[ai][0][m][n][e], g = acc[ai][1][m][n][e]; o[4 * n + e] = v * sigm_f(g); }
                u32x4 w;
#pragma unroll
                for (int e = 0; e < 4; ++e) { const float ga = __uint_as_float(gt[e] << 16), gb = __uint_as_float(gt[e] & 0xffff0000u); w[e] = cvt_pk_bf16(o[2 * e] * ga, o[2 * e + 1] * gb); }
                *(u32x4*)(Y + row * D + 768 + col8) = w;
            }
    }
};
}
__device__ __forceinline__ float wave_sum(float v) {
#pragma unroll
    for (int o = 1; o < 64; o <<= 1) v += __shfl_xor(v, o);
    return v;
}
__device__ __forceinline__ void transpose_item(const float* W, int K, int N, bf16_t* WT, int kb, int nphys0, int lbase, int pt, LAS float* scr, int lane) {
    const int k0 = 64 * kb;
#pragma unroll 8
    for (int i = 0; i < 32; ++i) { const int kk = 2 * i + (lane >> 5); scr[kk * 33 + (lane & 31)] = W[(size_t)(k0 + kk) * N + lbase + (lane & 31)]; }
    asm volatile("s_waitcnt lgkmcnt(0)" ::: "memory");
    const int c = lane & 7;
#pragma unroll
    for (int j = 0; j < 4; ++j) {
        const int n = (lane >> 3) + 8 * j; const int fq = n >> 3, nn = (n >> 2) & 1, e = n & 3;
        const int lo = pt == 0 ? n : pt == 1 ? 16 * nn + 4 * fq + e : 16 * (fq >> 1) + 8 * nn + 4 * (fq & 1) + e;
        const LAS float* s = scr + (8 * c) * 33 + lo;
        u32x4 o; o.x = pk2(s[0 * 33], s[1 * 33]); o.y = pk2(s[2 * 33], s[3 * 33]); o.z = pk2(s[4 * 33], s[5 * 33]); o.w = pk2(s[6 * 33], s[7 * 33]);
        *(u32x4*)(WT + (size_t)(nphys0 + n) * K + k0 + 8 * c) = o;
    }
    asm volatile("s_waitcnt lgkmcnt(0)" ::: "memory");
}
__device__ __forceinline__ void phase_prologue(const Params& p, const KArgs& ka, LAS unsigned char* lds, int gw, int ngw, int wave, int lane) {
    {
        float* sm = (float*)(ka.ws + O_SMALL);
#pragma unroll
        for (int i = 0; i < 18; ++i) { const float* src = ka.in[8 + i]; float* dst = sm + sm_off(i); for (int e = gw * 64 + lane; e < SM_N[i]; e += ngw * 64) dst[e] = src[e]; }
    }
    LAS float* sc5 = (LAS float*)lds;
    LAS float* scr = (LAS float*)(lds + 20480 + wave * 9216);
    for (int i = threadIdx.x; i < 5 * D; i += NTHR) { const float v = i < 4 * D ? p.c[i] : p.c_ctx[i - 4 * D]; sc5[i] = v / (1.f + expf(-v)); }
    __syncthreads();
    for (int it = gw; it < NL * 48; it += ngw) {
        const int l = it / 48, j = (it % 48) * 64 + lane;
        const float* w = p.w_ada + (size_t)l * D * 3 * D + j;
        float a0 = 0.f, a1 = 0.f, a2 = 0.f, a3 = 0.f, a4 = 0.f;
#pragma unroll 8
        for (int k = 0; k < D; ++k) { const float wv = w[(size_t)k * 3 * D]; a0 += sc5[k] * wv; a1 += sc5[D + k] * wv; a2 += sc5[2 * D + k] * wv; a3 += sc5[3 * D + k] * wv; a4 += sc5[4 * D + k] * wv; }
        const float bb = p.b_ada[l * 3 * D + j]; float* o = p.mod + (size_t)l * 5 * 3 * D + j;
        o[0] = a0 + bb; o[3 * D] = a1 + bb; o[6 * D] = a2 + bb; o[9 * D] = a3 + bb; o[12 * D] = a4 + bb;
    }
    for (int i = gw * 64 + lane; i < NL * 2 * 16 * 64; i += ngw * 64) {
        const int ig = i >> 6; const size_t ip = (size_t)i;
        const double ar = p.a_re[ip], ai = p.a_im[ip], dt = exp((double)p.log_dt[ig]);
        const double e = exp(ar * dt), lr = e * cos(ai * dt), li = e * sin(ai * dt);
        const double nr = lr - 1.0, ni = li, den = ar * ar + ai * ai; const double cr = (nr * ar + ni * ai) / den, ci = (ni * ar - nr * ai) / den;
        float* o = p.disc + ip * 34; o[0] = (float)lr; o[1] = (float)li;
        for (int c = 0; c < 16; ++c) { const double br = p.b_re[ip * 16 + c], bi = p.b_im[ip * 16 + c]; o[2 + c] = (float)(cr * br - ci * bi); o[18 + c] = (float)(cr * bi + ci * br); }
    }
    for (int i = gw * 64 + lane; i < 64 * 16 + 64 * 8; i += ngw * 64) {
        if (i < 1024) { const int pos = i >> 4, k = i & 15; const float an = (float)pos * powf(10000.f, -(float)k / 16.f); p.tabA[2 * i] = cosf(an); p.tabA[2 * i + 1] = sinf(an); }
        else { const int j = i - 1024, pos = j >> 3, k = j & 7; const float an = (float)pos * powf(10000.f, -(float)k / 8.f); p.tabB[2 * j] = cosf(an); p.tabB[2 * j + 1] = sinf(an); }
    }
    constexpr int I_IN = 16 * 104, I_OUT = 16 * 32, I_GLU = 4 * 16, I_L = I_IN + I_OUT + I_GLU;
    for (int it = gw; it < NL * I_L; it += ngw) {
        const int l = it / I_L; int r = it % I_L;
        if (r < I_IN) {
            const int kb = r / 104, nb = r % 104, c = 32 * nb, pn = c >> 8, bj = (c >> 7) & 1, wc = (c >> 5) & 3;
            const int pt = (pn == 0 || (pn == 1 && wc < 2)) ? 1 : (pn == 3 || pn == 4) ? 2 : 0;
            transpose_item(p.w_in + (size_t)l * D * NP, D, NP, p.Win_t + (size_t)l * NP * D, kb, c, 256 * pn + 64 * wc + 32 * bj, pt, scr, lane);
        } else if ((r -= I_IN) < I_OUT) {
            const int kb = r / 32, nb = r % 32;
            transpose_item(p.w_out + (size_t)l * D * D, D, D, p.Wout_t + (size_t)l * D * D, kb, 32 * nb, 32 * nb, 0, scr, lane);
        } else {
            r -= I_OUT; const int kb = r / 16, nb = r % 16, c = 32 * nb, pn = c >> 8, bj = (c >> 7) & 1, wc = (c >> 5) & 3;
            transpose_item(p.w_glu + (size_t)l * 256 * 512, 256, 512, p.Wglu_t + (size_t)l * 512 * 256, kb, c, 256 * bj + 128 * pn + 32 * wc, 0, scr, lane);
        }
    }
}
__device__ __forceinline__ void phase_rows(const Params& p, int l_prev, int l_next, int gw, int ngw, int lane) {
    for (int m = gw; m < MT; m += ngw) {
        const int b = m / T, t = m - b * T; const bool lat = t < S;
        if (l_next == NL && !lat) continue;
        float* xr = lat ? p.xl + ((size_t)b * S + t) * D : p.xc + ((size_t)b * CT + (t - S)) * D;
        f32x4 v[4];
        if (l_prev < 0) {
            const float* src = lat ? p.x + ((size_t)b * S + t) * D : p.ctx + ((size_t)b * CT + (t - S)) * D;
#pragma unroll
            for (int j = 0; j < 4; ++j) { v[j] = *(const f32x4*)(src + 4 * lane + 256 * j); *(f32x4*)(xr + 4 * lane + 256 * j) = v[j]; }
        } else {
            float s = 0.f;
#pragma unroll
            for (int j = 0; j < 4; ++j) { v[j] = *(const f32x4*)(xr + 4 * lane + 256 * j); s += (v[j][0] + v[j][1]) + (v[j][2] + v[j][3]); }
            const float mean = wave_sum(s) * (1.f / D); float q = 0.f;
#pragma unroll
            for (int j = 0; j < 4; ++j) { v[j] = v[j] - mean; q += (v[j][0] * v[j][0] + v[j][1] * v[j][1]) + (v[j][2] * v[j][2] + v[j][3] * v[j][3]); }
            const float rstd = rsqrtf(wave_sum(q) * (1.f / D) + LN_EPS);
#pragma unroll
            for (int j = 0; j < 4; ++j) {
                const f32x4 g = *(const f32x4*)(p.ln_g + l_prev * D + 4 * lane + 256 * j), be = *(const f32x4*)(p.ln_b + l_prev * D + 4 * lane + 256 * j);
                v[j] = v[j] * rstd * g + be; *(f32x4*)(xr + 4 * lane + 256 * j) = v[j];
            }
        }
        if (l_next < NL) {
            const float* md = p.mod + ((size_t)l_next * 5 + (lat ? b : 4)) * 3 * D;
            bf16_t* ar = p.A + (size_t)m * D;
#pragma unroll
            for (int j = 0; j < 4; ++j) {
                const f32x4 sh = *(const f32x4*)(md + 4 * lane + 256 * j), sc = *(const f32x4*)(md + D + 4 * lane + 256 * j);
                const f32x4 h = v[j] * (sc + 1.f) + sh;
                u32x2 w; w.x = pk2(h[0], h[1]); w.y = pk2(h[2], h[3]); *(u32x2*)(ar + 4 * lane + 256 * j) = w;
            }
        }
    }
}
namespace att {
typedef short bf16x8 __attribute__((ext_vector_type(8)));
typedef short s16x4 __attribute__((ext_vector_type(4)));
typedef float f32x16 __attribute__((ext_vector_type(16)));
typedef float f32x2_t __attribute__((ext_vector_type(2)));
typedef __bf16 bf16x2_t __attribute__((ext_vector_type(2)));
constexpr int SLOT = 16384, L_RING = 0, L_OST = 49152, L_WSF = L_OST + 8 * 8192, L_RPB = L_WSF + 8 * 256, L_END = L_RPB + 2048;
constexpr float THR = 6.f;
#define ATT_MFMA(a, b, c) __builtin_amdgcn_mfma_f32_32x32x16_bf16(a, b, c, 0, 0, 0)
#define ATT_WAIT_BAR(N) asm volatile("s_waitcnt vmcnt(" #N ") lgkmcnt(0)\n\ts_barrier" ::: "memory")
__device__ __forceinline__ int crow(int r, int hi) { return (r & 3) + 8 * (r >> 2) + 4 * hi; }
__device__ __forceinline__ unsigned cvtpk(float lo, float hi) { f32x2_t v = {lo, hi}; bf16x2_t b = __builtin_convertvector(v, bf16x2_t); return __builtin_bit_cast(unsigned, b); }
__device__ __forceinline__ void glds16(const void* g, unsigned lds_base) {
    unsigned sv; asm volatile("s_mov_b32 %0, m0\n\ts_mov_b32 m0, %2\n\ts_nop 0\n\tglobal_load_lds_dwordx4 %1, off\n\ts_mov_b32 m0, %0" : "=&s"(sv) : "v"(g), "s"(lds_base) : "memory"); }
#define ATT_MX3(a, b, c) __builtin_fmaxf(__builtin_fmaxf((a), (b)), (c))
__device__ __forceinline__ float rowmax(const f32x16& p0, const f32x16& p1) {
    float a = ATT_MX3(p0[0], p0[1], p1[0]), b = ATT_MX3(p0[2], p0[3], p1[1]); a = ATT_MX3(a, p1[2], p1[3]);
#pragma unroll
    for (int r = 4; r < 16; r += 4) { a = ATT_MX3(a, p0[r], p0[r + 1]); b = ATT_MX3(b, p0[r + 2], p0[r + 3]); a = ATT_MX3(a, p1[r], p1[r + 1]); b = ATT_MX3(b, p1[r + 2], p1[r + 3]); }
    float m = __builtin_fmaxf(a, b); auto rr = __builtin_amdgcn_permlane32_swap(__float_as_uint(m), __float_as_uint(m), false, false);
    return __builtin_fmaxf(__uint_as_float(rr[0]), __uint_as_float(rr[1])); }
__device__ __forceinline__ float rowsum(const f32x16& p0, const f32x16& p1) {
    float a = 0.f, b = 0.f;
#pragma unroll
    for (int r = 0; r < 16; r += 2) { a += p0[r] + p1[r]; b += p0[r + 1] + p1[r + 1]; }
    return a + b; }
__device__ __forceinline__ void vfrags(bf16x8 (&vf)[4], int vb, int d0) {
    s16x4 lo[4], hi[4];
    if (d0 == 0) {
#pragma unroll
        for (int ks = 0; ks < 4; ++ks) {
            asm volatile("ds_read_b64_tr_b16 %0,%1 offset:%c2" : "=&v"(lo[ks]) : "v"(vb), "i"(ks * 1024) : "memory");
            asm volatile("ds_read_b64_tr_b16 %0,%1 offset:%c2" : "=&v"(hi[ks]) : "v"(vb), "i"(ks * 1024 + 512) : "memory"); }
    } else {
#pragma unroll
        for (int ks = 0; ks < 4; ++ks) {
            asm volatile("ds_read_b64_tr_b16 %0,%1 offset:%c2" : "=&v"(lo[ks]) : "v"(vb), "i"(4096 + ks * 1024) : "memory");
            asm volatile("ds_read_b64_tr_b16 %0,%1 offset:%c2" : "=&v"(hi[ks]) : "v"(vb), "i"(4096 + ks * 1024 + 512) : "memory"); }
    }
    asm volatile("s_waitcnt lgkmcnt(0)" : "+v"(lo[0]), "+v"(lo[1]), "+v"(lo[2]), "+v"(lo[3]), "+v"(hi[0]), "+v"(hi[1]), "+v"(hi[2]), "+v"(hi[3]) :: "memory");
#pragma unroll
    for (int ks = 0; ks < 4; ++ks) vf[ks] = (bf16x8){lo[ks][0], lo[ks][1], lo[ks][2], lo[ks][3], hi[ks][0], hi[ks][1], hi[ks][2], hi[ks][3]};
}
struct PW { u32x4 w[4]; };
__device__ __forceinline__ void packp(PW& pw, const f32x16& p0, const f32x16& p1) {
#pragma unroll
    for (int i = 0; i < 4; ++i) { pw.w[0][i] = cvtpk(p0[2 * i], p0[2 * i + 1]); pw.w[1][i] = cvtpk(p0[8 + 2 * i], p0[9 + 2 * i]); pw.w[2][i] = cvtpk(p1[2 * i], p1[2 * i + 1]); pw.w[3][i] = cvtpk(p1[8 + 2 * i], p1[9 + 2 * i]); }
}
__device__ __forceinline__ bool softmax_tile(f32x16& p0, f32x16& p1, float& mhat, float& l_reg, float& f, bool first) {
    const float rm = rowmax(p0, p1);
    bool resc = false; f = 1.f;
    if (first || __any(rm > THR)) {
        const float dl = first ? rm : __builtin_fmaxf(rm, 0.f); mhat += dl;
#pragma unroll
        for (int r = 0; r < 16; ++r) { p0[r] -= dl; p1[r] -= dl; }
        if (!first) { f = __builtin_amdgcn_exp2f(-dl); l_reg *= f; resc = true; }
    }
#pragma unroll
    for (int r = 0; r < 16; ++r) { p0[r] = __builtin_amdgcn_exp2f(p0[r]); p1[r] = __builtin_amdgcn_exp2f(p1[r]); }
    l_reg += rowsum(p0, p1);
    return resc;
}
struct UnitDesc { int var, b, h, kvh, qrow0, f0, n0, f1, n1; };
struct LayerConst { int l; float lam, one_m_lam_init; };

template <int VAR> __device__ __forceinline__ void attn_unit(const Params& p, const UnitDesc& u, const LayerConst& lc, LAS unsigned char* lds) {
    const int tid = opaque_v((int)threadIdx.x), lane = tid & 63, r32 = lane & 31, hi = lane >> 5; const int wid = __builtin_amdgcn_readfirstlane(tid >> 6);
    constexpr int QOFF = VAR == 0 ? AQ : VAR == 1 ? BQ : CQ, KOFF = VAR == 0 ? AK : VAR == 1 ? BK : CK, VOFF = VAR == 0 ? AV : VAR == 1 ? BV : CV, GOFF = VAR == 0 ? AG : VAR == 1 ? BG : CG, YOFF = VAR * 256;
    const size_t rowb = (size_t)u.b * T;
    const unsigned lds0 = (unsigned)(uintptr_t)lds;
    LAS float* wsf = (LAS float*)(lds + L_WSF) + wid * 64;
    LAS float* ost = (LAS float*)(lds + L_OST) + wid * 2048;
    LAS float* rpbL = (LAS float*)(lds + L_RPB);
    const int NT = u.n0 + u.n1;
    const bf16_t* kbase = p.P + (rowb + lane) * NP + KOFF + u.kvh * 64 + wid * 8;
    const bf16_t* vbase = p.P + (rowb + 16 * (wid & 3) + (lane >> 2)) * NP + VOFF + u.kvh * 64 + (wid >> 2) * 32 + (lane & 3) * 8;
#define ATT_TROW(j) (((j) < u.n0 ? u.f0 + (j) : u.f1 + ((j) - u.n0)) * 64)
#define ATT_DMA(j, slot) do { const size_t ro_ = (size_t)ATT_TROW(j) * NP; \
        glds16(kbase + ro_, (unsigned)__builtin_amdgcn_readfirstlane(lds0 + L_RING + (slot) * SLOT + wid * 1024)); \
        glds16(vbase + ro_, (unsigned)__builtin_amdgcn_readfirstlane(lds0 + L_RING + (slot) * SLOT + 8192 + wid * 1024)); } while (0)
    ATT_DMA(0, 0);
    if (NT > 1) ATT_DMA(1, 1);
    if (VAR == 2) { for (int i = tid; i < 15 * 31; i += NTHR) rpbL[i] = p.rpb[((size_t)lc.l * 4 + u.h) * 15 * 31 + i] * LOG2E; }
    const bf16_t* qp = p.P + (rowb + u.qrow0 + wid * 32 + r32) * NP + QOFF + u.h * 64 + hi * 8;
    bf16x8 qr[4];
#pragma unroll
    for (int d0 = 0; d0 < 4; ++d0) qr[d0] = *(const bf16x8*)(qp + d0 * 16);
    const int qt = u.qrow0 + wid * 32 + r32; const int gr = qt >> 6, gwc = qt & 63;
    const int rs0 = min(max(gr - 4, 0), 56), cs0 = min(max(gwc - 8, 0), 48);
    const bool latq = u.qrow0 < S;
    f32x16 o[2], o2[2]; o[0] = f32x16{}; o[1] = f32x16{}; o2[0] = f32x16{}; o2[1] = f32x16{};
    float mhat = 0.f, l_reg = 0.f, mhat2 = 0.f, l_reg2 = 0.f;
    f32x16 negm = f32x16{}, negm2 = f32x16{};
    bool started = false;
    for (int j = 0; j < NT; ++j) {
        if (j + 1 < NT) ATT_WAIT_BAR(2); else ATT_WAIT_BAR(0);
        if (j + 2 < NT) { const int s2 = (j + 2) % 3; ATT_DMA(j + 2, s2); }
        const int sl = (j % 3) * SLOT;
        const int trow = ATT_TROW(j);
        bool active = true; const bool wintile = (VAR == 2) && latq && trow < S;
        if (wintile) { const int kr = trow >> 6; active = (kr >= rs0) && (kr < rs0 + 8); }
        if (!active) continue;
        const LAS unsigned char* kp = lds + L_RING + sl + hi * 1024 + r32 * 16;
        const int vb = (int)(lds0 + L_RING + sl + 8192) + ((lane >> 4) & 1) * 32 + (lane & 3) * 8 + (4 * hi + ((lane & 15) >> 2)) * 64;
        if (VAR != 1) {
            f32x16 p0, p1;
#pragma unroll
            for (int d0 = 0; d0 < 4; ++d0) {
                const bf16x8 b0 = *(const LAS bf16x8*)(kp + d0 * 2048), b1 = *(const LAS bf16x8*)(kp + d0 * 2048 + 512);
                p0 = ATT_MFMA(b0, qr[d0], d0 == 0 ? negm : p0); p1 = ATT_MFMA(b1, qr[d0], d0 == 0 ? negm : p1);
            }
            if (wintile) {
                const int kr = trow >> 6; const LAS float* brow = rpbL + (kr - gr + 7) * 31 + 15 - gwc;
#pragma unroll
                for (int r = 0; r < 16; ++r) {
                    const int kc = crow(r, hi);
                    p0[r] = ((unsigned)(kc - cs0) < 16u) ? p0[r] + brow[kc] : -INFINITY;
                    p1[r] = ((unsigned)(kc + 32 - cs0) < 16u) ? p1[r] + brow[kc + 32] : -INFINITY;
                }
            }
            float f; const bool resc = softmax_tile(p0, p1, mhat, l_reg, f, !started);
            if (resc || !started) {
#pragma unroll
                for (int r = 0; r < 16; ++r) negm[r] = -mhat;
            }
            if (resc) {
                if (hi == 0) wsf[r32] = f;
#pragma unroll
                for (int d_ = 0; d_ < 2; ++d_)
#pragma unroll
                    for (int r = 0; r < 16; ++r) o[d_][r] *= wsf[crow(r, hi)];
            }
            started = true;
            PW pw; packp(pw, p0, p1);
#pragma unroll
            for (int d0 = 0; d0 < 2; ++d0) {
                bf16x8 vf[4]; vfrags(vf, vb, d0);
#pragma unroll
                for (int ks = 0; ks < 4; ++ks) o[d0] = ATT_MFMA(__builtin_bit_cast(bf16x8, pw.w[ks]), vf[ks], o[d0]);
            }
        } else {
            PW pw, pw2; float f = 1.f, f2 = 1.f; bool resc = false;
            {
                f32x16 p0 = f32x16{}, p1 = f32x16{};
#pragma unroll
                for (int d0 = 0; d0 < 2; ++d0) {
                    const bf16x8 b0 = *(const LAS bf16x8*)(kp + d0 * 2048), b1 = *(const LAS bf16x8*)(kp + d0 * 2048 + 512);
                    p0 = ATT_MFMA(b0, qr[d0], p0); p1 = ATT_MFMA(b1, qr[d0], p1);
                }
                const float rm = rowmax(p0, p1);
                if (!started) mhat = rm;
                else if (__any(rm - mhat > THR)) { const float mn = __builtin_fmaxf(mhat, rm); f = __builtin_amdgcn_exp2f(mhat - mn); mhat = mn; l_reg *= f; resc = true; }
#pragma unroll
                for (int r = 0; r < 16; ++r) { p0[r] = __builtin_amdgcn_exp2f(p0[r] - mhat); p1[r] = __builtin_amdgcn_exp2f(p1[r] - mhat); }
                l_reg += rowsum(p0, p1);
                packp(pw, p0, p1);
            }
            {
                f32x16 q0 = f32x16{}, q1 = f32x16{};
#pragma unroll
                for (int d0 = 2; d0 < 4; ++d0) {
                    const bf16x8 b0 = *(const LAS bf16x8*)(kp + d0 * 2048), b1 = *(const LAS bf16x8*)(kp + d0 * 2048 + 512);
                    q0 = ATT_MFMA(b0, qr[d0], q0); q1 = ATT_MFMA(b1, qr[d0], q1);
                }
                const float rm = rowmax(q0, q1);
                if (!started) mhat2 = rm;
                else if (__any(rm - mhat2 > THR)) { const float mn = __builtin_fmaxf(mhat2, rm); f2 = __builtin_amdgcn_exp2f(mhat2 - mn); mhat2 = mn; l_reg2 *= f2; resc = true; }
#pragma unroll
                for (int r = 0; r < 16; ++r) { q0[r] = __builtin_amdgcn_exp2f(q0[r] - mhat2); q1[r] = __builtin_amdgcn_exp2f(q1[r] - mhat2); }
                l_reg2 += rowsum(q0, q1);
                packp(pw2, q0, q1);
            }
            if (resc) {
                if (hi == 0) { wsf[r32] = f; wsf[32 + r32] = f2; }
#pragma unroll
                for (int d_ = 0; d_ < 2; ++d_)
#pragma unroll
                    for (int r = 0; r < 16; ++r) { o[d_][r] *= wsf[crow(r, hi)]; o2[d_][r] *= wsf[32 + crow(r, hi)]; }
            }
            started = true;
#pragma unroll
            for (int d0 = 0; d0 < 2; ++d0) {
                bf16x8 vf[4]; vfrags(vf, vb, d0);
#pragma unroll
                for (int ks = 0; ks < 4; ++ks) { o[d0] = ATT_MFMA(__builtin_bit_cast(bf16x8, pw.w[ks]), vf[ks], o[d0]); o2[d0] = ATT_MFMA(__builtin_bit_cast(bf16x8, pw2.w[ks]), vf[ks], o2[d0]); }
            }
        }
    }
    { auto rr = __builtin_amdgcn_permlane32_swap(__float_as_uint(l_reg), __float_as_uint(l_reg), false, false); l_reg = __uint_as_float(rr[0]) + __uint_as_float(rr[1]); }
    if (VAR == 1) { auto rr = __builtin_amdgcn_permlane32_swap(__float_as_uint(l_reg2), __float_as_uint(l_reg2), false, false); l_reg2 = __uint_as_float(rr[0]) + __uint_as_float(rr[1]); }
    if (hi == 0) { wsf[r32] = 1.f / l_reg; if (VAR == 1) wsf[32 + r32] = lc.lam / l_reg2; }
#pragma unroll
    for (int r = 0; r < 16; ++r) {
        const int orow = crow(r, hi); const float a1 = wsf[orow];
        if (VAR == 1) { const float a2 = wsf[32 + orow]; ost[orow * 64 + r32] = o[0][r] * a1 - o2[0][r] * a2; ost[orow * 64 + 32 + r32] = o[1][r] * a1 - o2[1][r] * a2; }
        else { ost[orow * 64 + r32] = o[0][r] * a1; ost[orow * 64 + 32 + r32] = o[1][r] * a1; }
    }
    asm volatile("s_waitcnt lgkmcnt(0)" ::: "memory");
    const size_t mrow0 = rowb + u.qrow0 + wid * 32;
#pragma unroll
    for (int i = 0; i < 4; ++i) {
        const int row = i * 8 + (lane >> 3), ch = lane & 7;
        const f32x4 x0 = *(const LAS f32x4*)(ost + row * 64 + ch * 8), x1 = *(const LAS f32x4*)(ost + row * 64 + ch * 8 + 4);
        float v[8] = {x0[0], x0[1], x0[2], x0[3], x1[0], x1[1], x1[2], x1[3]};
        if (VAR == 1) {
            float ss = 0.f;
#pragma unroll
            for (int e = 0; e < 8; ++e) ss += v[e] * v[e];
            ss += __shfl_xor(ss, 1); ss += __shfl_xor(ss, 2); ss += __shfl_xor(ss, 4);
            const float rs = rsqrtf(ss * (1.f / 64.f) + RMS_EPS) * lc.one_m_lam_init;
            const f32x4 g0 = *(const f32x4*)(p.subln_g + lc.l * 64 + ch * 8), g1 = *(const f32x4*)(p.subln_g + lc.l * 64 + ch * 8 + 4);
            const float gg[8] = {g0[0], g0[1], g0[2], g0[3], g1[0], g1[1], g1[2], g1[3]};
#pragma unroll
            for (int e = 0; e < 8; ++e) v[e] *= rs * gg[e];
        }
        const u32x4 gt = *(const u32x4*)(p.P + (mrow0 + row) * NP + GOFF + u.h * 64 + ch * 8);
        u32x4 w;
#pragma unroll
        for (int e = 0; e < 4; ++e) { const float ga = __uint_as_float(gt[e] << 16), gb = __uint_as_float(gt[e] & 0xffff0000u); w[e] = cvtpk(v[2 * e] * ga, v[2 * e + 1] * gb); }
        *(u32x4*)(p.A + (mrow0 + row) * D + YOFF + u.h * 64 + ch * 8) = w;
    }
    asm volatile("s_waitcnt lgkmcnt(0)\n\ts_barrier" ::: "memory");
#undef ATT_TROW
#undef ATT_DMA
}

__device__ __forceinline__ void attn_phase(const Params& p, int l, LAS unsigned char* lds, int v, int G) {
    float d1 = 0.f, d2 = 0.f;
    for (int i = 0; i < 32; ++i) { d1 += p.lq1[l * 32 + i] * p.lk1[l * 32 + i]; d2 += p.lq2[l * 32 + i] * p.lk2[l * 32 + i]; }
    const float lam_init = 0.8f - 0.6f * expf(-0.3f * (float)l);
    LayerConst lc{l, expf(d1) - expf(d2) + lam_init, 1.f - lam_init};
    const bool need_ctx = l < NL - 1;
    for (int uidx = v; uidx < 256; uidx += G) {
        { UnitDesc u; u.var = 0; u.b = uidx >> 6; u.kvh = (uidx >> 5) & 1; u.h = u.kvh * 2 + ((uidx >> 4) & 1); u.qrow0 = (uidx & 15) * 256; u.f0 = 0; u.n0 = 68; u.f1 = 0; u.n1 = 0; attn_unit<0>(p, u, lc, lds); }
        { UnitDesc u; u.var = 1; u.b = uidx >> 6; u.h = (uidx >> 4) & 3; u.kvh = u.h; u.qrow0 = (uidx & 15) * 256; u.f0 = 0; u.n0 = 68; u.f1 = 0; u.n1 = 0; attn_unit<1>(p, u, lc, lds); }
        { UnitDesc u; u.var = 2; u.b = uidx >> 6; u.h = (uidx >> 4) & 3; u.kvh = u.h; const int qb = uidx & 15; u.qrow0 = qb * 256;
          const int ra = min(max(4 * qb - 4, 0), 56), rb = min(max(4 * qb + 3 - 4, 0), 56) + 8; u.f0 = 64; u.n0 = 4; u.f1 = ra; u.n1 = rb - ra; attn_unit<2>(p, u, lc, lds); }
    }
    if (need_ctx) {
        for (int uidx = v; uidx < 48; uidx += G) {
            const int var = uidx >> 4, b = (uidx >> 2) & 3, h = uidx & 3;
            UnitDesc u; u.var = var; u.b = b; u.h = h; u.kvh = var == 0 ? (h >> 1) : h; u.qrow0 = S; u.f0 = 64; u.n0 = 4; u.f1 = 0; u.n1 = 0;
            if (var == 0) attn_unit<0>(p, u, lc, lds); else if (var == 1) attn_unit<1>(p, u, lc, lds); else attn_unit<2>(p, u, lc, lds);
        }
    }
}
}
namespace s5n {
__device__ __forceinline__ int s5_tok(int dir, int s) { return dir == 0 ? (s < CT ? S + s : s - CT) : (s < CT ? S + CT - 1 - s : S - 1 - (s - CT)); }
struct S5Disc { float lr, li; float br[16], bi[16]; };
__device__ __forceinline__ void s5_disc(const Params& p, int l, int dir, int g, int st, S5Disc& d) {
    const float* t = p.disc + ((size_t)((l * 2 + dir) * 16 + g) * 64 + st) * 34;
    d.lr = t[0]; d.li = t[1];
#pragma unroll
    for (int c = 0; c < 16; ++c) { d.br[c] = t[2 + c]; d.bi[c] = t[18 + c]; }
}
__device__ __forceinline__ void phase1(const Params& p, int l, int gw, int ngw, int st) {
    for (int it = gw; it < NCH * 16 * NB * 2; it += ngw) {
        const int ch = it % NCH, g = (it / NCH) % 16, bd = it / (NCH * 16), b = bd >> 1, dir = bd & 1;
        S5Disc d; s5_disc(p, l, dir, g, st, d);
        float hr = 0.f, hi = 0.f;
        for (int s = 0; s < 64; ++s) {
            const int tok = s5_tok(dir, ch * 64 + s); const bf16_t* up = p.P + (size_t)(b * T + tok) * NP + DU + g * 16;
            float ur = 0.f, ui = 0.f;
#pragma unroll
            for (int c = 0; c < 16; ++c) { const float u = bf2f(up[c]); ur += d.br[c] * u; ui += d.bi[c] * u; }
            const float nr = d.lr * hr - d.li * hi + ur, ni = d.lr * hi + d.li * hr + ui; hr = nr; hi = ni;
        }
        float* o = p.Sst + ((((size_t)(b * 2 + dir) * 16 + g) * NCH + ch) * 64 + st) * 2; o[0] = hr; o[1] = hi;
    }
}
__device__ __forceinline__ void phase2(const Params& p, int l, int gw, int ngw, int st) {
    for (int it = gw; it < 16 * NB * 2; it += ngw) {
        const int g = it % 16, bd = it / 16, b = bd >> 1, dir = bd & 1;
        S5Disc d; s5_disc(p, l, dir, g, st, d);
        float pr = d.lr, pi = d.li;
        for (int i = 0; i < 6; ++i) { const float nr = pr * pr - pi * pi, ni = 2.f * pr * pi; pr = nr; pi = ni; }
        float hr = 0.f, hi = 0.f;
        const size_t base = (((size_t)(b * 2 + dir) * 16 + g) * NCH) * 64 + st;
        for (int ch = 0; ch < NCH; ++ch) {
            float* hin = p.Hin + (base + (size_t)ch * 64) * 2; hin[0] = hr; hin[1] = hi;
            const float* sv = p.Sst + (base + (size_t)ch * 64) * 2;
            const float nr = pr * hr - pi * hi + sv[0], ni = pr * hi + pi * hr + sv[1]; hr = nr; hi = ni;
        }
    }
}
__device__ __forceinline__ void phase3(const Params& p, int l, LAS unsigned char* lds, int blk, int nblk, int wave, int st) {
    if (wave >= 4) return;
    LAS float* hs = (LAS float*)(lds + wave * 33280);
    for (int it = blk * 4 + wave; it < NCH * 16 * NB; it += nblk * 4) {
        const int tc = it % NCH, g = (it / NCH) % 16, b = it / (NCH * 16);
        const int ti = st, m = b * T + tc * 64 + ti;
        float y[16];
#pragma unroll
        for (int c = 0; c < 16; ++c) y[c] = 0.f;
        for (int dir = 0; dir < 2; ++dir) {
            int ch; if (tc < 64) ch = dir == 0 ? 4 + tc : 4 + (63 - tc); else ch = dir == 0 ? tc - 64 : 3 - (tc - 64);
            S5Disc d; s5_disc(p, l, dir, g, st, d);
            const float* hin = p.Hin + ((((size_t)(b * 2 + dir) * 16 + g) * NCH + ch) * 64 + st) * 2;
            float hr = hin[0], hi = hin[1];
            for (int s = 0; s < 64; ++s) {
                const int tok = s5_tok(dir, ch * 64 + s); const bf16_t* up = p.P + (size_t)(b * T + tok) * NP + DU + g * 16;
                float ur = 0.f, ui = 0.f;
#pragma unroll
                for (int c = 0; c < 16; ++c) { const float u = bf2f(up[c]); ur += d.br[c] * u; ui += d.bi[c] * u; }
                const float nr = d.lr * hr - d.li * hi + ur, ni = d.lr * hi + d.li * hr + ui; hr = nr; hi = ni;
                const int tj = tok - tc * 64;
                hs[(tj * 65 + st) * 2] = hr; hs[(tj * 65 + st) * 2 + 1] = hi;
            }
            asm volatile("s_waitcnt lgkmcnt(0)" ::: "memory");
            const size_t cb = ((size_t)(l * 2 + dir) * 16 + g) * 16 * 64;
            for (int s2 = 0; s2 < 64; ++s2) {
                const float xr = hs[(ti * 65 + s2) * 2], xi = hs[(ti * 65 + s2) * 2 + 1];
#pragma unroll
                for (int c = 0; c < 16; ++c) y[c] += p.c_re[cb + c * 64 + s2] * xr - p.c_im[cb + c * 64 + s2] * xi;
            }
            asm volatile("s_waitcnt lgkmcnt(0)" ::: "memory");
        }
        const bf16_t* up = p.P + (size_t)m * NP + DU + g * 16;
#pragma unroll
        for (int c = 0; c < 16; ++c) { const float v = y[c] + p.s5_d[l * 256 + g * 16 + c] * bf2f(up[c]); p.ys5[(size_t)m * 256 + g * 16 + c] = f2bf(gelu_tanh(v)); }
    }
}
}
constexpr int LDS_BYTES = 147456;
__device__ __forceinline__ void ph_inproj(const Params& p, int l, LAS unsigned char* lds, int G, int bx) {
    pg8::Gemm g{p.A, p.Win_t + (size_t)l * NP * D, MT, NP, D}; pg8::StaticOrder So; So.init(MT, NP, G, bx);
    pg8::EpiInProj E{p.P, p.tabA, p.tabB, p.qn_g + l * 64, p.kn_g + l * 64};
    pg8::gemm_phase<pg8::EpiInProj, pg8::StaticOrder, true, true>(lds, g, So, E);
}
__device__ __forceinline__ void ph_outproj(const Params& p, int l, LAS unsigned char* lds, int G, int bx) {
    const int M = l == NL - 1 ? MT : MT;
    pg8::Gemm g{p.A, p.Wout_t + (size_t)l * D * D, M, D, D}; pg8::StaticOrder So; So.init(M, D, G, bx);
    pg8::EpiOutProj E{p.xl, p.xc, p.mod + (size_t)l * 5 * 3 * D};
    pg8::gemm_phase<pg8::EpiOutProj, pg8::StaticOrder, true, true>(lds, g, So, E);
}
__device__ __forceinline__ void ph_glu(const Params& p, int l, LAS unsigned char* lds, int G, int bx) {
    pg8::Gemm g{p.ys5, p.Wglu_t + (size_t)l * 512 * 256, MT, 512, 256}; pg8::StaticOrder So; So.init(MT, 512, G, bx);
    pg8::EpiGlu E{p.A, p.P};
    pg8::gemm_phase<pg8::EpiGlu, pg8::StaticOrder, true, true>(lds, g, So, E);
}
struct Ctx { int tid, lane, wave, G, bx, gw, ngw, v; };
__device__ __forceinline__ Ctx make_ctx() {
    Ctx c; c.tid = opaque_v((int)threadIdx.x); c.lane = c.tid & 63; c.wave = __builtin_amdgcn_readfirstlane(c.tid >> 6);
    c.G = opaque_s((int)gridDim.x); c.bx = opaque_s((int)blockIdx.x); c.gw = c.bx * NWAVES + c.wave; c.ngw = c.G * NWAVES;
    c.v = (c.G % 8 == 0) ? (c.bx % 8) * (c.G / 8) + (c.bx / 8) : c.bx;
    return c;
}
#define GRID_SYNC() cg::this_grid().sync()
__global__ void __launch_bounds__(NTHR, 2) mega(KArgs ka) {
    extern __shared__ __attribute__((aligned(16))) unsigned char lds_raw[];
    LAS unsigned char* lds = (LAS unsigned char*)lds_raw;
    { const Params pp = make_params(ka, true);
      { const Ctx c = make_ctx(); phase_prologue(pp, ka, lds, c.gw, c.ngw, c.wave, c.lane); }
      GRID_SYNC();
      { const Ctx c = make_ctx(); phase_rows(pp, -1, 0, c.gw, c.ngw, c.lane); } }
    GRID_SYNC();
#pragma nounroll
    for (int l = 0; l < NL; ++l) {
        { const Ctx c = make_ctx(); const Params p = make_params(ka, false); ph_inproj(p, l, lds, c.G, c.bx); }
        GRID_SYNC();
        { const Ctx c = make_ctx(); const Params p = make_params(ka, false); att::attn_phase(p, l, lds, c.v, c.G); }
        { const Ctx c = make_ctx(); const Params p = make_params(ka, false); s5n::phase1(p, l, c.gw, c.ngw, c.lane); }
        GRID_SYNC();
        { const Ctx c = make_ctx(); const Params p = make_params(ka, false); s5n::phase2(p, l, c.gw, c.ngw, c.lane); }
        GRID_SYNC();
        { const Ctx c = make_ctx(); const Params p = make_params(ka, false); s5n::phase3(p, l, lds, c.bx, c.G, c.wave, c.lane); }
        GRID_SYNC();
        { const Ctx c = make_ctx(); const Params p = make_params(ka, false); ph_glu(p, l, lds, c.G, c.bx); }
        GRID_SYNC();
        { const Ctx c = make_ctx(); const Params p = make_params(ka, false); ph_outproj(p, l, lds, c.G, c.bx); }
        GRID_SYNC();
        { const Ctx c = make_ctx(); const Params p = make_params(ka, false); phase_rows(p, l, l + 1, c.gw, c.ngw, c.lane); }
        if (l + 1 < NL) GRID_SYNC();
    }
}

extern "C" void kernel_launch(void* const* d_in, const int* in_sizes, int n_in, void* d_out, int out_size, void* d_ws, size_t ws_size, hipStream_t stream) {
    static int grid = 0;
    if (grid == 0) {
        int dev = 0, cus = 0, per_cu = 0;
        (void)hipGetDevice(&dev); (void)hipDeviceGetAttribute(&cus, hipDeviceAttributeMultiprocessorCount, dev);
        (void)hipFuncSetAttribute((const void*)mega, hipFuncAttributeMaxDynamicSharedMemorySize, LDS_BYTES);
        if (hipOccupancyMaxActiveBlocksPerMultiprocessor(&per_cu, (const void*)mega, NTHR, LDS_BYTES) != hipSuccess || per_cu < 1) { per_cu = 1; (void)hipGetLastError(); }
        if (per_cu > 1) per_cu = 1;
        grid = (cus > 0 ? cus : 256) * per_cu;
    }
    KArgs ka{};
    for (int i = 0; i < 27; ++i) ka.in[i] = (const float*)d_in[i];
    ka.out = (float*)d_out; ka.ws = (unsigned char*)d_ws;
    if (O_END > ws_size) { fprintf(stderr, "kernel_launch: workspace too small: need %zu have %zu\n", (size_t)O_END, ws_size); return; }
    void* args[] = {&ka};
    hipError_t e = hipLaunchCooperativeKernel((const void*)mega, dim3(grid), dim3(NTHR), args, LDS_BYTES, stream);
    if (e != hipSuccess) fprintf(stderr, "cooperative launch failed: %s (grid %d)\n", hipGetErrorString(e), grid);
}
```

```cpp
#include <hip/hip_runtime.h>
#include <hip/hip_cooperative_groups.h>
#include <cstdint>
#include <cstdio>
#include <math.h>
namespace cg = cooperative_groups;

constexpr int D = 1024, NB = 4, S = 4096, NL = 4, GW = 64, CT = 256;
constexpr int T = S + CT;
constexpr int MT = NB * T;
constexpr int NP = 3328;
constexpr int AQ = 0, AK = 256, AV = 384, AG = 512, BQ = 768, BK = 1024, BV = 1280, BG = 1536, CQ = 1792, CK = 2048, CV = 2304, CG = 2560, DU = 2816, DG = 3072;
constexpr float RMS_EPS = 1e-6f, LN_EPS = 1e-5f;
constexpr float ALPHA = 1.681792830507429f;
constexpr float LOG2E = 1.4426950408889634f;
constexpr float C2A = 0.125f * LOG2E;
constexpr float C2B = 0.17677669529663687f * LOG2E;
constexpr int NCH = T / 64;
constexpr int NWAVES = 8, NTHR = 512;

typedef unsigned short bf16_t;
typedef float f32x4 __attribute__((ext_vector_type(4)));
typedef unsigned u32x4 __attribute__((ext_vector_type(4)));
typedef unsigned u32x2 __attribute__((ext_vector_type(2)));
#define LAS __attribute__((address_space(3)))
__device__ __forceinline__ float bf2f(bf16_t v) { return __uint_as_float(((unsigned)v) << 16); }
__device__ __forceinline__ unsigned f2bf_u(float f) { unsigned u = __float_as_uint(f); return (u + 0x7fffu + ((u >> 16) & 1u)) >> 16; }
__device__ __forceinline__ bf16_t f2bf(float f) { return (bf16_t)f2bf_u(f); }
__device__ __forceinline__ unsigned pk2(float lo, float hi) { return f2bf_u(lo) | (f2bf_u(hi) << 16); }
__device__ __forceinline__ float silu_f(float v) { return v / (1.f + __expf(-v)); }
__device__ __forceinline__ float sigm_f(float v) { return 1.f / (1.f + __expf(-v)); }
__device__ __forceinline__ float gelu_tanh(float v) { return 0.5f * v * (1.f + tanhf(0.7978845608028654f * (v + 0.044715f * v * v * v))); }

__device__ __forceinline__ int opaque_v(int x) { asm volatile("" : "+v"(x)); return x; }
__device__ __forceinline__ int opaque_s(int x) { asm volatile("" : "+s"(x)); return x; }
struct Params {
    const float *x, *c, *ctx, *c_ctx, *w_ada, *b_ada, *w_in, *w_out, *ln_g, *ln_b, *qn_g, *kn_g, *lq1, *lk1, *lq2, *lk2, *subln_g, *rpb;
    const float *a_re, *a_im, *log_dt, *b_re, *b_im, *c_re, *c_im, *s5_d, *w_glu;
    float* xl;
    float* xc;
    float* mod;
    float* tabA;
    float* tabB;
    bf16_t* Win_t;
    bf16_t* Wout_t;
    bf16_t* Wglu_t;
    bf16_t* A;
    bf16_t* P;
    bf16_t* ys5;
    float* Sbuf;
    bf16_t* Hinb;
    bf16_t* Ttab; bf16_t* Etab; bf16_t* Ftab; float* lam16; float* lampow;
    unsigned* ctl;
    float* disc;
};
struct KArgs { const float* in[27]; float* out; unsigned char* ws; };
constexpr size_t al256(size_t x) { return (x + 255) & ~(size_t)255; }
constexpr size_t O_CTL = 0, O_XC = O_CTL + (1 << 20), O_MOD = O_XC + al256((size_t)NB * CT * D * 4), O_TABA = O_MOD + al256((size_t)NL * 5 * 3 * D * 4), O_TABB = O_TABA + 8192,
    O_WIN = O_TABB + 4096, O_WOUT = O_WIN + al256((size_t)NL * NP * D * 2), O_WGLU = O_WOUT + al256((size_t)NL * D * D * 2), O_A = O_WGLU + al256((size_t)NL * 512 * 256 * 2),
    O_P = O_A + al256((size_t)MT * D * 2), O_YS5 = O_P + al256((size_t)MT * NP * 2), O_SBUF = O_YS5 + al256((size_t)MT * 256 * 2), O_HINB = O_SBUF + al256((size_t)NB * 16 * 272 * 256 * 4), O_TTAB = O_HINB + al256((size_t)NB * 16 * 272 * 256 * 2),
    O_ETAB = O_TTAB + al256((size_t)NL * 16 * 31 * 256 * 2), O_FTAB = O_ETAB + al256((size_t)NL * 16 * 2 * 128 * 256 * 2), O_LAM16 = O_FTAB + al256((size_t)NL * 16 * 2 * 256 * 128 * 2),
    O_LAMPOW = O_LAM16 + al256((size_t)NL * 2 * 16 * 64 * 2 * 4), O_SMALL = O_LAMPOW + al256((size_t)NL * 2 * 16 * 64 * 32 * 4);
constexpr int SM_N[18] = {NL * D, NL * D, NL * 64, NL * 64, NL * 32, NL * 32, NL * 32, NL * 32, NL * 64, NL * 4 * 15 * 31, NL * 2 * 16 * 64, NL * 2 * 16 * 64, NL * 2 * 16, NL * 2 * 16 * 64 * 16, NL * 2 * 16 * 64 * 16, NL * 2 * 16 * 16 * 64, NL * 2 * 16 * 16 * 64, NL * 256};
constexpr int sm_off(int i) { int o = 0; for (int k = 0; k < i; ++k) o += (SM_N[k] + 63) & ~63; return o; }
constexpr size_t O_DISC = O_SMALL + al256((size_t)sm_off(18) * 4);
constexpr size_t O_END = O_DISC + al256((size_t)NL * 2 * 16 * 64 * 34 * 4);
template <class Tp> __device__ __forceinline__ Tp* opaque_p(Tp* x) { asm volatile("" : "+s"(x)); return x; }
__device__ __forceinline__ Params make_params(const KArgs& ka, bool prologue) {
    Params p;
    const float** f = (const float**)&p;
    if (prologue) { for (int i = 0; i < 27; ++i) f[i] = ka.in[i]; }
    else {
        for (int i = 0; i < 27; ++i) f[i] = nullptr;
        const float* sm = (const float*)(opaque_p(ka.ws) + O_SMALL);
        p.ln_g = sm + sm_off(0); p.ln_b = sm + sm_off(1); p.qn_g = sm + sm_off(2); p.kn_g = sm + sm_off(3); p.lq1 = sm + sm_off(4); p.lk1 = sm + sm_off(5); p.lq2 = sm + sm_off(6); p.lk2 = sm + sm_off(7);
        p.subln_g = sm + sm_off(8); p.rpb = sm + sm_off(9); p.a_re = sm + sm_off(10); p.a_im = sm + sm_off(11); p.log_dt = sm + sm_off(12); p.b_re = sm + sm_off(13); p.b_im = sm + sm_off(14);
        p.c_re = sm + sm_off(15); p.c_im = sm + sm_off(16); p.s5_d = sm + sm_off(17);
    }
    unsigned char* ws = opaque_p(ka.ws);
    p.xl = opaque_p(ka.out); p.xc = (float*)(ws + O_XC); p.mod = (float*)(ws + O_MOD); p.tabA = (float*)(ws + O_TABA); p.tabB = (float*)(ws + O_TABB);
    p.Win_t = (bf16_t*)(ws + O_WIN); p.Wout_t = (bf16_t*)(ws + O_WOUT); p.Wglu_t = (bf16_t*)(ws + O_WGLU); p.A = (bf16_t*)(ws + O_A); p.P = (bf16_t*)(ws + O_P);
    p.ys5 = (bf16_t*)(ws + O_YS5); p.Sbuf = (float*)(ws + O_SBUF); p.Hinb = (bf16_t*)(ws + O_HINB); p.Ttab = (bf16_t*)(ws + O_TTAB); p.Etab = (bf16_t*)(ws + O_ETAB); p.Ftab = (bf16_t*)(ws + O_FTAB); p.lam16 = (float*)(ws + O_LAM16); p.lampow = (float*)(ws + O_LAMPOW); p.ctl = (unsigned*)(ws + O_CTL); p.disc = (float*)(ws + O_DISC);
    return p;
}
__device__ __forceinline__ float* xrow(const Params& p, int m) { const int b = m / T, t = m - b * T; return t < S ? p.xl + ((size_t)b * S + t) * D : p.xc + ((size_t)b * CT + (t - S)) * D; }
__device__ __forceinline__ int modrow(int m) { const int b = m / T, t = m - b * T; return t < S ? b : 4; }
namespace pg8 {
#define PG8_LAS __attribute__((address_space(3)))
typedef unsigned short bf16_t;
typedef short bf16x8 __attribute__((ext_vector_type(8)));
typedef float f32x4 __attribute__((ext_vector_type(4)));
typedef unsigned u32x4 __attribute__((ext_vector_type(4)));
constexpr int BM = 256, BK = 64, HALF = 128, HTB = HALF * BK * 2  , STAGE_BYTES = 8 * HTB, NXCD = 8, WGM = 8;

__host__ __device__ __forceinline__ int lds_byte(int r, int c) { const int st = (r >> 4) * 2 + (c >> 5), rr = r & 15, cc = c & 31, ob = rr * 64 + cc * 2; return st * 1024 + (ob ^ (((ob >> 9) & 1) << 5)); }
__host__ __device__ __forceinline__ void stage_rc(int b, int& R, int& C) { const int st = b / 1024, sb = b % 1024, swz = sb ^ (((sb >> 9) & 1) << 5); R = (st >> 1) * 16 + swz / 64; C = (st & 1) * 32 + (swz % 64) / 2; }
__host__ __device__ __forceinline__ int perm32(int rho) { const int n = rho >> 4, i = rho & 15; return 8 * (i >> 2) + 4 * n + (i & 3); }

struct Unit { int pm, pn; };
struct Gemm { const bf16_t* A; const bf16_t* Bt; int M, N, K; };

struct StaticOrder {
    int nM, nN, nwg, G, c;
    __host__ __device__ void init(int M, int N, int G_, int c_) { nM = M / BM; nN = N / BM; nwg = nM * nN; G = G_; c = c_; }
    __host__ __device__ bool next(int i, Unit& u) const {
        const long L = (long)i * G + c; if (L >= nwg) return false;
        int wgid = (int)L; { const int q = nwg / NXCD, r = nwg % NXCD, xcd = wgid % NXCD, off = wgid / NXCD; wgid = (xcd < r ? xcd * (q + 1) : r * (q + 1) + (xcd - r) * q) + off; }
        const int nig = WGM * nN, gid = wgid / nig, fm = gid * WGM, gsz = (nM - fm) < WGM ? (nM - fm) : WGM;
        u.pm = fm + ((wgid % nig) % gsz); u.pn = (wgid % nig) / gsz; return true;
    }
    __device__ __forceinline__ void a_ready(const Unit&) const {}
    __device__ __forceinline__ void done(const Unit&) const {}
};

__device__ __forceinline__ unsigned cvt_pk_bf16(float lo, float hi) { unsigned r; asm volatile("v_cvt_pk_bf16_f32 %0, %1, %2" : "=v"(r) : "v"(lo), "v"(hi)); return r; }
typedef float f32x2 __attribute__((ext_vector_type(2)));
template <class Epi, class Sched, bool ALIGN_EPI = false, bool SP2 = false>
__device__ __forceinline__ void gemm_phase(PG8_LAS unsigned char* lds, const Gemm g, const Sched& S, const Epi& E) {
    const int tid = opaque_v((int)threadIdx.x), wid = __builtin_amdgcn_readfirstlane(tid >> 6), lane = tid & 63, wr = wid >> 2, wc = wid & 3, fr = lane & 15, fq = lane >> 4;
    const int K = g.K, nt = K / BK;
    unsigned voffA[2], voffB[2];
#pragma unroll
    for (int i = 0; i < 2; ++i) { int R, C; stage_rc(tid * 16 + i * 8192, R, C); const int Rb = Epi::PERM ? ((R & ~31) + perm32(R & 31)) : R;
        voffA[i] = (unsigned)(R * K + C) * 2u; voffB[i] = (unsigned)(Rb * K + C) * 2u; }
    const size_t kstep = (size_t)(BK * 2);
    const size_t hstep = (size_t)HALF * K * 2;
    const size_t tstep = 2 * hstep;
    const unsigned ldsw = (unsigned)wid * 1024u;
    const int aoff = lds_byte(wr * 64 + fr, fq * 8), boff = lds_byte(wc * 32 + fr, fq * 8);
#define PG8_SA(b, h) (((b) * 2 + (h)) * HTB)
#define PG8_SB(b, h) ((4 + (b) * 2 + (h)) * HTB)
#define PG8_STAGE(bufoff, gbase, voff) do { _Pragma("unroll") for (int _i = 0; _i < 2; ++_i) \
        __builtin_amdgcn_global_load_lds((const unsigned*)((const char*)(gbase) + (voff)[_i]), (PG8_LAS unsigned*)(lds + (bufoff) + ldsw + _i * 8192), 16, 0, 0); } while (0)
#define PG8_LDA(dst, b, h) do { _Pragma("unroll") for (int m = 0; m < 4; ++m) _Pragma("unroll") for (int k = 0; k < 2; ++k) dst[m][k] = *(const PG8_LAS bf16x8*)(lds + PG8_SA(b, h) + aoff + m * 2048 + k * 1024); } while (0)
#define PG8_LDB(dst, b, h) do { _Pragma("unroll") for (int n = 0; n < 2; ++n) _Pragma("unroll") for (int k = 0; k < 2; ++k) dst[n][k] = *(const PG8_LAS bf16x8*)(lds + PG8_SB(b, h) + boff + n * 2048 + k * 1024); } while (0)
#define PG8_MMA(ai, bj, At, Bt) do { __builtin_amdgcn_s_setprio(1); _Pragma("unroll") for (int m = 0; m < 4; ++m) _Pragma("unroll") for (int n = 0; n < 2; ++n) _Pragma("unroll") for (int k = 0; k < 2; ++k) \
        acc[ai][bj][m][n] = __builtin_amdgcn_mfma_f32_16x16x32_bf16(Bt[n][k], At[m][k], acc[ai][bj][m][n], 0, 0, 0); __builtin_amdgcn_s_setprio(0); } while (0)
#define PG8_WAIT_V(n) asm volatile("s_waitcnt vmcnt(" #n ")" ::: "memory")
#define PG8_WAIT_L(n) asm volatile("s_waitcnt lgkmcnt(" #n ")" ::: "memory")
#define PG8_BAR __builtin_amdgcn_s_barrier()
#define PG8_SCHED __builtin_amdgcn_sched_barrier(0)
    Unit cur, nxt; int ui = 0;
    if (!S.next(0, cur)) return;
    f32x4 acc[2][2][4][2];
#pragma unroll
    for (int a = 0; a < 2; ++a)
#pragma unroll
        for (int b = 0; b < 2; ++b)
#pragma unroll
            for (int m = 0; m < 4; ++m)
#pragma unroll
                for (int n = 0; n < 2; ++n) acc[a][b][m][n] = (f32x4){0.f, 0.f, 0.f, 0.f};
    bf16x8 At[4][2], B0[2][2], B1[2][2];
    const char* cA = (const char*)g.A + (size_t)cur.pm * tstep; const char* cB = (const char*)g.Bt + (size_t)cur.pn * tstep;
    S.a_ready(cur);
    if constexpr (SP2) {
        PG8_STAGE(PG8_SB(0, 0), cB, voffB); PG8_STAGE(PG8_SB(0, 1), cB + hstep, voffB); PG8_STAGE(PG8_SA(0, 0), cA, voffA); PG8_STAGE(PG8_SA(0, 1), cA + hstep, voffA);
        if (wr == 1) PG8_BAR;
        PG8_WAIT_V(2); PG8_BAR;
        PG8_STAGE(PG8_SB(1, 0), cB + kstep, voffB); PG8_STAGE(PG8_SA(1, 0), cA + kstep, voffA); PG8_STAGE(PG8_SB(1, 1), cB + hstep + kstep, voffB);
        PG8_WAIT_V(6); PG8_BAR;
    } else {
        PG8_STAGE(PG8_SB(0, 0), cB, voffB); PG8_STAGE(PG8_SA(0, 0), cA, voffA); PG8_STAGE(PG8_SB(0, 1), cB + hstep, voffB); PG8_STAGE(PG8_SA(0, 1), cA + hstep, voffA);
        if (wr == 1) PG8_BAR;
        PG8_WAIT_V(4); PG8_BAR;
        PG8_STAGE(PG8_SB(1, 0), cB + kstep, voffB); PG8_STAGE(PG8_SA(1, 0), cA + kstep, voffA); PG8_STAGE(PG8_SB(1, 1), cB + hstep + kstep, voffB);
        PG8_WAIT_V(6); PG8_BAR;
    }
    for (;;) {
        const bool has_next = S.next(ui + 1, nxt);
        const char* nA = has_next ? (const char*)g.A + (size_t)nxt.pm * tstep : cA; const char* nB = has_next ? (const char*)g.Bt + (size_t)nxt.pn * tstep : cB;
        for (int t = 0; t < nt; t += 2) {
            const bool last = (t == nt - 2);
            const char* a1 = cA + (size_t)(t + 1) * kstep;
            const char* a2 = last ? nA : cA + (size_t)(t + 2) * kstep; const char* b2 = last ? nB : cB + (size_t)(t + 2) * kstep;
            const char* a3 = a2 + kstep; const char* b3 = b2 + kstep;
            if (last && has_next) S.a_ready(nxt);
            if constexpr (SP2) {
            PG8_LDB(B0, 0, 0); PG8_LDB(B1, 0, 1); PG8_SCHED; PG8_LDA(At, 0, 0); PG8_STAGE(PG8_SA(1, 1), a1 + hstep, voffA);
            PG8_WAIT_V(8); PG8_WAIT_L(0); PG8_BAR; PG8_MMA(0, 0, At, B0); PG8_MMA(0, 1, At, B1); PG8_BAR; PG8_SCHED;
            PG8_LDA(At, 0, 1); PG8_STAGE(PG8_SB(0, 0), b2, voffB); PG8_STAGE(PG8_SB(0, 1), b2 + hstep, voffB); PG8_STAGE(PG8_SA(0, 0), a2, voffA);
            PG8_WAIT_V(8); PG8_WAIT_L(0); PG8_BAR; PG8_MMA(1, 0, At, B0); PG8_MMA(1, 1, At, B1); PG8_BAR; PG8_SCHED;
            PG8_LDB(B0, 1, 0); PG8_LDB(B1, 1, 1); PG8_SCHED; PG8_LDA(At, 1, 0); PG8_STAGE(PG8_SA(0, 1), a2 + hstep, voffA);
            PG8_WAIT_V(8); PG8_WAIT_L(0); PG8_BAR; PG8_MMA(0, 0, At, B0); PG8_MMA(0, 1, At, B1); PG8_BAR; PG8_SCHED;
            PG8_LDA(At, 1, 1); PG8_STAGE(PG8_SB(1, 0), b3, voffB); PG8_STAGE(PG8_SB(1, 1), b3 + hstep, voffB); PG8_STAGE(PG8_SA(1, 0), a3, voffA);
            PG8_WAIT_V(8); PG8_WAIT_L(0); PG8_BAR; PG8_MMA(1, 0, At, B0); PG8_MMA(1, 1, At, B1); PG8_BAR; PG8_SCHED;
            } else {
            PG8_LDB(B0, 0, 0); PG8_SCHED; PG8_LDA(At, 0, 0); PG8_STAGE(PG8_SA(1, 1), a1 + hstep, voffA);
            PG8_WAIT_L(8); PG8_BAR; PG8_WAIT_L(0); PG8_MMA(0, 0, At, B0); PG8_BAR; PG8_SCHED;
            PG8_LDB(B1, 0, 1); PG8_STAGE(PG8_SB(0, 0), b2, voffB);
            PG8_BAR; PG8_WAIT_L(0); PG8_MMA(0, 1, At, B1); PG8_BAR;
            PG8_LDA(At, 0, 1); PG8_STAGE(PG8_SA(0, 0), a2, voffA);
            PG8_BAR; PG8_WAIT_L(0); PG8_MMA(1, 0, At, B0); PG8_BAR; PG8_SCHED;
            PG8_STAGE(PG8_SB(0, 1), b2 + hstep, voffB);
            PG8_WAIT_V(6); PG8_BAR; PG8_MMA(1, 1, At, B1); PG8_BAR;
            PG8_LDB(B0, 1, 0); PG8_SCHED; PG8_LDA(At, 1, 0); PG8_STAGE(PG8_SA(0, 1), a2 + hstep, voffA);
            PG8_WAIT_L(8); PG8_BAR; PG8_WAIT_L(0); PG8_MMA(0, 0, At, B0); PG8_BAR; PG8_SCHED;
            PG8_LDB(B1, 1, 1); PG8_STAGE(PG8_SB(1, 0), b3, voffB);
            PG8_BAR; PG8_WAIT_L(0); PG8_MMA(0, 1, At, B1); PG8_BAR;
            PG8_LDA(At, 1, 1); PG8_STAGE(PG8_SA(1, 0), a3, voffA);
            PG8_BAR; PG8_WAIT_L(0); PG8_MMA(1, 0, At, B0); PG8_BAR; PG8_SCHED;
            PG8_STAGE(PG8_SB(1, 1), b3 + hstep, voffB);
            PG8_WAIT_V(6); PG8_BAR; PG8_MMA(1, 1, At, B1); PG8_BAR;
            }
        }
        if constexpr (ALIGN_EPI) { if (wr == 0) PG8_BAR; }
        if constexpr (!Epi::AFTER_DRAIN) { E(acc, cur, wr, wc, fr, fq); S.done(cur); }
        if (!has_next) break;
#pragma unroll
        for (int a = 0; a < 2; ++a)
#pragma unroll
            for (int b = 0; b < 2; ++b)
#pragma unroll
                for (int m = 0; m < 4; ++m)
#pragma unroll
                    for (int n = 0; n < 2; ++n) acc[a][b][m][n] = (f32x4){0.f, 0.f, 0.f, 0.f};
        cur = nxt; cA = nA; cB = nB; ++ui;
        if constexpr (ALIGN_EPI) { if (wr == 1) PG8_BAR; }
    }
    PG8_WAIT_V(0);
    if constexpr (!ALIGN_EPI) { if (wr == 0) PG8_BAR; }
    PG8_BAR;
    if constexpr (Epi::AFTER_DRAIN) { E.fused(acc, cur, wr, wc, fr, fq, lds, wid, lane); S.done(cur); }
#undef PG8_SA
#undef PG8_SB
#undef PG8_STAGE
#undef PG8_LDA
#undef PG8_LDB
#undef PG8_MMA
#undef PG8_WAIT_V
#undef PG8_WAIT_L
#undef PG8_BAR
#undef PG8_SCHED
}
}
namespace pg8 {
struct EpiInProj {
    static constexpr bool PERM = true, AFTER_DRAIN = false;
    ::bf16_t* P; const float* tabA; const float* tabB; const float* qn_g; const float* kn_g;
    __device__ __forceinline__ void operator()(const f32x4 (&acc)[2][2][4][2], const Unit& u, int wr_, int wc_, int fr_, int fq_) const {
        const int fr = opaque_v(fr_), fq = opaque_v(fq_), wr = opaque_s(wr_), wc = opaque_s(wc_);
        const int pn = u.pn, m0 = u.pm * BM; const int t0 = m0 % T; const bool lat = t0 < S;
        int type = 0; float qs = 1.f; const float* g = nullptr;
        if (pn == 0) { type = 3; qs = C2A; g = qn_g; }
        else if (pn == 1) { if (wc < 2) { type = 3; g = kn_g; } }
        else if (pn == 2 || pn == 6 || pn == 10 || pn == 12) type = 1;
        else if (pn == 3) { type = 4; qs = C2B; }
        else if (pn == 4) type = 4;
        else if (pn == 7) { type = 2; qs = C2A; }
        ::bf16_t* base = P + (size_t)(m0 + wr * 64 + fr) * NP + 256 * pn + 64 * wc + 8 * fq;
        f32x4 gv[2][2];
        if (type == 3) {
#pragma unroll
            for (int bj = 0; bj < 2; ++bj)
#pragma unroll
                for (int n = 0; n < 2; ++n) gv[bj][n] = *(const f32x4*)(g + 32 * bj + 16 * n + 4 * fq);
        }
#pragma unroll
        for (int ai = 0; ai < 2; ++ai) {
            const int prow = (t0 >> 6) + 2 * ai + wr;
#pragma unroll
            for (int m = 0; m < 4; ++m) {
                f32x4 v[2][2];
#pragma unroll
                for (int bj = 0; bj < 2; ++bj)
#pragma unroll
                    for (int n = 0; n < 2; ++n) v[bj][n] = acc[ai][bj][m][n];
                const int pcol = 16 * m + fr;
                if (type == 1) {
#pragma unroll
                    for (int bj = 0; bj < 2; ++bj)
#pragma unroll
                        for (int n = 0; n < 2; ++n)
#pragma unroll
                            for (int e = 0; e < 4; ++e) v[bj][n][e] = silu_f(v[bj][n][e]);
                } else if (type == 2) {
#pragma unroll
                    for (int bj = 0; bj < 2; ++bj)
#pragma unroll
                        for (int n = 0; n < 2; ++n) v[bj][n] = v[bj][n] * qs;
                } else if (type == 3) {
                    float ss = 0.f;
#pragma unroll
                    for (int bj = 0; bj < 2; ++bj)
#pragma unroll
                        for (int n = 0; n < 2; ++n) ss += (v[bj][n][0] * v[bj][n][0] + v[bj][n][1] * v[bj][n][1]) + (v[bj][n][2] * v[bj][n][2] + v[bj][n][3] * v[bj][n][3]);
                    ss += __shfl_xor(ss, 16); ss += __shfl_xor(ss, 32);
                    const float rs = rsqrtf(ss * (1.f / 64.f) + RMS_EPS);
#pragma unroll
                    for (int bj = 0; bj < 2; ++bj)
#pragma unroll
                        for (int n = 0; n < 2; ++n) v[bj][n] = v[bj][n] * rs * gv[bj][n];
                    if (lat) {
#pragma unroll
                        for (int bj = 0; bj < 2; ++bj) {
                            const int pos = bj == 0 ? prow : pcol;
                            const f32x4 t0v = *(const f32x4*)(tabA + (pos * 16 + 4 * fq) * 2), t1v = *(const f32x4*)(tabA + (pos * 16 + 4 * fq) * 2 + 4);
                            const float cs[4] = {t0v[0], t0v[2], t1v[0], t1v[2]}, sn[4] = {t0v[1], t0v[3], t1v[1], t1v[3]};
#pragma unroll
                            for (int e = 0; e < 4; ++e) { const float x1 = v[bj][0][e], x2 = v[bj][1][e]; v[bj][0][e] = x1 * cs[e] - x2 * sn[e]; v[bj][1][e] = x1 * sn[e] + x2 * cs[e]; }
                        }
                    }
                    if (qs != 1.f) {
#pragma unroll
                        for (int bj = 0; bj < 2; ++bj)
#pragma unroll
                            for (int n = 0; n < 2; ++n) v[bj][n] = v[bj][n] * qs;
                    }
                } else if (type == 4) {
                    if (lat) {
                        const int pos = (fq >> 1) == 0 ? prow : pcol;
                        const f32x4 t0v = *(const f32x4*)(tabB + (pos * 8 + 4 * (fq & 1)) * 2), t1v = *(const f32x4*)(tabB + (pos * 8 + 4 * (fq & 1)) * 2 + 4);
                        const float cs[4] = {t0v[0], t0v[2], t1v[0], t1v[2]}, sn[4] = {t0v[1], t0v[3], t1v[1], t1v[3]};
#pragma unroll
                        for (int bj = 0; bj < 2; ++bj)
#pragma unroll
                            for (int e = 0; e < 4; ++e) { const float x1 = v[bj][0][e], x2 = v[bj][1][e]; v[bj][0][e] = x1 * cs[e] - x2 * sn[e]; v[bj][1][e] = x1 * sn[e] + x2 * cs[e]; }
                    }
                    if (qs != 1.f) {
#pragma unroll
                        for (int bj = 0; bj < 2; ++bj)
#pragma unroll
                            for (int n = 0; n < 2; ++n) v[bj][n] = v[bj][n] * qs;
                    }
                }
                ::bf16_t* rowp = base + (size_t)(ai * HALF + m * 16) * NP;
#pragma unroll
                for (int bj = 0; bj < 2; ++bj) {
                    u32x4 w; w.x = cvt_pk_bf16(v[bj][0][0], v[bj][0][1]); w.y = cvt_pk_bf16(v[bj][0][2], v[bj][0][3]); w.z = cvt_pk_bf16(v[bj][1][0], v[bj][1][1]); w.w = cvt_pk_bf16(v[bj][1][2], v[bj][1][3]);
                    *(u32x4*)(rowp + 32 * bj) = w;
                }
            }
        }
    }
};
struct EpiOutProj {
    static constexpr bool PERM = false, AFTER_DRAIN = false;
    float* xl; float* xc; const float* mod_l;
    __device__ __forceinline__ void operator()(const f32x4 (&acc)[2][2][4][2], const Unit& u, int wr_, int wc_, int fr_, int fq_) const {
        const int fr = opaque_v(fr_), fq = opaque_v(fq_), wr = opaque_s(wr_), wc = opaque_s(wc_);
        const int m0 = u.pm * BM; const int b = m0 / T, t0 = m0 - b * T;
        float* xb = t0 < S ? xl + ((size_t)b * S + t0) * D : xc + ((size_t)b * CT + (t0 - S)) * D;
        const float* gate = mod_l + (size_t)(t0 < S ? b : 4) * 3 * D + 2 * D;
        const int col0 = u.pn * BM + wc * 32 + 4 * fq;
        f32x4 gv[2][2];
#pragma unroll
        for (int bj = 0; bj < 2; ++bj)
#pragma unroll
            for (int n = 0; n < 2; ++n) gv[bj][n] = *(const f32x4*)(gate + col0 + bj * HALF + n * 16);
#pragma unroll
        for (int ai = 0; ai < 2; ++ai)
#pragma unroll
            for (int m = 0; m < 4; ++m) {
                float* xr = xb + (size_t)(ai * HALF + wr * 64 + m * 16 + fr) * D + col0;
#pragma unroll
                for (int bj = 0; bj < 2; ++bj)
#pragma unroll
                    for (int n = 0; n < 2; ++n) { const f32x4 xv = *(const f32x4*)(xr + bj * HALF + n * 16); *(f32x4*)(xr + bj * HALF + n * 16) = xv * ALPHA + gv[bj][n] * acc[ai][bj][m][n]; }
            }
    }
};
struct EpiGlu {
    static constexpr bool PERM = true, AFTER_DRAIN = false;
    ::bf16_t* Y; const ::bf16_t* P;
    __device__ __forceinline__ void operator()(const f32x4 (&acc)[2][2][4][2], const Unit& u, int wr_, int wc_, int fr_, int fq_) const {
        const int fr = opaque_v(fr_), fq = opaque_v(fq_), wr = opaque_s(wr_), wc = opaque_s(wc_);
        const int m0 = u.pm * BM, col8 = 128 * u.pn + 32 * wc + 8 * fq;
#pragma unroll
        for (int ai = 0; ai < 2; ++ai)
#pragma unroll
            for (int m = 0; m < 4; ++m) {
                const size_t row = (size_t)(m0 + ai * HALF + wr * 64 + m * 16 + fr);
                const u32x4 gt = *(const u32x4*)(P + row * NP + DG + col8);
                float o[8];
#pragma unroll
                for (int n = 0; n < 2; ++n)
#pragma unroll
                    for (int e = 0; e < 4; ++e) { const float v = acc[ai][0][m][n][e], g = acc[ai][1][m][n][e]; o[4 * n + e] = v * sigm_f(g); }
                u32x4 w;
#pragma unroll
                for (int e = 0; e < 4; ++e) { const float ga = __uint_as_float(gt[e] << 16), gb = __uint_as_float(gt[e] & 0xffff0000u); w[e] = cvt_pk_bf16(o[2 * e] * ga, o[2 * e + 1] * gb); }
                *(u32x4*)(Y + row * D + 768 + col8) = w;
            }
    }
};
}
__device__ __forceinline__ float wave_sum(float v) {
#pragma unroll
    for (int o = 1; o < 64; o <<= 1) v += __shfl_xor(v, o);
    return v;
}
__device__ __forceinline__ void transpose_item(const float* W, int K, int N, bf16_t* WT, int kb, int nphys0, int lbase, int pt, LAS float* scr, int lane) {
    const int k0 = 64 * kb;
#pragma unroll 8
    for (int i = 0; i < 32; ++i) { const int kk = 2 * i + (lane >> 5); scr[kk * 33 + (lane & 31)] = W[(size_t)(k0 + kk) * N + lbase + (lane & 31)]; }
    asm volatile("s_waitcnt lgkmcnt(0)" ::: "memory");
    const int c = lane & 7;
#pragma unroll
    for (int j = 0; j < 4; ++j) {
        const int n = (lane >> 3) + 8 * j; const int fq = n >> 3, nn = (n >> 2) & 1, e = n & 3;
        const int lo = pt == 0 ? n : pt == 1 ? 16 * nn + 4 * fq + e : 16 * (fq >> 1) + 8 * nn + 4 * (fq & 1) + e;
        const LAS float* s = scr + (8 * c) * 33 + lo;
        u32x4 o; o.x = pk2(s[0 * 33], s[1 * 33]); o.y = pk2(s[2 * 33], s[3 * 33]); o.z = pk2(s[4 * 33], s[5 * 33]); o.w = pk2(s[6 * 33], s[7 * 33]);
        *(u32x4*)(WT + (size_t)(nphys0 + n) * K + k0 + 8 * c) = o;
    }
    asm volatile("s_waitcnt lgkmcnt(0)" ::: "memory");
}
__device__ __forceinline__ void phase_prologue(const Params& p, const KArgs& ka, LAS unsigned char* lds, int gw, int ngw, int wave, int lane) {
    {
        float* sm = (float*)(ka.ws + O_SMALL);
#pragma unroll
        for (int i = 0; i < 18; ++i) { const float* src = ka.in[8 + i]; float* dst = sm + sm_off(i); for (int e = gw * 64 + lane; e < SM_N[i]; e += ngw * 64) dst[e] = src[e]; }
    }
    LAS float* sc5 = (LAS float*)lds;
    LAS float* scr = (LAS float*)(lds + 20480 + wave * 9216);
    for (int i = threadIdx.x; i < 5 * D; i += NTHR) { const float v = i < 4 * D ? p.c[i] : p.c_ctx[i - 4 * D]; sc5[i] = v / (1.f + expf(-v)); }
    __syncthreads();
    for (int it = gw; it < NL * 48; it += ngw) {
        const int l = it / 48, j = (it % 48) * 64 + lane;
        const float* w = p.w_ada + (size_t)l * D * 3 * D + j;
        float a0 = 0.f, a1 = 0.f, a2 = 0.f, a3 = 0.f, a4 = 0.f;
#pragma unroll 8
        for (int k = 0; k < D; ++k) { const float wv = w[(size_t)k * 3 * D]; a0 += sc5[k] * wv; a1 += sc5[D + k] * wv; a2 += sc5[2 * D + k] * wv; a3 += sc5[3 * D + k] * wv; a4 += sc5[4 * D + k] * wv; }
        const float bb = p.b_ada[l * 3 * D + j]; float* o = p.mod + (size_t)l * 5 * 3 * D + j;
        o[0] = a0 + bb; o[3 * D] = a1 + bb; o[6 * D] = a2 + bb; o[9 * D] = a3 + bb; o[12 * D] = a4 + bb;
    }
    for (int i = gw * 64 + lane; i < 64 * 16 + 64 * 8; i += ngw * 64) {
        if (i < 1024) { const int pos = i >> 4, k = i & 15; const float an = (float)pos * powf(10000.f, -(float)k / 16.f); p.tabA[2 * i] = cosf(an); p.tabA[2 * i + 1] = sinf(an); }
        else { const int j = i - 1024, pos = j >> 3, k = j & 7; const float an = (float)pos * powf(10000.f, -(float)k / 8.f); p.tabB[2 * j] = cosf(an); p.tabB[2 * j + 1] = sinf(an); }
    }
    constexpr int I_IN = 16 * 104, I_OUT = 16 * 32, I_GLU = 4 * 16, I_L = I_IN + I_OUT + I_GLU;
    for (int it = gw; it < NL * I_L; it += ngw) {
        const int l = it / I_L; int r = it % I_L;
        if (r < I_IN) {
            const int kb = r / 104, nb = r % 104, c = 32 * nb, pn = c >> 8, bj = (c >> 7) & 1, wc = (c >> 5) & 3;
            const int pt = (pn == 0 || (pn == 1 && wc < 2)) ? 1 : (pn == 3 || pn == 4) ? 2 : 0;
            transpose_item(p.w_in + (size_t)l * D * NP, D, NP, p.Win_t + (size_t)l * NP * D, kb, c, 256 * pn + 64 * wc + 32 * bj, pt, scr, lane);
        } else if ((r -= I_IN) < I_OUT) {
            const int kb = r / 32, nb = r % 32;
            transpose_item(p.w_out + (size_t)l * D * D, D, D, p.Wout_t + (size_t)l * D * D, kb, 32 * nb, 32 * nb, 0, scr, lane);
        } else {
            r -= I_OUT; const int kb = r / 16, nb = r % 16, c = 32 * nb, pn = c >> 8, bj = (c >> 7) & 1, wc = (c >> 5) & 3;
            transpose_item(p.w_glu + (size_t)l * 256 * 512, 256, 512, p.Wglu_t + (size_t)l * 512 * 256, kb, c, 256 * bj + 128 * pn + 32 * wc, 0, scr, lane);
        }
    }
}
__device__ __forceinline__ void phase_rows(const Params& p, int l_prev, int l_next, int gw, int ngw, int lane) {
    for (int m = gw; m < MT; m += ngw) {
        const int b = m / T, t = m - b * T; const bool lat = t < S;
        if (l_next == NL && !lat) continue;
        float* xr = lat ? p.xl + ((size_t)b * S + t) * D : p.xc + ((size_t)b * CT + (t - S)) * D;
        f32x4 v[4];
        if (l_prev < 0) {
            const float* src = lat ? p.x + ((size_t)b * S + t) * D : p.ctx + ((size_t)b * CT + (t - S)) * D;
#pragma unroll
            for (int j = 0; j < 4; ++j) { v[j] = *(const f32x4*)(src + 4 * lane + 256 * j); *(f32x4*)(xr + 4 * lane + 256 * j) = v[j]; }
        } else {
            float s = 0.f;
#pragma unroll
            for (int j = 0; j < 4; ++j) { v[j] = *(const f32x4*)(xr + 4 * lane + 256 * j); s += (v[j][0] + v[j][1]) + (v[j][2] + v[j][3]); }
            const float mean = wave_sum(s) * (1.f / D); float q = 0.f;
#pragma unroll
            for (int j = 0; j < 4; ++j) { v[j] = v[j] - mean; q += (v[j][0] * v[j][0] + v[j][1] * v[j][1]) + (v[j][2] * v[j][2] + v[j][3] * v[j][3]); }
            const float rstd = rsqrtf(wave_sum(q) * (1.f / D) + LN_EPS);
#pragma unroll
            for (int j = 0; j < 4; ++j) {
                const f32x4 g = *(const f32x4*)(p.ln_g + l_prev * D + 4 * lane + 256 * j), be = *(const f32x4*)(p.ln_b + l_prev * D + 4 * lane + 256 * j);
                v[j] = v[j] * rstd * g + be; *(f32x4*)(xr + 4 * lane + 256 * j) = v[j];
            }
        }
        if (l_next < NL) {
            const float* md = p.mod + ((size_t)l_next * 5 + (lat ? b : 4)) * 3 * D;
            bf16_t* ar = p.A + (size_t)m * D;
#pragma unroll
            for (int j = 0; j < 4; ++j) {
                const f32x4 sh = *(const f32x4*)(md + 4 * lane + 256 * j), sc = *(const f32x4*)(md + D + 4 * lane + 256 * j);
                const f32x4 h = v[j] * (sc + 1.f) + sh;
                u32x2 w; w.x = pk2(h[0], h[1]); w.y = pk2(h[2], h[3]); *(u32x2*)(ar + 4 * lane + 256 * j) = w;
            }
        }
    }
}
namespace att {
typedef short bf16x8 __attribute__((ext_vector_type(8)));
typedef short s16x4 __attribute__((ext_vector_type(4)));
typedef float f32x16 __attribute__((ext_vector_type(16)));
typedef float f32x2_t __attribute__((ext_vector_type(2)));
typedef __bf16 bf16x2_t __attribute__((ext_vector_type(2)));
constexpr int SLOT = 16384, L_RING = 0, L_OST = 49152, L_WSF = L_OST + 8 * 8192, L_RPB = L_WSF + 8 * 256, L_END = L_RPB + 2048;
constexpr float THR = 6.f;
#define ATT_MFMA(a, b, c) __builtin_amdgcn_mfma_f32_32x32x16_bf16(a, b, c, 0, 0, 0)
#define ATT_WAIT_BAR(N) asm volatile("s_waitcnt vmcnt(" #N ") lgkmcnt(0)\n\ts_barrier" ::: "memory")
__device__ __forceinline__ int crow(int r, int hi) { return (r & 3) + 8 * (r >> 2) + 4 * hi; }
__device__ __forceinline__ unsigned cvtpk(float lo, float hi) { f32x2_t v = {lo, hi}; bf16x2_t b = __builtin_convertvector(v, bf16x2_t); return __builtin_bit_cast(unsigned, b); }
__device__ __forceinline__ void glds16(const void* g, unsigned lds_base) {
    unsigned sv; asm volatile("s_mov_b32 %0, m0\n\ts_mov_b32 m0, %2\n\ts_nop 0\n\tglobal_load_lds_dwordx4 %1, off\n\ts_mov_b32 m0, %0" : "=&s"(sv) : "v"(g), "s"(lds_base) : "memory"); }
#define ATT_MX3(a, b, c) __builtin_fmaxf(__builtin_fmaxf((a), (b)), (c))
__device__ __forceinline__ float rowmax(const f32x16& p0, const f32x16& p1) {
    float a = ATT_MX3(p0[0], p0[1], p1[0]), b = ATT_MX3(p0[2], p0[3], p1[1]); a = ATT_MX3(a, p1[2], p1[3]);
#pragma unroll
    for (int r = 4; r < 16; r += 4) { a = ATT_MX3(a, p0[r], p0[r + 1]); b = ATT_MX3(b, p0[r + 2], p0[r + 3]); a = ATT_MX3(a, p1[r], p1[r + 1]); b = ATT_MX3(b, p1[r + 2], p1[r + 3]); }
    float m = __builtin_fmaxf(a, b); auto rr = __builtin_amdgcn_permlane32_swap(__float_as_uint(m), __float_as_uint(m), false, false);
    return __builtin_fmaxf(__uint_as_float(rr[0]), __uint_as_float(rr[1])); }
__device__ __forceinline__ float rowsum(const f32x16& p0, const f32x16& p1) {
    float a = 0.f, b = 0.f;
#pragma unroll
    for (int r = 0; r < 16; r += 2) { a += p0[r] + p1[r]; b += p0[r + 1] + p1[r + 1]; }
    return a + b; }
__device__ __forceinline__ void vfrags(bf16x8 (&vf)[4], int vb, int d0) {
    s16x4 lo[4], hi[4];
    if (d0 == 0) {
#pragma unroll
        for (int ks = 0; ks < 4; ++ks) {
            asm volatile("ds_read_b64_tr_b16 %0,%1 offset:%c2" : "=&v"(lo[ks]) : "v"(vb), "i"(ks * 1024) : "memory");
            asm volatile("ds_read_b64_tr_b16 %0,%1 offset:%c2" : "=&v"(hi[ks]) : "v"(vb), "i"(ks * 1024 + 512) : "memory"); }
    } else {
#pragma unroll
        for (int ks = 0; ks < 4; ++ks) {
            asm volatile("ds_read_b64_tr_b16 %0,%1 offset:%c2" : "=&v"(lo[ks]) : "v"(vb), "i"(4096 + ks * 1024) : "memory");
            asm volatile("ds_read_b64_tr_b16 %0,%1 offset:%c2" : "=&v"(hi[ks]) : "v"(vb), "i"(4096 + ks * 1024 + 512) : "memory"); }
    }
    asm volatile("s_waitcnt lgkmcnt(0)" : "+v"(lo[0]), "+v"(lo[1]), "+v"(lo[2]), "+v"(lo[3]), "+v"(hi[0]), "+v"(hi[1]), "+v"(hi[2]), "+v"(hi[3]) :: "memory");
#pragma unroll
    for (int ks = 0; ks < 4; ++ks) vf[ks] = (bf16x8){lo[ks][0], lo[ks][1], lo[ks][2], lo[ks][3], hi[ks][0], hi[ks][1], hi[ks][2], hi[ks][3]};
}
struct PW { u32x4 w[4]; };
__device__ __forceinline__ void packp(PW& pw, const f32x16& p0, const f32x16& p1) {
#pragma unroll
    for (int i = 0; i < 4; ++i) { pw.w[0][i] = cvtpk(p0[2 * i], p0[2 * i + 1]); pw.w[1][i] = cvtpk(p0[8 + 2 * i], p0[9 + 2 * i]); pw.w[2][i] = cvtpk(p1[2 * i], p1[2 * i + 1]); pw.w[3][i] = cvtpk(p1[8 + 2 * i], p1[9 + 2 * i]); }
}
__device__ __forceinline__ bool softmax_tile(f32x16& p0, f32x16& p1, float& mhat, float& l_reg, float& f, bool first) {
    const float rm = rowmax(p0, p1);
    bool resc = false; f = 1.f;
    if (first || __any(rm > THR)) {
        const float dl = first ? rm : __builtin_fmaxf(rm, 0.f); mhat += dl;
#pragma unroll
        for (int r = 0; r < 16; ++r) { p0[r] -= dl; p1[r] -= dl; }
        if (!first) { f = __builtin_amdgcn_exp2f(-dl); l_reg *= f; resc = true; }
    }
#pragma unroll
    for (int r = 0; r < 16; ++r) { p0[r] = __builtin_amdgcn_exp2f(p0[r]); p1[r] = __builtin_amdgcn_exp2f(p1[r]); }
    l_reg += rowsum(p0, p1);
    return resc;
}
struct UnitDesc { int var, b, h, kvh, qrow0, f0, n0, f1, n1; };
struct LayerConst { int l; float lam, one_m_lam_init; };

template <int VAR> __device__ __forceinline__ void attn_unit(const Params& p, const UnitDesc& u, const LayerConst& lc, LAS unsigned char* lds) {
    const int tid = opaque_v((int)threadIdx.x), lane = tid & 63, r32 = lane & 31, hi = lane >> 5; const int wid = __builtin_amdgcn_readfirstlane(tid >> 6);
    constexpr int QOFF = VAR == 0 ? AQ : VAR == 1 ? BQ : CQ, KOFF = VAR == 0 ? AK : VAR == 1 ? BK : CK, VOFF = VAR == 0 ? AV : VAR == 1 ? BV : CV, GOFF = VAR == 0 ? AG : VAR == 1 ? BG : CG, YOFF = VAR * 256;
    const size_t rowb = (size_t)u.b * T;
    const unsigned lds0 = (unsigned)(uintptr_t)lds;
    LAS float* wsf = (LAS float*)(lds + L_WSF) + wid * 64;
    LAS float* ost = (LAS float*)(lds + L_OST) + wid * 2048;
    LAS float* rpbL = (LAS float*)(lds + L_RPB);
    const int NT = u.n0 + u.n1;
    const bf16_t* kbase = p.P + (rowb + lane) * NP + KOFF + u.kvh * 64 + wid * 8;
    const bf16_t* vbase = p.P + (rowb + 16 * (wid & 3) + (lane >> 2)) * NP + VOFF + u.kvh * 64 + (wid >> 2) * 32 + (lane & 3) * 8;
#define ATT_TROW(j) (((j) < u.n0 ? u.f0 + (j) : u.f1 + ((j) - u.n0)) * 64)
#define ATT_DMA(j, slot) do { const size_t ro_ = (size_t)ATT_TROW(j) * NP; \
        glds16(kbase + ro_, (unsigned)__builtin_amdgcn_readfirstlane(lds0 + L_RING + (slot) * SLOT + wid * 1024)); \
        glds16(vbase + ro_, (unsigned)__builtin_amdgcn_readfirstlane(lds0 + L_RING + (slot) * SLOT + 8192 + wid * 1024)); } while (0)
    ATT_DMA(0, 0);
    if (NT > 1) ATT_DMA(1, 1);
    if (VAR == 2) { for (int i = tid; i < 15 * 31; i += NTHR) rpbL[i] = p.rpb[((size_t)lc.l * 4 + u.h) * 15 * 31 + i] * LOG2E; }
    const bf16_t* qp = p.P + (rowb + u.qrow0 + wid * 32 + r32) * NP + QOFF + u.h * 64 + hi * 8;
    bf16x8 qr[4];
#pragma unroll
    for (int d0 = 0; d0 < 4; ++d0) qr[d0] = *(const bf16x8*)(qp + d0 * 16);
    const int qt = u.qrow0 + wid * 32 + r32; const int gr = qt >> 6, gwc = qt & 63;
    const int rs0 = min(max(gr - 4, 0), 56), cs0 = min(max(gwc - 8, 0), 48);
    const bool latq = u.qrow0 < S;
    f32x16 o[2], o2[2]; o[0] = f32x16{}; o[1] = f32x16{}; o2[0] = f32x16{}; o2[1] = f32x16{};
    float mhat = 0.f, l_reg = 0.f, mhat2 = 0.f, l_reg2 = 0.f;
    f32x16 negm = f32x16{}, negm2 = f32x16{};
    bool started = false;
    for (int j = 0; j < NT; ++j) {
        if (j + 1 < NT) ATT_WAIT_BAR(2); else ATT_WAIT_BAR(0);
        if (j + 2 < NT) { const int s2 = (j + 2) % 3; ATT_DMA(j + 2, s2); }
        const int sl = (j % 3) * SLOT;
        const int trow = ATT_TROW(j);
        bool active = true; const bool wintile = (VAR == 2) && latq && trow < S;
        if (wintile) { const int kr = trow >> 6; active = (kr >= rs0) && (kr < rs0 + 8); }
        if (!active) continue;
        const LAS unsigned char* kp = lds + L_RING + sl + hi * 1024 + r32 * 16;
        const int vb = (int)(lds0 + L_RING + sl + 8192) + ((lane >> 4) & 1) * 32 + (lane & 3) * 8 + (4 * hi + ((lane & 15) >> 2)) * 64;
        if (VAR != 1) {
            f32x16 p0, p1;
#pragma unroll
            for (int d0 = 0; d0 < 4; ++d0) {
                const bf16x8 b0 = *(const LAS bf16x8*)(kp + d0 * 2048), b1 = *(const LAS bf16x8*)(kp + d0 * 2048 + 512);
                p0 = ATT_MFMA(b0, qr[d0], d0 == 0 ? negm : p0); p1 = ATT_MFMA(b1, qr[d0], d0 == 0 ? negm : p1);
            }
            if (wintile) {
                const int kr = trow >> 6; const LAS float* brow = rpbL + (kr - gr + 7) * 31 + 15 - gwc;
#pragma unroll
                for (int r = 0; r < 16; ++r) {
                    const int kc = crow(r, hi);
                    p0[r] = ((unsigned)(kc - cs0) < 16u) ? p0[r] + brow[kc] : -INFINITY;
                    p1[r] = ((unsigned)(kc + 32 - cs0) < 16u) ? p1[r] + brow[kc + 32] : -INFINITY;
                }
            }
            float f; const bool resc = softmax_tile(p0, p1, mhat, l_reg, f, !started);
            if (resc || !started) {
#pragma unroll
                for (int r = 0; r < 16; ++r) negm[r] = -mhat;
            }
            if (resc) {
                if (hi == 0) wsf[r32] = f;
#pragma unroll
                for (int d_ = 0; d_ < 2; ++d_)
#pragma unroll
                    for (int r = 0; r < 16; ++r) o[d_][r] *= wsf[crow(r, hi)];
            }
            started = true;
            PW pw; packp(pw, p0, p1);
#pragma unroll
            for (int d0 = 0; d0 < 2; ++d0) {
                bf16x8 vf[4]; vfrags(vf, vb, d0);
#pragma unroll
                for (int ks = 0; ks < 4; ++ks) o[d0] = ATT_MFMA(__builtin_bit_cast(bf16x8, pw.w[ks]), vf[ks], o[d0]);
            }
        } else {
            PW pw, pw2; float f = 1.f, f2 = 1.f; bool resc = false;
            {
                f32x16 p0 = f32x16{}, p1 = f32x16{};
#pragma unroll
                for (int d0 = 0; d0 < 2; ++d0) {
                    const bf16x8 b0 = *(const LAS bf16x8*)(kp + d0 * 2048), b1 = *(const LAS bf16x8*)(kp + d0 * 2048 + 512);
                    p0 = ATT_MFMA(b0, qr[d0], p0); p1 = ATT_MFMA(b1, qr[d0], p1);
                }
                const float rm = rowmax(p0, p1);
                if (!started) mhat = rm;
                else if (__any(rm - mhat > THR)) { const float mn = __builtin_fmaxf(mhat, rm); f = __builtin_amdgcn_exp2f(mhat - mn); mhat = mn; l_reg *= f; resc = true; }
#pragma unroll
                for (int r = 0; r < 16; ++r) { p0[r] = __builtin_amdgcn_exp2f(p0[r] - mhat); p1[r] = __builtin_amdgcn_exp2f(p1[r] - mhat); }
                l_reg += rowsum(p0, p1);
                packp(pw, p0, p1);
            }
            {
                f32x16 q0 = f32x16{}, q1 = f32x16{};
#pragma unroll
                for (int d0 = 2; d0 < 4; ++d0) {
                    const bf16x8 b0 = *(const LAS bf16x8*)(kp + d0 * 2048), b1 = *(const LAS bf16x8*)(kp + d0 * 2048 + 512);
                    q0 = ATT_MFMA(b0, qr[d0], q0); q1 = ATT_MFMA(b1, qr[d0], q1);
                }
                const float rm = rowmax(q0, q1);
                if (!started) mhat2 = rm;
                else if (__any(rm - mhat2 > THR)) { const float mn = __builtin_fmaxf(mhat2, rm); f2 = __builtin_amdgcn_exp2f(mhat2 - mn); mhat2 = mn; l_reg2 *= f2; resc = true; }
#pragma unroll
                for (int r = 0; r < 16; ++r) { q0[r] = __builtin_amdgcn_exp2f(q0[r] - mhat2); q1[r] = __builtin_amdgcn_exp2f(q1[r] - mhat2); }
                l_reg2 += rowsum(q0, q1);
                packp(pw2, q0, q1);
            }
            if (resc) {
                if (hi == 0) { wsf[r32] = f; wsf[32 + r32] = f2; }
#pragma unroll
                for (int d_ = 0; d_ < 2; ++d_)
#pragma unroll
                    for (int r = 0; r < 16; ++r) { o[d_][r] *= wsf[crow(r, hi)]; o2[d_][r] *= wsf[32 + crow(r, hi)]; }
            }
            started = true;
#pragma unroll
            for (int d0 = 0; d0 < 2; ++d0) {
                bf16x8 vf[4]; vfrags(vf, vb, d0);
#pragma unroll
                for (int ks = 0; ks < 4; ++ks) { o[d0] = ATT_MFMA(__builtin_bit_cast(bf16x8, pw.w[ks]), vf[ks], o[d0]); o2[d0] = ATT_MFMA(__builtin_bit_cast(bf16x8, pw2.w[ks]), vf[ks], o2[d0]); }
            }
        }
    }
    { auto rr = __builtin_amdgcn_permlane32_swap(__float_as_uint(l_reg), __float_as_uint(l_reg), false, false); l_reg = __uint_as_float(rr[0]) + __uint_as_float(rr[1]); }
    if (VAR == 1) { auto rr = __builtin_amdgcn_permlane32_swap(__float_as_uint(l_reg2), __float_as_uint(l_reg2), false, false); l_reg2 = __uint_as_float(rr[0]) + __uint_as_float(rr[1]); }
    if (hi == 0) { wsf[r32] = 1.f / l_reg; if (VAR == 1) wsf[32 + r32] = lc.lam / l_reg2; }
#pragma unroll
    for (int r = 0; r < 16; ++r) {
        const int orow = crow(r, hi); const float a1 = wsf[orow];
        if (VAR == 1) { const float a2 = wsf[32 + orow]; ost[orow * 64 + r32] = o[0][r] * a1 - o2[0][r] * a2; ost[orow * 64 + 32 + r32] = o[1][r] * a1 - o2[1][r] * a2; }
        else { ost[orow * 64 + r32] = o[0][r] * a1; ost[orow * 64 + 32 + r32] = o[1][r] * a1; }
    }
    asm volatile("s_waitcnt lgkmcnt(0)" ::: "memory");
    const size_t mrow0 = rowb + u.qrow0 + wid * 32;
#pragma unroll
    for (int i = 0; i < 4; ++i) {
        const int row = i * 8 + (lane >> 3), ch = lane & 7;
        const f32x4 x0 = *(const LAS f32x4*)(ost + row * 64 + ch * 8), x1 = *(const LAS f32x4*)(ost + row * 64 + ch * 8 + 4);
        float v[8] = {x0[0], x0[1], x0[2], x0[3], x1[0], x1[1], x1[2], x1[3]};
        if (VAR == 1) {
            float ss = 0.f;
#pragma unroll
            for (int e = 0; e < 8; ++e) ss += v[e] * v[e];
            ss += __shfl_xor(ss, 1); ss += __shfl_xor(ss, 2); ss += __shfl_xor(ss, 4);
            const float rs = rsqrtf(ss * (1.f / 64.f) + RMS_EPS) * lc.one_m_lam_init;
            const f32x4 g0 = *(const f32x4*)(p.subln_g + lc.l * 64 + ch * 8), g1 = *(const f32x4*)(p.subln_g + lc.l * 64 + ch * 8 + 4);
            const float gg[8] = {g0[0], g0[1], g0[2], g0[3], g1[0], g1[1], g1[2], g1[3]};
#pragma unroll
            for (int e = 0; e < 8; ++e) v[e] *= rs * gg[e];
        }
        const u32x4 gt = *(const u32x4*)(p.P + (mrow0 + row) * NP + GOFF + u.h * 64 + ch * 8);
        u32x4 w;
#pragma unroll
        for (int e = 0; e < 4; ++e) { const float ga = __uint_as_float(gt[e] << 16), gb = __uint_as_float(gt[e] & 0xffff0000u); w[e] = cvtpk(v[2 * e] * ga, v[2 * e + 1] * gb); }
        *(u32x4*)(p.A + (mrow0 + row) * D + YOFF + u.h * 64 + ch * 8) = w;
    }
    asm volatile("s_waitcnt lgkmcnt(0)\n\ts_barrier" ::: "memory");
#undef ATT_TROW
#undef ATT_DMA
}

__device__ __forceinline__ void attn_phase(const Params& p, int l, LAS unsigned char* lds, int v, int G) {
    float d1 = 0.f, d2 = 0.f;
    for (int i = 0; i < 32; ++i) { d1 += p.lq1[l * 32 + i] * p.lk1[l * 32 + i]; d2 += p.lq2[l * 32 + i] * p.lk2[l * 32 + i]; }
    const float lam_init = 0.8f - 0.6f * expf(-0.3f * (float)l);
    LayerConst lc{l, expf(d1) - expf(d2) + lam_init, 1.f - lam_init};
    const bool need_ctx = l < NL - 1;
    for (int uidx = v; uidx < 256; uidx += G) {
        { UnitDesc u; u.var = 0; u.b = uidx >> 6; u.kvh = (uidx >> 5) & 1; u.h = u.kvh * 2 + ((uidx >> 4) & 1); u.qrow0 = (uidx & 15) * 256; u.f0 = 0; u.n0 = 68; u.f1 = 0; u.n1 = 0; attn_unit<0>(p, u, lc, lds); }
        { UnitDesc u; u.var = 1; u.b = uidx >> 6; u.h = (uidx >> 4) & 3; u.kvh = u.h; u.qrow0 = (uidx & 15) * 256; u.f0 = 0; u.n0 = 68; u.f1 = 0; u.n1 = 0; attn_unit<1>(p, u, lc, lds); }
        { UnitDesc u; u.var = 2; u.b = uidx >> 6; u.h = (uidx >> 4) & 3; u.kvh = u.h; const int qb = uidx & 15; u.qrow0 = qb * 256;
          const int ra = min(max(4 * qb - 4, 0), 56), rb = min(max(4 * qb + 3 - 4, 0), 56) + 8; u.f0 = 64; u.n0 = 4; u.f1 = ra; u.n1 = rb - ra; attn_unit<2>(p, u, lc, lds); }
    }
    if (need_ctx) {
        for (int uidx = v; uidx < 48; uidx += G) {
            const int var = uidx >> 4, b = (uidx >> 2) & 3, h = uidx & 3;
            UnitDesc u; u.var = var; u.b = b; u.h = h; u.kvh = var == 0 ? (h >> 1) : h; u.qrow0 = S; u.f0 = 64; u.n0 = 4; u.f1 = 0; u.n1 = 0;
            if (var == 0) attn_unit<0>(p, u, lc, lds); else if (var == 1) attn_unit<1>(p, u, lc, lds); else attn_unit<2>(p, u, lc, lds);
        }
    }
}
}
namespace s5m {
typedef short bf16x8 __attribute__((ext_vector_type(8)));
constexpr int NCK = T / 16;
constexpr int TT_SZ = 31 * 256, E_SZ = 2 * 128 * 256, F_SZ = 2 * 256 * 128;
#define S5_MFMA(a, b, c) __builtin_amdgcn_mfma_f32_16x16x32_bf16(a, b, c, 0, 0, 0)
__device__ __forceinline__ void build_a(const Params& p, int gw, int ngw, int lane) {
    for (int it = gw * 64 + lane; it < NL * 16 * 64; it += ngw * 64) {
        const int st = it & 63, g = (it >> 6) & 15, l = it >> 10;
#pragma unroll
        for (int dir = 0; dir < 2; ++dir) {
            const size_t ip = (size_t)((l * 2 + dir) * 16 + g) * 64 + st; const int ig = (l * 2 + dir) * 16 + g;
            float* dsc = p.disc + ip * 34;
            double lr, li;
            {
                const double ar = p.a_re[ip], ai = p.a_im[ip], dt = exp((double)p.log_dt[ig]);
                const double e = exp(ar * dt); lr = e * cos(ai * dt); li = e * sin(ai * dt);
                const double nr = lr - 1.0, ni = li, den = ar * ar + ai * ai; const double cr = (nr * ar + ni * ai) / den, ci = (ni * ar - nr * ai) / den;
                dsc[0] = (float)lr; dsc[1] = (float)li;
                for (int c = 0; c < 16; ++c) { const double br = p.b_re[ip * 16 + c], bi = p.b_im[ip * 16 + c]; dsc[2 + c] = (float)(cr * br - ci * bi); dsc[18 + c] = (float)(cr * bi + ci * br); }
            }
            double pr[17], pi[17]; pr[0] = 1.0; pi[0] = 0.0;
#pragma unroll
            for (int k = 1; k <= 16; ++k) { pr[k] = pr[k - 1] * lr - pi[k - 1] * li; pi[k] = pr[k - 1] * li + pi[k - 1] * lr; }
            float* lp = p.lampow + ip * 32;
#pragma unroll
            for (int k = 0; k < 16; ++k) { lp[2 * k] = (float)pr[k]; lp[2 * k + 1] = (float)pi[k]; }
            p.lam16[ip * 2] = (float)pr[16]; p.lam16[ip * 2 + 1] = (float)pi[16];
            bf16_t* E = p.Etab + ((size_t)(l * 16 + g) * 2 + dir) * 128 * 256;
#pragma unroll
            for (int s = 0; s < 16; ++s) {
                const double wr = dir == 0 ? pr[15 - s] : pr[s], wi = dir == 0 ? pi[15 - s] : pi[s];
                for (int c = 0; c < 16; ++c) {
                    const double br = dsc[2 + c], bi = dsc[18 + c];
                    E[(size_t)st * 256 + s * 16 + c] = f2bf((float)(wr * br - wi * bi)); E[(size_t)(64 + st) * 256 + s * 16 + c] = f2bf((float)(wr * bi + wi * br));
                }
            }
            bf16_t* F = p.Ftab + ((size_t)(l * 16 + g) * 2 + dir) * 256 * 128;
            const size_t cb = ((size_t)(l * 2 + dir) * 16 + g) * 16 * 64;
#pragma unroll
            for (int t = 0; t < 16; ++t) {
                const double wr = dir == 0 ? pr[t + 1] : pr[16 - t], wi = dir == 0 ? pi[t + 1] : pi[16 - t];
                for (int c = 0; c < 16; ++c) {
                    const double cr = p.c_re[cb + c * 64 + st], ci = p.c_im[cb + c * 64 + st];
                    F[(size_t)(t * 16 + c) * 128 + st] = f2bf((float)(cr * wr - ci * wi)); F[(size_t)(t * 16 + c) * 128 + 64 + st] = f2bf((float)(-(cr * wi + ci * wr)));
                }
            }
        }
    }
}
__device__ __forceinline__ void build_b(const Params& p, int gw, int ngw, int lane) {
    for (int it = gw * 64 + lane; it < NL * 16 * 31 * 256; it += ngw * 64) {
        const int cc = it & 15, c = (it >> 4) & 15, ti = (it >> 8) % 31, lg = it / (31 * 256), g = lg & 15, l = lg >> 4;
        float acc = 0.f;
        for (int dir = 0; dir < 2; ++dir) {
            if ((dir == 0 && ti < 15) || (dir == 1 && ti > 15)) continue;
            const int tau = dir == 0 ? ti - 15 : 15 - ti;
            const size_t ig = (size_t)((l * 2 + dir) * 16 + g);
            const float* cre = p.c_re + (ig * 16 + c) * 64; const float* cim = p.c_im + (ig * 16 + c) * 64;
            for (int st = 0; st < 64; ++st) {
                const size_t ip = ig * 64 + st;
                const float wr = p.lampow[ip * 32 + 2 * tau], wi = p.lampow[ip * 32 + 2 * tau + 1];
                const float br = p.disc[ip * 34 + 2 + cc], bi = p.disc[ip * 34 + 18 + cc];
                const float xr = wr * br - wi * bi, xi = wr * bi + wi * br;
                acc += cre[st] * xr - cim[st] * xi;
            }
        }
        p.Ttab[(size_t)it] = f2bf(acc);
    }
}
__device__ __forceinline__ void unit(const Params& p, int l, int b, int g, LAS unsigned char* lds) {
    const int tid = opaque_v((int)threadIdx.x), lane = tid & 63, wave = __builtin_amdgcn_readfirstlane(tid >> 6), nn = lane & 15, kg = lane >> 4;
    const size_t rowb = (size_t)b * T;
    float* Sb = p.Sbuf + (size_t)(b * 16 + g) * NCK * 256; bf16_t* Hb = p.Hinb + (size_t)(b * 16 + g) * NCK * 256;
    for (int i = tid; i < T * 2; i += NTHR) {
        const int t = i >> 1, half = i & 1, n = t >> 4, s = t & 15;
        const u32x4 v = *(const u32x4*)(p.P + (rowb + t) * NP + DU + g * 16 + half * 8);
        *(LAS u32x4*)(lds + n * 512 + (((s * 2 + half) ^ (n & 15)) * 16)) = v;
    }
    __syncthreads();
    {
        const bf16_t* E = p.Etab + (size_t)(l * 16 + g) * E_SZ;
        bf16x8 af[2][8];
#pragma unroll
        for (int rb = 0; rb < 2; ++rb)
#pragma unroll
            for (int kb = 0; kb < 8; ++kb) af[rb][kb] = *(const bf16x8*)(E + (size_t)(wave * 32 + rb * 16 + nn) * 256 + kb * 32 + kg * 8);
        for (int cb = 0; cb < 17; ++cb) {
            const int n = cb * 16 + nn;
            f32x4 a0 = {0.f, 0.f, 0.f, 0.f}, a1 = {0.f, 0.f, 0.f, 0.f};
#pragma unroll
            for (int kb = 0; kb < 8; ++kb) {
                const int s = 2 * kb + (kg >> 1), half = kg & 1;
                const bf16x8 bfr = *(const LAS bf16x8*)(lds + n * 512 + (((s * 2 + half) ^ (n & 15)) * 16));
                a0 = S5_MFMA(af[0][kb], bfr, a0); a1 = S5_MFMA(af[1][kb], bfr, a1);
            }
            *(f32x4*)(Sb + (size_t)n * 256 + wave * 32 + kg * 4) = a0; *(f32x4*)(Sb + (size_t)n * 256 + wave * 32 + 16 + kg * 4) = a1;
        }
    }
    asm volatile("s_waitcnt vmcnt(0)" ::: "memory"); __syncthreads(); asm volatile("buffer_inv sc1\n\ts_waitcnt vmcnt(0)" ::: "memory");
    if (tid < 128) {
        const int dir = tid >> 6, st = tid & 63;
        const size_t ip = (size_t)((l * 2 + dir) * 16 + g) * 64 + st;
        const float ar = p.lam16[ip * 2], ai = p.lam16[ip * 2 + 1];
        float hr = 0.f, hi = 0.f;
        for (int o0 = 0; o0 < NCK; o0 += 8) {
            float sr[8], si[8]; int nidx[8];
#pragma unroll
            for (int j = 0; j < 8; ++j) {
                const int o = o0 + j; const int n = dir == 0 ? (o < 16 ? 256 + o : o - 16) : (o < 16 ? 256 + 15 - o : 255 - (o - 16)); nidx[j] = n;
                sr[j] = __builtin_nontemporal_load(Sb + (size_t)n * 256 + dir * 128 + st); si[j] = __builtin_nontemporal_load(Sb + (size_t)n * 256 + dir * 128 + 64 + st);
            }
#pragma unroll
            for (int j = 0; j < 8; ++j) {
                Hb[(size_t)nidx[j] * 256 + dir * 128 + st] = f2bf(hr); Hb[(size_t)nidx[j] * 256 + dir * 128 + 64 + st] = f2bf(hi);
                const float nr = ar * hr - ai * hi + sr[j], ni = ar * hi + ai * hr + si[j]; hr = nr; hi = ni;
            }
        }
    }
    asm volatile("s_waitcnt vmcnt(0)" ::: "memory"); __syncthreads(); asm volatile("buffer_inv sc1\n\ts_waitcnt vmcnt(0)" ::: "memory");
    {
        const bf16_t* Tt = p.Ttab + (size_t)(l * 16 + g) * TT_SZ; const bf16_t* F = p.Ftab + (size_t)(l * 16 + g) * F_SZ;
        bf16x8 at[2][8], afq[2][8];
#pragma unroll
        for (int rb = 0; rb < 2; ++rb) {
            const int t = wave * 2 + rb;
#pragma unroll
            for (int kb = 0; kb < 8; ++kb) {
                const int s = 2 * kb + (kg >> 1), half = kg & 1, ti = t - s + 15;
                at[rb][kb] = *(const bf16x8*)(Tt + (size_t)(ti * 16 + nn) * 16 + half * 8);
                afq[rb][kb] = *(const bf16x8*)(F + (size_t)((kb >> 2) * 256 + t * 16 + nn) * 128 + (kb & 3) * 32 + kg * 8);
            }
        }
        const float* dsk = p.s5_d + l * 256 + g * 16 + kg * 4;
        const float d0 = dsk[0], d1 = dsk[1], d2 = dsk[2], d3 = dsk[3];
        for (int cb = 0; cb < 17; ++cb) {
            const int n = cb * 16 + nn;
            f32x4 a0 = {0.f, 0.f, 0.f, 0.f}, a1 = {0.f, 0.f, 0.f, 0.f};
            bf16x8 hf[8];
#pragma unroll
            for (int kb = 0; kb < 8; ++kb) hf[kb] = *(const bf16x8*)(Hb + (size_t)n * 256 + kb * 32 + kg * 8);
#pragma unroll
            for (int kb = 0; kb < 8; ++kb) {
                const int s = 2 * kb + (kg >> 1), half = kg & 1;
                const bf16x8 bfr = *(const LAS bf16x8*)(lds + n * 512 + (((s * 2 + half) ^ (n & 15)) * 16));
                a0 = S5_MFMA(at[0][kb], bfr, a0); a1 = S5_MFMA(at[1][kb], bfr, a1);
            }
#pragma unroll
            for (int kb = 0; kb < 8; ++kb) { a0 = S5_MFMA(afq[0][kb], hf[kb], a0); a1 = S5_MFMA(afq[1][kb], hf[kb], a1); }
#pragma unroll
            for (int rb = 0; rb < 2; ++rb) {
                const int t = wave * 2 + rb; const f32x4 a = rb == 0 ? a0 : a1;
                const u32x2 uu = *(const LAS u32x2*)(lds + n * 512 + (((t * 2 + (kg >> 1)) ^ (n & 15)) * 16) + (kg & 1) * 8);
                const float u0 = __uint_as_float(uu.x << 16), u1 = __uint_as_float(uu.x & 0xffff0000u), u2 = __uint_as_float(uu.y << 16), u3 = __uint_as_float(uu.y & 0xffff0000u);
                u32x2 w; w.x = pk2(gelu_tanh(a[0] + d0 * u0), gelu_tanh(a[1] + d1 * u1)); w.y = pk2(gelu_tanh(a[2] + d2 * u2), gelu_tanh(a[3] + d3 * u3));
                *(u32x2*)(p.ys5 + (rowb + n * 16 + t) * 256 + g * 16 + kg * 4) = w;
            }
        }
    }
    __syncthreads();
}
}
constexpr int LDS_BYTES = 147456;
__device__ __forceinline__ void ph_inproj(const Params& p, int l, LAS unsigned char* lds, int G, int bx) {
    pg8::Gemm g{p.A, p.Win_t + (size_t)l * NP * D, MT, NP, D}; pg8::StaticOrder So; So.init(MT, NP, G, bx);
    pg8::EpiInProj E{p.P, p.tabA, p.tabB, p.qn_g + l * 64, p.kn_g + l * 64};
    pg8::gemm_phase<pg8::EpiInProj, pg8::StaticOrder, true, true>(lds, g, So, E);
}
__device__ __forceinline__ void ph_outproj(const Params& p, int l, LAS unsigned char* lds, int G, int bx) {
    const int M = l == NL - 1 ? MT : MT;
    pg8::Gemm g{p.A, p.Wout_t + (size_t)l * D * D, M, D, D}; pg8::StaticOrder So; So.init(M, D, G, bx);
    pg8::EpiOutProj E{p.xl, p.xc, p.mod + (size_t)l * 5 * 3 * D};
    pg8::gemm_phase<pg8::EpiOutProj, pg8::StaticOrder, true, true>(lds, g, So, E);
}
__device__ __forceinline__ void ph_glu(const Params& p, int l, LAS unsigned char* lds, int G, int bx) {
    pg8::Gemm g{p.ys5, p.Wglu_t + (size_t)l * 512 * 256, MT, 512, 256}; pg8::StaticOrder So; So.init(MT, 512, G, bx);
    pg8::EpiGlu E{p.A, p.P};
    pg8::gemm_phase<pg8::EpiGlu, pg8::StaticOrder, true, true>(lds, g, So, E);
}
struct Ctx { int tid, lane, wave, G, bx, gw, ngw, v; };
__device__ __forceinline__ Ctx make_ctx() {
    Ctx c; c.tid = opaque_v((int)threadIdx.x); c.lane = c.tid & 63; c.wave = __builtin_amdgcn_readfirstlane(c.tid >> 6);
    c.G = opaque_s((int)gridDim.x); c.bx = opaque_s((int)blockIdx.x); c.gw = c.bx * NWAVES + c.wave; c.ngw = c.G * NWAVES;
    c.v = (c.G % 8 == 0) ? (c.bx % 8) * (c.G / 8) + (c.bx / 8) : c.bx;
    return c;
}
#define GRID_SYNC() cg::this_grid().sync()
__global__ void __launch_bounds__(NTHR, 2) mega(KArgs ka) {
    extern __shared__ __attribute__((aligned(16))) unsigned char lds_raw[];
    LAS unsigned char* lds = (LAS unsigned char*)lds_raw;
    { const Params pp = make_params(ka, true);
      { const Ctx c = make_ctx(); phase_prologue(pp, ka, lds, c.gw, c.ngw, c.wave, c.lane); s5m::build_a(pp, c.gw, c.ngw, c.lane); }
      GRID_SYNC();
      { const Ctx c = make_ctx(); s5m::build_b(pp, c.gw, c.ngw, c.lane); phase_rows(pp, -1, 0, c.gw, c.ngw, c.lane); } }
    GRID_SYNC();
#pragma nounroll
    for (int l = 0; l < NL; ++l) {
        { const Ctx c = make_ctx(); const Params p = make_params(ka, false); ph_inproj(p, l, lds, c.G, c.bx); }
        GRID_SYNC();
        { const Ctx c = make_ctx(); const Params p = make_params(ka, false); att::attn_phase(p, l, lds, c.v, c.G); }
        { const Ctx c = make_ctx(); const Params p = make_params(ka, false); for (int u = c.v; u < NB * 16; u += c.G) s5m::unit(p, l, u >> 4, u & 15, lds); }
        GRID_SYNC();
        { const Ctx c = make_ctx(); const Params p = make_params(ka, false); ph_glu(p, l, lds, c.G, c.bx); }
        GRID_SYNC();
        { const Ctx c = make_ctx(); const Params p = make_params(ka, false); ph_outproj(p, l, lds, c.G, c.bx); }
        GRID_SYNC();
        { const Ctx c = make_ctx(); const Params p = make_params(ka, false); phase_rows(p, l, l + 1, c.gw, c.ngw, c.lane); }
        if (l + 1 < NL) GRID_SYNC();
    }
}

extern "C" void kernel_launch(void* const* d_in, const int* in_sizes, int n_in, void* d_out, int out_size, void* d_ws, size_t ws_size, hipStream_t stream) {
    static int grid = 0;
    if (grid == 0) {
        int dev = 0, cus = 0, per_cu = 0;
        (void)hipGetDevice(&dev); (void)hipDeviceGetAttribute(&cus, hipDeviceAttributeMultiprocessorCount, dev);
        (void)hipFuncSetAttribute((const void*)mega, hipFuncAttributeMaxDynamicSharedMemorySize, LDS_BYTES);
        if (hipOccupancyMaxActiveBlocksPerMultiprocessor(&per_cu, (const void*)mega, NTHR, LDS_BYTES) != hipSuccess || per_cu < 1) { per_cu = 1; (void)hipGetLastError(); }
        if (per_cu > 1) per_cu = 1;
        grid = (cus > 0 ? cus : 256) * per_cu;
    }
    KArgs ka{};
    for (int i = 0; i < 27; ++i) ka.in[i] = (const float*)d_in[i];
    ka.out = (float*)d_out; ka.ws = (unsigned char*)d_ws;
    if (O_END > ws_size) { fprintf(stderr, "kernel_launch: workspace too small: need %zu have %zu\n", (size_t)O_END, ws_size); return; }
    void* args[] = {&ka};
    hipError_t e = hipLaunchCooperativeKernel((const void*)mega, dim3(grid), dim3(NTHR), args, LDS_BYTES, stream);
    if (e != hipSuccess) fprintf(stderr, "cooperative launch failed: %s (grid %d)\n", hipGetErrorString(e), grid);
}
```

```cpp
#include <hip/hip_runtime.h>
#include <hip/hip_cooperative_groups.h>
#include <cstdint>
#include <cstdio>
#include <math.h>
namespace cg = cooperative_groups;

constexpr int D = 1024, NB = 4, S = 4096, NL = 4, GW = 64, CT = 256;
constexpr int T = S + CT;
constexpr int MT = NB * T;
constexpr int NP = 3328;
constexpr int AQ = 0, AK = 256, AV = 384, AG = 512, BQ = 768, BK = 1024, BV = 1280, BG = 1536, CQ = 1792, CK = 2048, CV = 2304, CG = 2560, DU = 2816, DG = 3072;
constexpr float RMS_EPS = 1e-6f, LN_EPS = 1e-5f;
constexpr float ALPHA = 1.681792830507429f;
constexpr float LOG2E = 1.4426950408889634f;
constexpr float C2A = 0.125f * LOG2E;
constexpr float C2B = 0.17677669529663687f * LOG2E;
constexpr int NCH = T / 64;
constexpr int NWAVES = 8, NTHR = 512;

typedef unsigned short bf16_t;
typedef float f32x4 __attribute__((ext_vector_type(4)));
typedef unsigned u32x4 __attribute__((ext_vector_type(4)));
typedef unsigned u32x2 __attribute__((ext_vector_type(2)));
#define LAS __attribute__((address_space(3)))
__device__ __forceinline__ float bf2f(bf16_t v) { return __uint_as_float(((unsigned)v) << 16); }
__device__ __forceinline__ unsigned f2bf_u(float f) { unsigned u = __float_as_uint(f); return (u + 0x7fffu + ((u >> 16) & 1u)) >> 16; }
__device__ __forceinline__ bf16_t f2bf(float f) { return (bf16_t)f2bf_u(f); }
__device__ __forceinline__ unsigned pk2(float lo, float hi) { return f2bf_u(lo) | (f2bf_u(hi) << 16); }
__device__ __forceinline__ float silu_f(float v) { return v / (1.f + __expf(-v)); }
__device__ __forceinline__ float sigm_f(float v) { return 1.f / (1.f + __expf(-v)); }
__device__ __forceinline__ float gelu_tanh(float v) { return 0.5f * v * (1.f + tanhf(0.7978845608028654f * (v + 0.044715f * v * v * v))); }

__device__ __forceinline__ int opaque_v(int x) { asm volatile("" : "+v"(x)); return x; }
__device__ __forceinline__ int opaque_s(int x) { asm volatile("" : "+s"(x)); return x; }
struct Params {
    const float *x, *c, *ctx, *c_ctx, *w_ada, *b_ada, *w_in, *w_out, *ln_g, *ln_b, *qn_g, *kn_g, *lq1, *lk1, *lq2, *lk2, *subln_g, *rpb;
    const float *a_re, *a_im, *log_dt, *b_re, *b_im, *c_re, *c_im, *s5_d, *w_glu;
    float* xl;
    float* xc;
    float* mod;
    float* tabA;
    float* tabB;
    bf16_t* Win_t;
    bf16_t* Wout_t;
    bf16_t* Wglu_t;
    bf16_t* A;
    bf16_t* P;
    bf16_t* ys5;
    float* Sbuf;
    bf16_t* Hinb;
    bf16_t* Ttab; bf16_t* Etab; bf16_t* Ftab; float* apow; float* lampow;
    unsigned* ctl;
    float* disc;
};
struct KArgs { const float* in[27]; float* out; unsigned char* ws; };
constexpr size_t al256(size_t x) { return (x + 255) & ~(size_t)255; }
constexpr size_t O_CTL = 0, O_XC = O_CTL + (1 << 20), O_MOD = O_XC + al256((size_t)NB * CT * D * 4), O_TABA = O_MOD + al256((size_t)NL * 5 * 3 * D * 4), O_TABB = O_TABA + 8192,
    O_WIN = O_TABB + 4096, O_WOUT = O_WIN + al256((size_t)NL * NP * D * 2), O_WGLU = O_WOUT + al256((size_t)NL * D * D * 2), O_A = O_WGLU + al256((size_t)NL * 512 * 256 * 2),
    O_P = O_A + al256((size_t)MT * D * 2), O_YS5 = O_P + al256((size_t)MT * NP * 2), O_SBUF = O_YS5 + al256((size_t)MT * 256 * 2), O_HINB = O_SBUF + al256((size_t)NB * 16 * 272 * 256 * 4), O_TTAB = O_HINB + al256((size_t)NB * 16 * 272 * 256 * 2),
    O_ETAB = O_TTAB + al256((size_t)NL * 16 * 31 * 256 * 2), O_FTAB = O_ETAB + al256((size_t)NL * 16 * 2 * 128 * 256 * 2), O_LAM16 = O_FTAB + al256((size_t)NL * 16 * 2 * 256 * 128 * 2),
    O_LAMPOW = O_LAM16 + al256((size_t)NL * 2 * 16 * 64 * 32 * 4), O_SMALL = O_LAMPOW + al256((size_t)NL * 2 * 16 * 64 * 34 * 4);
constexpr int SM_N[18] = {NL * D, NL * D, NL * 64, NL * 64, NL * 32, NL * 32, NL * 32, NL * 32, NL * 64, NL * 4 * 15 * 31, NL * 2 * 16 * 64, NL * 2 * 16 * 64, NL * 2 * 16, NL * 2 * 16 * 64 * 16, NL * 2 * 16 * 64 * 16, NL * 2 * 16 * 16 * 64, NL * 2 * 16 * 16 * 64, NL * 256};
constexpr int sm_off(int i) { int o = 0; for (int k = 0; k < i; ++k) o += (SM_N[k] + 63) & ~63; return o; }
constexpr size_t O_DISC = O_SMALL + al256((size_t)sm_off(18) * 4);
constexpr size_t O_END = O_DISC + al256((size_t)NL * 2 * 16 * 64 * 34 * 4);
template <class Tp> __device__ __forceinline__ Tp* opaque_p(Tp* x) { asm volatile("" : "+s"(x)); return x; }
__device__ __forceinline__ Params make_params(const KArgs& ka, bool prologue) {
    Params p;
    const float** f = (const float**)&p;
    if (prologue) { for (int i = 0; i < 27; ++i) f[i] = ka.in[i]; }
    else {
        for (int i = 0; i < 27; ++i) f[i] = nullptr;
        const float* sm = (const float*)(opaque_p(ka.ws) + O_SMALL);
        p.ln_g = sm + sm_off(0); p.ln_b = sm + sm_off(1); p.qn_g = sm + sm_off(2); p.kn_g = sm + sm_off(3); p.lq1 = sm + sm_off(4); p.lk1 = sm + sm_off(5); p.lq2 = sm + sm_off(6); p.lk2 = sm + sm_off(7);
        p.subln_g = sm + sm_off(8); p.rpb = sm + sm_off(9); p.a_re = sm + sm_off(10); p.a_im = sm + sm_off(11); p.log_dt = sm + sm_off(12); p.b_re = sm + sm_off(13); p.b_im = sm + sm_off(14);
        p.c_re = sm + sm_off(15); p.c_im = sm + sm_off(16); p.s5_d = sm + sm_off(17);
    }
    unsigned char* ws = opaque_p(ka.ws);
    p.xl = opaque_p(ka.out); p.xc = (float*)(ws + O_XC); p.mod = (float*)(ws + O_MOD); p.tabA = (float*)(ws + O_TABA); p.tabB = (float*)(ws + O_TABB);
    p.Win_t = (bf16_t*)(ws + O_WIN); p.Wout_t = (bf16_t*)(ws + O_WOUT); p.Wglu_t = (bf16_t*)(ws + O_WGLU); p.A = (bf16_t*)(ws + O_A); p.P = (bf16_t*)(ws + O_P);
    p.ys5 = (bf16_t*)(ws + O_YS5); p.Sbuf = (float*)(ws + O_SBUF); p.Hinb = (bf16_t*)(ws + O_HINB); p.Ttab = (bf16_t*)(ws + O_TTAB); p.Etab = (bf16_t*)(ws + O_ETAB); p.Ftab = (bf16_t*)(ws + O_FTAB); p.apow = (float*)(ws + O_LAM16); p.lampow = (float*)(ws + O_LAMPOW); p.ctl = (unsigned*)(ws + O_CTL); p.disc = (float*)(ws + O_DISC);
    return p;
}
__device__ __forceinline__ float* xrow(const Params& p, int m) { const int b = m / T, t = m - b * T; return t < S ? p.xl + ((size_t)b * S + t) * D : p.xc + ((size_t)b * CT + (t - S)) * D; }
__device__ __forceinline__ int modrow(int m) { const int b = m / T, t = m - b * T; return t < S ? b : 4; }
namespace pg8 {
#define PG8_LAS __attribute__((address_space(3)))
typedef unsigned short bf16_t;
typedef short bf16x8 __attribute__((ext_vector_type(8)));
typedef float f32x4 __attribute__((ext_vector_type(4)));
typedef unsigned u32x4 __attribute__((ext_vector_type(4)));
constexpr int BM = 256, BK = 64, HALF = 128, HTB = HALF * BK * 2  , STAGE_BYTES = 8 * HTB, NXCD = 8, WGM = 8;

__host__ __device__ __forceinline__ int lds_byte(int r, int c) { const int st = (r >> 4) * 2 + (c >> 5), rr = r & 15, cc = c & 31, ob = rr * 64 + cc * 2; return st * 1024 + (ob ^ (((ob >> 9) & 1) << 5)); }
__host__ __device__ __forceinline__ void stage_rc(int b, int& R, int& C) { const int st = b / 1024, sb = b % 1024, swz = sb ^ (((sb >> 9) & 1) << 5); R = (st >> 1) * 16 + swz / 64; C = (st & 1) * 32 + (swz % 64) / 2; }
__host__ __device__ __forceinline__ int perm32(int rho) { const int n = rho >> 4, i = rho & 15; return 8 * (i >> 2) + 4 * n + (i & 3); }

struct Unit { int pm, pn; };
struct Gemm { const bf16_t* A; const bf16_t* Bt; int M, N, K; };

struct StaticOrder {
    int nM, nN, nwg, G, c;
    __host__ __device__ void init(int M, int N, int G_, int c_) { nM = M / BM; nN = N / BM; nwg = nM * nN; G = G_; c = c_; }
    __host__ __device__ bool next(int i, Unit& u) const {
        const long L = (long)i * G + c; if (L >= nwg) return false;
        int wgid = (int)L; { const int q = nwg / NXCD, r = nwg % NXCD, xcd = wgid % NXCD, off = wgid / NXCD; wgid = (xcd < r ? xcd * (q + 1) : r * (q + 1) + (xcd - r) * q) + off; }
        const int nig = WGM * nN, gid = wgid / nig, fm = gid * WGM, gsz = (nM - fm) < WGM ? (nM - fm) : WGM;
        u.pm = fm + ((wgid % nig) % gsz); u.pn = (wgid % nig) / gsz; return true;
    }
    __device__ __forceinline__ void a_ready(const Unit&) const {}
    __device__ __forceinline__ void done(const Unit&) const {}
};

__device__ __forceinline__ unsigned cvt_pk_bf16(float lo, float hi) { unsigned r; asm volatile("v_cvt_pk_bf16_f32 %0, %1, %2" : "=v"(r) : "v"(lo), "v"(hi)); return r; }
typedef float f32x2 __attribute__((ext_vector_type(2)));
template <class Epi, class Sched, bool ALIGN_EPI = false, bool SP2 = false>
__device__ __forceinline__ void gemm_phase(PG8_LAS unsigned char* lds, const Gemm g, const Sched& S, const Epi& E, int tid_in) {
    const int tid = tid_in, wid = __builtin_amdgcn_readfirstlane(tid >> 6), lane = tid & 63, wr = wid >> 2, wc = wid & 3, fr = lane & 15, fq = lane >> 4;
    const int K = g.K, nt = K / BK;
    unsigned voffA[2], voffB[2];
#pragma unroll
    for (int i = 0; i < 2; ++i) { int R, C; stage_rc(tid * 16 + i * 8192, R, C); const int Rb = Epi::PERM ? ((R & ~31) + perm32(R & 31)) : R;
        voffA[i] = (unsigned)(R * K + C) * 2u; voffB[i] = (unsigned)(Rb * K + C) * 2u; }
    const size_t kstep = (size_t)(BK * 2);
    const size_t hstep = (size_t)HALF * K * 2;
    const size_t tstep = 2 * hstep;
    const unsigned ldsw = (unsigned)wid * 1024u;
    const int aoff = lds_byte(wr * 64 + fr, fq * 8), boff = lds_byte(wc * 32 + fr, fq * 8);
#define PG8_SA(b, h) (((b) * 2 + (h)) * HTB)
#define PG8_SB(b, h) ((4 + (b) * 2 + (h)) * HTB)
#define PG8_STAGE(bufoff, gbase, voff) do { _Pragma("unroll") for (int _i = 0; _i < 2; ++_i) \
        __builtin_amdgcn_global_load_lds((const unsigned*)((const char*)(gbase) + (voff)[_i]), (PG8_LAS unsigned*)(lds + (bufoff) + ldsw + _i * 8192), 16, 0, 0); } while (0)
#define PG8_LDA(dst, b, h) do { _Pragma("unroll") for (int m = 0; m < 4; ++m) _Pragma("unroll") for (int k = 0; k < 2; ++k) dst[m][k] = *(const PG8_LAS bf16x8*)(lds + PG8_SA(b, h) + aoff + m * 2048 + k * 1024); } while (0)
#define PG8_LDB(dst, b, h) do { _Pragma("unroll") for (int n = 0; n < 2; ++n) _Pragma("unroll") for (int k = 0; k < 2; ++k) dst[n][k] = *(const PG8_LAS bf16x8*)(lds + PG8_SB(b, h) + boff + n * 2048 + k * 1024); } while (0)
#define PG8_MMA(ai, bj, At, Bt) do { __builtin_amdgcn_s_setprio(1); _Pragma("unroll") for (int m = 0; m < 4; ++m) _Pragma("unroll") for (int n = 0; n < 2; ++n) _Pragma("unroll") for (int k = 0; k < 2; ++k) \
        acc[ai][bj][m][n] = __builtin_amdgcn_mfma_f32_16x16x32_bf16(Bt[n][k], At[m][k], acc[ai][bj][m][n], 0, 0, 0); __builtin_amdgcn_s_setprio(0); } while (0)
#define PG8_WAIT_V(n) asm volatile("s_waitcnt vmcnt(" #n ")" ::: "memory")
#define PG8_WAIT_L(n) asm volatile("s_waitcnt lgkmcnt(" #n ")" ::: "memory")
#define PG8_BAR __builtin_amdgcn_s_barrier()
#define PG8_SCHED __builtin_amdgcn_sched_barrier(0)
    Unit cur, nxt; int ui = 0;
    if (!S.next(0, cur)) return;
    f32x4 acc[2][2][4][2];
#pragma unroll
    for (int a = 0; a < 2; ++a)
#pragma unroll
        for (int b = 0; b < 2; ++b)
#pragma unroll
            for (int m = 0; m < 4; ++m)
#pragma unroll
                for (int n = 0; n < 2; ++n) acc[a][b][m][n] = (f32x4){0.f, 0.f, 0.f, 0.f};
    bf16x8 At[4][2], B0[2][2], B1[2][2];
    const char* cA = (const char*)g.A + (size_t)cur.pm * tstep; const char* cB = (const char*)g.Bt + (size_t)cur.pn * tstep;
    S.a_ready(cur);
    if constexpr (SP2) {
        PG8_STAGE(PG8_SB(0, 0), cB, voffB); PG8_STAGE(PG8_SB(0, 1), cB + hstep, voffB); PG8_STAGE(PG8_SA(0, 0), cA, voffA); PG8_STAGE(PG8_SA(0, 1), cA + hstep, voffA);
        if (wr == 1) PG8_BAR;
        PG8_WAIT_V(2); PG8_BAR;
        PG8_STAGE(PG8_SB(1, 0), cB + kstep, voffB); PG8_STAGE(PG8_SA(1, 0), cA + kstep, voffA); PG8_STAGE(PG8_SB(1, 1), cB + hstep + kstep, voffB);
        PG8_WAIT_V(6); PG8_BAR;
    } else {
        PG8_STAGE(PG8_SB(0, 0), cB, voffB); PG8_STAGE(PG8_SA(0, 0), cA, voffA); PG8_STAGE(PG8_SB(0, 1), cB + hstep, voffB); PG8_STAGE(PG8_SA(0, 1), cA + hstep, voffA);
        if (wr == 1) PG8_BAR;
        PG8_WAIT_V(4); PG8_BAR;
        PG8_STAGE(PG8_SB(1, 0), cB + kstep, voffB); PG8_STAGE(PG8_SA(1, 0), cA + kstep, voffA); PG8_STAGE(PG8_SB(1, 1), cB + hstep + kstep, voffB);
        PG8_WAIT_V(6); PG8_BAR;
    }
    for (;;) {
        const bool has_next = S.next(ui + 1, nxt);
        const char* nA = has_next ? (const char*)g.A + (size_t)nxt.pm * tstep : cA; const char* nB = has_next ? (const char*)g.Bt + (size_t)nxt.pn * tstep : cB;
        for (int t = 0; t < nt; t += 2) {
            const bool last = (t == nt - 2);
            const char* a1 = cA + (size_t)(t + 1) * kstep;
            const char* a2 = last ? nA : cA + (size_t)(t + 2) * kstep; const char* b2 = last ? nB : cB + (size_t)(t + 2) * kstep;
            const char* a3 = a2 + kstep; const char* b3 = b2 + kstep;
            if (last && has_next) S.a_ready(nxt);
            if constexpr (SP2) {
            PG8_LDB(B0, 0, 0); PG8_LDB(B1, 0, 1); PG8_SCHED; PG8_LDA(At, 0, 0); PG8_STAGE(PG8_SA(1, 1), a1 + hstep, voffA);
            PG8_WAIT_V(8); PG8_WAIT_L(0); PG8_BAR; PG8_MMA(0, 0, At, B0); PG8_MMA(0, 1, At, B1); PG8_BAR; PG8_SCHED;
            PG8_LDA(At, 0, 1); PG8_STAGE(PG8_SB(0, 0), b2, voffB); PG8_STAGE(PG8_SB(0, 1), b2 + hstep, voffB); PG8_STAGE(PG8_SA(0, 0), a2, voffA);
            PG8_WAIT_V(8); PG8_WAIT_L(0); PG8_BAR; PG8_MMA(1, 0, At, B0); PG8_MMA(1, 1, At, B1); PG8_BAR; PG8_SCHED;
            PG8_LDB(B0, 1, 0); PG8_LDB(B1, 1, 1); PG8_SCHED; PG8_LDA(At, 1, 0); PG8_STAGE(PG8_SA(0, 1), a2 + hstep, voffA);
            PG8_WAIT_V(8); PG8_WAIT_L(0); PG8_BAR; PG8_MMA(0, 0, At, B0); PG8_MMA(0, 1, At, B1); PG8_BAR; PG8_SCHED;
            PG8_LDA(At, 1, 1); PG8_STAGE(PG8_SB(1, 0), b3, voffB); PG8_STAGE(PG8_SB(1, 1), b3 + hstep, voffB); PG8_STAGE(PG8_SA(1, 0), a3, voffA);
            PG8_WAIT_V(8); PG8_WAIT_L(0); PG8_BAR; PG8_MMA(1, 0, At, B0); PG8_MMA(1, 1, At, B1); PG8_BAR; PG8_SCHED;
            } else {
            PG8_LDB(B0, 0, 0); PG8_SCHED; PG8_LDA(At, 0, 0); PG8_STAGE(PG8_SA(1, 1), a1 + hstep, voffA);
            PG8_WAIT_L(8); PG8_BAR; PG8_WAIT_L(0); PG8_MMA(0, 0, At, B0); PG8_BAR; PG8_SCHED;
            PG8_LDB(B1, 0, 1); PG8_STAGE(PG8_SB(0, 0), b2, voffB);
            PG8_BAR; PG8_WAIT_L(0); PG8_MMA(0, 1, At, B1); PG8_BAR;
            PG8_LDA(At, 0, 1); PG8_STAGE(PG8_SA(0, 0), a2, voffA);
            PG8_BAR; PG8_WAIT_L(0); PG8_MMA(1, 0, At, B0); PG8_BAR; PG8_SCHED;
            PG8_STAGE(PG8_SB(0, 1), b2 + hstep, voffB);
            PG8_WAIT_V(6); PG8_BAR; PG8_MMA(1, 1, At, B1); PG8_BAR;
            PG8_LDB(B0, 1, 0); PG8_SCHED; PG8_LDA(At, 1, 0); PG8_STAGE(PG8_SA(0, 1), a2 + hstep, voffA);
            PG8_WAIT_L(8); PG8_BAR; PG8_WAIT_L(0); PG8_MMA(0, 0, At, B0); PG8_BAR; PG8_SCHED;
            PG8_LDB(B1, 1, 1); PG8_STAGE(PG8_SB(1, 0), b3, voffB);
            PG8_BAR; PG8_WAIT_L(0); PG8_MMA(0, 1, At, B1); PG8_BAR;
            PG8_LDA(At, 1, 1); PG8_STAGE(PG8_SA(1, 0), a3, voffA);
            PG8_BAR; PG8_WAIT_L(0); PG8_MMA(1, 0, At, B0); PG8_BAR; PG8_SCHED;
            PG8_STAGE(PG8_SB(1, 1), b3 + hstep, voffB);
            PG8_WAIT_V(6); PG8_BAR; PG8_MMA(1, 1, At, B1); PG8_BAR;
            }
        }
        if constexpr (ALIGN_EPI) { if (wr == 0) PG8_BAR; }
        if constexpr (!Epi::AFTER_DRAIN) { E(acc, cur, wr, wc, fr, fq); S.done(cur); }
        if (!has_next) break;
#pragma unroll
        for (int a = 0; a < 2; ++a)
#pragma unroll
            for (int b = 0; b < 2; ++b)
#pragma unroll
                for (int m = 0; m < 4; ++m)
#pragma unroll
                    for (int n = 0; n < 2; ++n) acc[a][b][m][n] = (f32x4){0.f, 0.f, 0.f, 0.f};
        cur = nxt; cA = nA; cB = nB; ++ui;
        if constexpr (ALIGN_EPI) { if (wr == 1) PG8_BAR; }
    }
    PG8_WAIT_V(0);
    if constexpr (!ALIGN_EPI) { if (wr == 0) PG8_BAR; }
    PG8_BAR;
    if constexpr (Epi::AFTER_DRAIN) { E.fused(acc, cur, wr, wc, fr, fq, lds, wid, lane); S.done(cur); }
#undef PG8_SA
#undef PG8_SB
#undef PG8_STAGE
#undef PG8_LDA
#undef PG8_LDB
#undef PG8_MMA
#undef PG8_WAIT_V
#undef PG8_WAIT_L
#undef PG8_BAR
#undef PG8_SCHED
}
}
namespace pg8 {
struct EpiInProj {
    static constexpr bool PERM = true, AFTER_DRAIN = false;
    ::bf16_t* P; const float* tabA; const float* tabB; const float* qn_g; const float* kn_g;
    __device__ __forceinline__ void operator()(const f32x4 (&acc)[2][2][4][2], const Unit& u, int wr_, int wc_, int fr_, int fq_) const {
        const int fr = opaque_v(fr_), fq = opaque_v(fq_), wr = opaque_s(wr_), wc = opaque_s(wc_);
        const int pn = u.pn, m0 = u.pm * BM; const int t0 = m0 % T; const bool lat = t0 < S;
        int type = 0; float qs = 1.f; const float* g = nullptr;
        if (pn == 0) { type = 3; qs = C2A; g = qn_g; }
        else if (pn == 1) { if (wc < 2) { type = 3; g = kn_g; } }
        else if (pn == 2 || pn == 6 || pn == 10 || pn == 12) type = 1;
        else if (pn == 3) { type = 4; qs = C2B; }
        else if (pn == 4) type = 4;
        else if (pn == 7) { type = 2; qs = C2A; }
        ::bf16_t* base = P + (size_t)(m0 + wr * 64 + fr) * NP + 256 * pn + 64 * wc + 8 * fq;
        f32x4 gv[2][2];
        if (type == 3) {
#pragma unroll
            for (int bj = 0; bj < 2; ++bj)
#pragma unroll
                for (int n = 0; n < 2; ++n) gv[bj][n] = *(const f32x4*)(g + 32 * bj + 16 * n + 4 * fq);
        }
#pragma unroll
        for (int ai = 0; ai < 2; ++ai) {
            const int prow = (t0 >> 6) + 2 * ai + wr;
#pragma unroll
            for (int m = 0; m < 4; ++m) {
                f32x4 v[2][2];
#pragma unroll
                for (int bj = 0; bj < 2; ++bj)
#pragma unroll
                    for (int n = 0; n < 2; ++n) v[bj][n] = acc[ai][bj][m][n];
                const int pcol = 16 * m + fr;
                if (type == 1) {
#pragma unroll
                    for (int bj = 0; bj < 2; ++bj)
#pragma unroll
                        for (int n = 0; n < 2; ++n)
#pragma unroll
                            for (int e = 0; e < 4; ++e) v[bj][n][e] = silu_f(v[bj][n][e]);
                } else if (type == 2) {
#pragma unroll
                    for (int bj = 0; bj < 2; ++bj)
#pragma unroll
                        for (int n = 0; n < 2; ++n) v[bj][n] = v[bj][n] * qs;
                } else if (type == 3) {
                    float ss = 0.f;
#pragma unroll
                    for (int bj = 0; bj < 2; ++bj)
#pragma unroll
                        for (int n = 0; n < 2; ++n) ss += (v[bj][n][0] * v[bj][n][0] + v[bj][n][1] * v[bj][n][1]) + (v[bj][n][2] * v[bj][n][2] + v[bj][n][3] * v[bj][n][3]);
                    ss += __shfl_xor(ss, 16); ss += __shfl_xor(ss, 32);
                    const float rs = rsqrtf(ss * (1.f / 64.f) + RMS_EPS);
#pragma unroll
                    for (int bj = 0; bj < 2; ++bj)
#pragma unroll
                        for (int n = 0; n < 2; ++n) v[bj][n] = v[bj][n] * rs * gv[bj][n];
                    if (lat) {
#pragma unroll
                        for (int bj = 0; bj < 2; ++bj) {
                            const int pos = bj == 0 ? prow : pcol;
                            const f32x4 t0v = *(const f32x4*)(tabA + (pos * 16 + 4 * fq) * 2), t1v = *(const f32x4*)(tabA + (pos * 16 + 4 * fq) * 2 + 4);
                            const float cs[4] = {t0v[0], t0v[2], t1v[0], t1v[2]}, sn[4] = {t0v[1], t0v[3], t1v[1], t1v[3]};
#pragma unroll
                            for (int e = 0; e < 4; ++e) { const float x1 = v[bj][0][e], x2 = v[bj][1][e]; v[bj][0][e] = x1 * cs[e] - x2 * sn[e]; v[bj][1][e] = x1 * sn[e] + x2 * cs[e]; }
                        }
                    }
                    if (qs != 1.f) {
#pragma unroll
                        for (int bj = 0; bj < 2; ++bj)
#pragma unroll
                            for (int n = 0; n < 2; ++n) v[bj][n] = v[bj][n] * qs;
                    }
                } else if (type == 4) {
                    if (lat) {
                        const int pos = (fq >> 1) == 0 ? prow : pcol;
                        const f32x4 t0v = *(const f32x4*)(tabB + (pos * 8 + 4 * (fq & 1)) * 2), t1v = *(const f32x4*)(tabB + (pos * 8 + 4 * (fq & 1)) * 2 + 4);
                        const float cs[4] = {t0v[0], t0v[2], t1v[0], t1v[2]}, sn[4] = {t0v[1], t0v[3], t1v[1], t1v[3]};
#pragma unroll
                        for (int bj = 0; bj < 2; ++bj)
#pragma unroll
                            for (int e = 0; e < 4; ++e) { const float x1 = v[bj][0][e], x2 = v[bj][1][e]; v[bj][0][e] = x1 * cs[e] - x2 * sn[e]; v[bj][1][e] = x1 * sn[e] + x2 * cs[e]; }
                    }
                    if (qs != 1.f) {
#pragma unroll
                        for (int bj = 0; bj < 2; ++bj)
#pragma unroll
                            for (int n = 0; n < 2; ++n) v[bj][n] = v[bj][n] * qs;
                    }
                }
                ::bf16_t* rowp = base + (size_t)(ai * HALF + m * 16) * NP;
#pragma unroll
                for (int bj = 0; bj < 2; ++bj) {
                    u32x4 w; w.x = cvt_pk_bf16(v[bj][0][0], v[bj][0][1]); w.y = cvt_pk_bf16(v[bj][0][2], v[bj][0][3]); w.z = cvt_pk_bf16(v[bj][1][0], v[bj][1][1]); w.w = cvt_pk_bf16(v[bj][1][2], v[bj][1][3]);
                    *(u32x4*)(rowp + 32 * bj) = w;
                }
            }
        }
    }
};
struct EpiOutProj {
    static constexpr bool PERM = false, AFTER_DRAIN = false;
    float* xl; float* xc; const float* mod_l;
    __device__ __forceinline__ void operator()(const f32x4 (&acc)[2][2][4][2], const Unit& u, int wr_, int wc_, int fr_, int fq_) const {
        const int fr = opaque_v(fr_), fq = opaque_v(fq_), wr = opaque_s(wr_), wc = opaque_s(wc_);
        const int m0 = u.pm * BM; const int b = m0 / T, t0 = m0 - b * T;
        float* xb = t0 < S ? xl + ((size_t)b * S + t0) * D : xc + ((size_t)b * CT + (t0 - S)) * D;
        const float* gate = mod_l + (size_t)(t0 < S ? b : 4) * 3 * D + 2 * D;
        const int col0 = u.pn * BM + wc * 32 + 4 * fq;
        f32x4 gv[2][2];
#pragma unroll
        for (int bj = 0; bj < 2; ++bj)
#pragma unroll
            for (int n = 0; n < 2; ++n) gv[bj][n] = *(const f32x4*)(gate + col0 + bj * HALF + n * 16);
#pragma unroll
        for (int ai = 0; ai < 2; ++ai)
#pragma unroll
            for (int m = 0; m < 4; ++m) {
                float* xr = xb + (size_t)(ai * HALF + wr * 64 + m * 16 + fr) * D + col0;
#pragma unroll
                for (int bj = 0; bj < 2; ++bj)
#pragma unroll
                    for (int n = 0; n < 2; ++n) { const f32x4 xv = *(const f32x4*)(xr + bj * HALF + n * 16); *(f32x4*)(xr + bj * HALF + n * 16) = xv * ALPHA + gv[bj][n] * acc[ai][bj][m][n]; }
            }
    }
};
struct EpiGlu {
    static constexpr bool PERM = true, AFTER_DRAIN = false;
    ::bf16_t* Y; const ::bf16_t* P;
    __device__ __forceinline__ void operator()(const f32x4 (&acc)[2][2][4][2], const Unit& u, int wr_, int wc_, int fr_, int fq_) const {
        const int fr = opaque_v(fr_), fq = opaque_v(fq_), wr = opaque_s(wr_), wc = opaque_s(wc_);
        const int m0 = u.pm * BM, col8 = 128 * u.pn + 32 * wc + 8 * fq;
#pragma unroll
        for (int ai = 0; ai < 2; ++ai)
#pragma unroll
            for (int m = 0; m < 4; ++m) {
                const size_t row = (size_t)(m0 + ai * HALF + wr * 64 + m * 16 + fr);
                const u32x4 gt = *(const u32x4*)(P + row * NP + DG + col8);
                float o[8];
#pragma unroll
                for (int n = 0; n < 2; ++n)
#pragma unroll
                    for (int e = 0; e < 4; ++e) { const float v = acc[ai][0][m][n][e], g = acc[ai][1][m][n][e]; o[4 * n + e] = v * sigm_f(g); }
                u32x4 w;
#pragma unroll
                for (int e = 0; e < 4; ++e) { const float ga = __uint_as_float(gt[e] << 16), gb = __uint_as_float(gt[e] & 0xffff0000u); w[e] = cvt_pk_bf16(o[2 * e] * ga, o[2 * e + 1] * gb); }
                *(u32x4*)(Y + row * D + 768 + col8) = w;
            }
    }
};
}
__device__ __forceinline__ float wave_sum(float v) {
#pragma unroll
    for (int o = 1; o < 64; o <<= 1) v += __shfl_xor(v, o);
    return v;
}
__device__ __forceinline__ void transpose_item(const float* W, int K, int N, bf16_t* WT, int kb, int nphys0, int lbase, int pt, LAS float* scr, int lane) {
    const int k0 = 64 * kb;
#pragma unroll 8
    for (int i = 0; i < 32; ++i) { const int kk = 2 * i + (lane >> 5); scr[kk * 33 + (lane & 31)] = W[(size_t)(k0 + kk) * N + lbase + (lane & 31)]; }
    asm volatile("s_waitcnt lgkmcnt(0)" ::: "memory");
    const int c = lane & 7;
#pragma unroll
    for (int j = 0; j < 4; ++j) {
        const int n = (lane >> 3) + 8 * j; const int fq = n >> 3, nn = (n >> 2) & 1, e = n & 3;
        const int lo = pt == 0 ? n : pt == 1 ? 16 * nn + 4 * fq + e : 16 * (fq >> 1) + 8 * nn + 4 * (fq & 1) + e;
        const LAS float* s = scr + (8 * c) * 33 + lo;
        u32x4 o; o.x = pk2(s[0 * 33], s[1 * 33]); o.y = pk2(s[2 * 33], s[3 * 33]); o.z = pk2(s[4 * 33], s[5 * 33]); o.w = pk2(s[6 * 33], s[7 * 33]);
        *(u32x4*)(WT + (size_t)(nphys0 + n) * K + k0 + 8 * c) = o;
    }
    asm volatile("s_waitcnt lgkmcnt(0)" ::: "memory");
}
__device__ __forceinline__ void phase_prologue(const Params& p, const KArgs& ka, LAS unsigned char* lds, int gw, int ngw, int wave, int lane) {
    {
        float* sm = (float*)(ka.ws + O_SMALL);
#pragma unroll
        for (int i = 0; i < 18; ++i) { const float* src = ka.in[8 + i]; float* dst = sm + sm_off(i); for (int e = gw * 64 + lane; e < SM_N[i]; e += ngw * 64) dst[e] = src[e]; }
    }
    LAS float* sc5 = (LAS float*)lds;
    LAS float* scr = (LAS float*)(lds + 20480 + wave * 9216);
    for (int i = threadIdx.x; i < 5 * D; i += NTHR) { const float v = i < 4 * D ? p.c[i] : p.c_ctx[i - 4 * D]; sc5[i] = v / (1.f + expf(-v)); }
    __syncthreads();
    for (int it = gw; it < NL * 48; it += ngw) {
        const int l = it / 48, j = (it % 48) * 64 + lane;
        const float* w = p.w_ada + (size_t)l * D * 3 * D + j;
        float a0 = 0.f, a1 = 0.f, a2 = 0.f, a3 = 0.f, a4 = 0.f;
#pragma unroll 8
        for (int k = 0; k < D; ++k) { const float wv = w[(size_t)k * 3 * D]; a0 += sc5[k] * wv; a1 += sc5[D + k] * wv; a2 += sc5[2 * D + k] * wv; a3 += sc5[3 * D + k] * wv; a4 += sc5[4 * D + k] * wv; }
        const float bb = p.b_ada[l * 3 * D + j]; float* o = p.mod + (size_t)l * 5 * 3 * D + j;
        o[0] = a0 + bb; o[3 * D] = a1 + bb; o[6 * D] = a2 + bb; o[9 * D] = a3 + bb; o[12 * D] = a4 + bb;
    }
    for (int i = gw * 64 + lane; i < 64 * 16 + 64 * 8; i += ngw * 64) {
        if (i < 1024) { const int pos = i >> 4, k = i & 15; const float an = (float)pos * powf(10000.f, -(float)k / 16.f); p.tabA[2 * i] = cosf(an); p.tabA[2 * i + 1] = sinf(an); }
        else { const int j = i - 1024, pos = j >> 3, k = j & 7; const float an = (float)pos * powf(10000.f, -(float)k / 8.f); p.tabB[2 * j] = cosf(an); p.tabB[2 * j + 1] = sinf(an); }
    }
    constexpr int I_IN = 16 * 104, I_OUT = 16 * 32, I_GLU = 4 * 16, I_L = I_IN + I_OUT + I_GLU;
    for (int it = gw; it < NL * I_L; it += ngw) {
        const int l = it / I_L; int r = it % I_L;
        if (r < I_IN) {
            const int kb = r / 104, nb = r % 104, c = 32 * nb, pn = c >> 8, bj = (c >> 7) & 1, wc = (c >> 5) & 3;
            const int pt = (pn == 0 || (pn == 1 && wc < 2)) ? 1 : (pn == 3 || pn == 4) ? 2 : 0;
            transpose_item(p.w_in + (size_t)l * D * NP, D, NP, p.Win_t + (size_t)l * NP * D, kb, c, 256 * pn + 64 * wc + 32 * bj, pt, scr, lane);
        } else if ((r -= I_IN) < I_OUT) {
            const int kb = r / 32, nb = r % 32;
            transpose_item(p.w_out + (size_t)l * D * D, D, D, p.Wout_t + (size_t)l * D * D, kb, 32 * nb, 32 * nb, 0, scr, lane);
        } else {
            r -= I_OUT; const int kb = r / 16, nb = r % 16, c = 32 * nb, pn = c >> 8, bj = (c >> 7) & 1, wc = (c >> 5) & 3;
            transpose_item(p.w_glu + (size_t)l * 256 * 512, 256, 512, p.Wglu_t + (size_t)l * 512 * 256, kb, c, 256 * bj + 128 * pn + 32 * wc, 0, scr, lane);
        }
    }
}
__device__ __forceinline__ void phase_rows(const Params& p, int l_prev, int l_next, int gw, int ngw, int lane) {
    for (int m = gw; m < MT; m += ngw) {
        const int b = m / T, t = m - b * T; const bool lat = t < S;
        if (l_next == NL && !lat) continue;
        float* xr = lat ? p.xl + ((size_t)b * S + t) * D : p.xc + ((size_t)b * CT + (t - S)) * D;
        f32x4 v[4];
        if (l_prev < 0) {
            const float* src = lat ? p.x + ((size_t)b * S + t) * D : p.ctx + ((size_t)b * CT + (t - S)) * D;
#pragma unroll
            for (int j = 0; j < 4; ++j) { v[j] = *(const f32x4*)(src + 4 * lane + 256 * j); *(f32x4*)(xr + 4 * lane + 256 * j) = v[j]; }
        } else {
            float s = 0.f;
#pragma unroll
            for (int j = 0; j < 4; ++j) { v[j] = *(const f32x4*)(xr + 4 * lane + 256 * j); s += (v[j][0] + v[j][1]) + (v[j][2] + v[j][3]); }
            const float mean = wave_sum(s) * (1.f / D); float q = 0.f;
#pragma unroll
            for (int j = 0; j < 4; ++j) { v[j] = v[j] - mean; q += (v[j][0] * v[j][0] + v[j][1] * v[j][1]) + (v[j][2] * v[j][2] + v[j][3] * v[j][3]); }
            const float rstd = rsqrtf(wave_sum(q) * (1.f / D) + LN_EPS);
#pragma unroll
            for (int j = 0; j < 4; ++j) {
                const f32x4 g = *(const f32x4*)(p.ln_g + l_prev * D + 4 * lane + 256 * j), be = *(const f32x4*)(p.ln_b + l_prev * D + 4 * lane + 256 * j);
                v[j] = v[j] * rstd * g + be; *(f32x4*)(xr + 4 * lane + 256 * j) = v[j];
            }
        }
        if (l_next < NL) {
            const float* md = p.mod + ((size_t)l_next * 5 + (lat ? b : 4)) * 3 * D;
            bf16_t* ar = p.A + (size_t)m * D;
#pragma unroll
            for (int j = 0; j < 4; ++j) {
                const f32x4 sh = *(const f32x4*)(md + 4 * lane + 256 * j), sc = *(const f32x4*)(md + D + 4 * lane + 256 * j);
                const f32x4 h = v[j] * (sc + 1.f) + sh;
                u32x2 w; w.x = pk2(h[0], h[1]); w.y = pk2(h[2], h[3]); *(u32x2*)(ar + 4 * lane + 256 * j) = w;
            }
        }
    }
}
namespace att {
typedef short bf16x8 __attribute__((ext_vector_type(8)));
typedef short s16x4 __attribute__((ext_vector_type(4)));
typedef float f32x16 __attribute__((ext_vector_type(16)));
typedef float f32x2_t __attribute__((ext_vector_type(2)));
typedef __bf16 bf16x2_t __attribute__((ext_vector_type(2)));
constexpr int SLOT = 16384, L_RING = 0, L_OST = 49152, L_WSF = L_OST + 8 * 8192, L_RPB = L_WSF + 8 * 256, L_END = L_RPB + 2048;
constexpr float THR = 6.f;
#define ATT_MFMA(a, b, c) __builtin_amdgcn_mfma_f32_32x32x16_bf16(a, b, c, 0, 0, 0)
#define ATT_WAIT_BAR(N) asm volatile("s_waitcnt vmcnt(" #N ") lgkmcnt(0)\n\ts_barrier" ::: "memory")
__device__ __forceinline__ int crow(int r, int hi) { return (r & 3) + 8 * (r >> 2) + 4 * hi; }
__device__ __forceinline__ unsigned cvtpk(float lo, float hi) { f32x2_t v = {lo, hi}; bf16x2_t b = __builtin_convertvector(v, bf16x2_t); return __builtin_bit_cast(unsigned, b); }
__device__ __forceinline__ void glds16(const void* g, unsigned lds_base) {
    unsigned sv; asm volatile("s_mov_b32 %0, m0\n\ts_mov_b32 m0, %2\n\ts_nop 0\n\tglobal_load_lds_dwordx4 %1, off\n\ts_mov_b32 m0, %0" : "=&s"(sv) : "v"(g), "s"(lds_base) : "memory"); }
#define ATT_MX3(a, b, c) __builtin_fmaxf(__builtin_fmaxf((a), (b)), (c))
__device__ __forceinline__ float rowmax(const f32x16& p0, const f32x16& p1) {
    float a = ATT_MX3(p0[0], p0[1], p1[0]), b = ATT_MX3(p0[2], p0[3], p1[1]); a = ATT_MX3(a, p1[2], p1[3]);
#pragma unroll
    for (int r = 4; r < 16; r += 4) { a = ATT_MX3(a, p0[r], p0[r + 1]); b = ATT_MX3(b, p0[r + 2], p0[r + 3]); a = ATT_MX3(a, p1[r], p1[r + 1]); b = ATT_MX3(b, p1[r + 2], p1[r + 3]); }
    float m = __builtin_fmaxf(a, b); auto rr = __builtin_amdgcn_permlane32_swap(__float_as_uint(m), __float_as_uint(m), false, false);
    return __builtin_fmaxf(__uint_as_float(rr[0]), __uint_as_float(rr[1])); }
__device__ __forceinline__ float rowsum(const f32x16& p0, const f32x16& p1) {
    float a = 0.f, b = 0.f;
#pragma unroll
    for (int r = 0; r < 16; r += 2) { a += p0[r] + p1[r]; b += p0[r + 1] + p1[r + 1]; }
    return a + b; }
__device__ __forceinline__ void vfrags(bf16x8 (&vf)[4], int vb, int d0) {
    s16x4 lo[4], hi[4];
    if (d0 == 0) {
#pragma unroll
        for (int ks = 0; ks < 4; ++ks) {
            asm volatile("ds_read_b64_tr_b16 %0,%1 offset:%c2" : "=&v"(lo[ks]) : "v"(vb), "i"(ks * 1024) : "memory");
            asm volatile("ds_read_b64_tr_b16 %0,%1 offset:%c2" : "=&v"(hi[ks]) : "v"(vb), "i"(ks * 1024 + 512) : "memory"); }
    } else {
#pragma unroll
        for (int ks = 0; ks < 4; ++ks) {
            asm volatile("ds_read_b64_tr_b16 %0,%1 offset:%c2" : "=&v"(lo[ks]) : "v"(vb), "i"(4096 + ks * 1024) : "memory");
            asm volatile("ds_read_b64_tr_b16 %0,%1 offset:%c2" : "=&v"(hi[ks]) : "v"(vb), "i"(4096 + ks * 1024 + 512) : "memory"); }
    }
    asm volatile("s_waitcnt lgkmcnt(0)" : "+v"(lo[0]), "+v"(lo[1]), "+v"(lo[2]), "+v"(lo[3]), "+v"(hi[0]), "+v"(hi[1]), "+v"(hi[2]), "+v"(hi[3]) :: "memory");
#pragma unroll
    for (int ks = 0; ks < 4; ++ks) vf[ks] = (bf16x8){lo[ks][0], lo[ks][1], lo[ks][2], lo[ks][3], hi[ks][0], hi[ks][1], hi[ks][2], hi[ks][3]};
}
struct PW { u32x4 w[4]; };
__device__ __forceinline__ void packp(PW& pw, const f32x16& p0, const f32x16& p1) {
#pragma unroll
    for (int i = 0; i < 4; ++i) { pw.w[0][i] = cvtpk(p0[2 * i], p0[2 * i + 1]); pw.w[1][i] = cvtpk(p0[8 + 2 * i], p0[9 + 2 * i]); pw.w[2][i] = cvtpk(p1[2 * i], p1[2 * i + 1]); pw.w[3][i] = cvtpk(p1[8 + 2 * i], p1[9 + 2 * i]); }
}
__device__ __forceinline__ bool softmax_tile(f32x16& p0, f32x16& p1, float& mhat, float& l_reg, float& f, bool first) {
    const float rm = rowmax(p0, p1);
    bool resc = false; f = 1.f;
    if (first || __any(rm > THR)) {
        const float dl = first ? rm : __builtin_fmaxf(rm, 0.f); mhat += dl;
#pragma unroll
        for (int r = 0; r < 16; ++r) { p0[r] -= dl; p1[r] -= dl; }
        if (!first) { f = __builtin_amdgcn_exp2f(-dl); l_reg *= f; resc = true; }
    }
#pragma unroll
    for (int r = 0; r < 16; ++r) { p0[r] = __builtin_amdgcn_exp2f(p0[r]); p1[r] = __builtin_amdgcn_exp2f(p1[r]); }
    l_reg += rowsum(p0, p1);
    return resc;
}
struct UnitDesc { int var, b, h, kvh, qrow0, f0, n0, f1, n1; };
struct LayerConst { int l; float lam, one_m_lam_init; };

template <int VAR> __device__ __forceinline__ void attn_unit(const Params& p, const UnitDesc& u, const LayerConst& lc, LAS unsigned char* lds, int tid_in) {
    const int tid = opaque_v(tid_in), lane = tid & 63, r32 = lane & 31, hi = lane >> 5; const int wid = __builtin_amdgcn_readfirstlane(tid >> 6);
    constexpr int QOFF = VAR == 0 ? AQ : VAR == 1 ? BQ : CQ, KOFF = VAR == 0 ? AK : VAR == 1 ? BK : CK, VOFF = VAR == 0 ? AV : VAR == 1 ? BV : CV, GOFF = VAR == 0 ? AG : VAR == 1 ? BG : CG, YOFF = VAR * 256;
    const size_t rowb = (size_t)u.b * T;
    const unsigned lds0 = (unsigned)(uintptr_t)lds;
    LAS float* wsf = (LAS float*)(lds + L_WSF) + wid * 64;
    LAS float* ost = (LAS float*)(lds + L_OST) + wid * 2048;
    LAS float* rpbL = (LAS float*)(lds + L_RPB);
    const int NT = u.n0 + u.n1;
    const bf16_t* kbase = p.P + (rowb + lane) * NP + KOFF + u.kvh * 64 + wid * 8;
    const bf16_t* vbase = p.P + (rowb + 16 * (wid & 3) + (lane >> 2)) * NP + VOFF + u.kvh * 64 + (wid >> 2) * 32 + (lane & 3) * 8;
#define ATT_TROW(j) (((j) < u.n0 ? u.f0 + (j) : u.f1 + ((j) - u.n0)) * 64)
#define ATT_DMA(j, slot) do { const size_t ro_ = (size_t)ATT_TROW(j) * NP; \
        glds16(kbase + ro_, (unsigned)__builtin_amdgcn_readfirstlane(lds0 + L_RING + (slot) * SLOT + wid * 1024)); \
        glds16(vbase + ro_, (unsigned)__builtin_amdgcn_readfirstlane(lds0 + L_RING + (slot) * SLOT + 8192 + wid * 1024)); } while (0)
    ATT_DMA(0, 0);
    if (NT > 1) ATT_DMA(1, 1);
    if (VAR == 2) { for (int i = tid; i < 15 * 31; i += NTHR) rpbL[i] = p.rpb[((size_t)lc.l * 4 + u.h) * 15 * 31 + i] * LOG2E; }
    const bf16_t* qp = p.P + (rowb + u.qrow0 + wid * 32 + r32) * NP + QOFF + u.h * 64 + hi * 8;
    bf16x8 qr[4];
#pragma unroll
    for (int d0 = 0; d0 < 4; ++d0) qr[d0] = *(const bf16x8*)(qp + d0 * 16);
    const int qt = u.qrow0 + wid * 32 + r32; const int gr = qt >> 6, gwc = qt & 63;
    const int rs0 = min(max(gr - 4, 0), 56), cs0 = min(max(gwc - 8, 0), 48);
    const bool latq = u.qrow0 < S;
    f32x16 o[2], o2[2]; o[0] = f32x16{}; o[1] = f32x16{}; o2[0] = f32x16{}; o2[1] = f32x16{};
    float mhat = 0.f, l_reg = 0.f, mhat2 = 0.f, l_reg2 = 0.f;
    f32x16 negm = f32x16{}, negm2 = f32x16{};
    bool started = false;
    for (int j = 0; j < NT; ++j) {
        if (j + 1 < NT) ATT_WAIT_BAR(2); else ATT_WAIT_BAR(0);
        if (j + 2 < NT) { const int s2 = (j + 2) % 3; ATT_DMA(j + 2, s2); }
        const int sl = (j % 3) * SLOT;
        const int trow = ATT_TROW(j);
        bool active = true; const bool wintile = (VAR == 2) && latq && trow < S;
        if (wintile) { const int kr = trow >> 6; active = (kr >= rs0) && (kr < rs0 + 8); }
        if (!active) continue;
        const LAS unsigned char* kp = lds + L_RING + sl + hi * 1024 + r32 * 16;
        const int vb = (int)(lds0 + L_RING + sl + 8192) + ((lane >> 4) & 1) * 32 + (lane & 3) * 8 + (4 * hi + ((lane & 15) >> 2)) * 64;
        if (VAR != 1) {
            f32x16 p0, p1;
#pragma unroll
            for (int d0 = 0; d0 < 4; ++d0) {
                const bf16x8 b0 = *(const LAS bf16x8*)(kp + d0 * 2048), b1 = *(const LAS bf16x8*)(kp + d0 * 2048 + 512);
                p0 = ATT_MFMA(b0, qr[d0], d0 == 0 ? negm : p0); p1 = ATT_MFMA(b1, qr[d0], d0 == 0 ? negm : p1);
            }
            if (wintile) {
                const int kr = trow >> 6; const LAS float* brow = rpbL + (kr - gr + 7) * 31 + 15 - gwc;
#pragma unroll
                for (int r = 0; r < 16; ++r) {
                    const int kc = crow(r, hi);
                    p0[r] = ((unsigned)(kc - cs0) < 16u) ? p0[r] + brow[kc] : -INFINITY;
                    p1[r] = ((unsigned)(kc + 32 - cs0) < 16u) ? p1[r] + brow[kc + 32] : -INFINITY;
                }
            }
            float f; const bool resc = softmax_tile(p0, p1, mhat, l_reg, f, !started);
            if (resc || !started) {
#pragma unroll
                for (int r = 0; r < 16; ++r) negm[r] = -mhat;
            }
            if (resc) {
                if (hi == 0) wsf[r32] = f;
#pragma unroll
                for (int d_ = 0; d_ < 2; ++d_)
#pragma unroll
                    for (int r = 0; r < 16; ++r) o[d_][r] *= wsf[crow(r, hi)];
            }
            started = true;
            PW pw; packp(pw, p0, p1);
#pragma unroll
            for (int d0 = 0; d0 < 2; ++d0) {
                bf16x8 vf[4]; vfrags(vf, vb, d0);
#pragma unroll
                for (int ks = 0; ks < 4; ++ks) o[d0] = ATT_MFMA(__builtin_bit_cast(bf16x8, pw.w[ks]), vf[ks], o[d0]);
            }
        } else {
            PW pw, pw2; float f = 1.f, f2 = 1.f; bool resc = false;
            {
                f32x16 p0 = f32x16{}, p1 = f32x16{};
#pragma unroll
                for (int d0 = 0; d0 < 2; ++d0) {
                    const bf16x8 b0 = *(const LAS bf16x8*)(kp + d0 * 2048), b1 = *(const LAS bf16x8*)(kp + d0 * 2048 + 512);
                    p0 = ATT_MFMA(b0, qr[d0], p0); p1 = ATT_MFMA(b1, qr[d0], p1);
                }
                const float rm = rowmax(p0, p1);
                if (!started) mhat = rm;
                else if (__any(rm - mhat > THR)) { const float mn = __builtin_fmaxf(mhat, rm); f = __builtin_amdgcn_exp2f(mhat - mn); mhat = mn; l_reg *= f; resc = true; }
#pragma unroll
                for (int r = 0; r < 16; ++r) { p0[r] = __builtin_amdgcn_exp2f(p0[r] - mhat); p1[r] = __builtin_amdgcn_exp2f(p1[r] - mhat); }
                l_reg += rowsum(p0, p1);
                packp(pw, p0, p1);
            }
            {
                f32x16 q0 = f32x16{}, q1 = f32x16{};
#pragma unroll
                for (int d0 = 2; d0 < 4; ++d0) {
                    const bf16x8 b0 = *(const LAS bf16x8*)(kp + d0 * 2048), b1 = *(const LAS bf16x8*)(kp + d0 * 2048 + 512);
                    q0 = ATT_MFMA(b0, qr[d0], q0); q1 = ATT_MFMA(b1, qr[d0], q1);
                }
                const float rm = rowmax(q0, q1);
                if (!started) mhat2 = rm;
                else if (__any(rm - mhat2 > THR)) { const float mn = __builtin_fmaxf(mhat2, rm); f2 = __builtin_amdgcn_exp2f(mhat2 - mn); mhat2 = mn; l_reg2 *= f2; resc = true; }
#pragma unroll
                for (int r = 0; r < 16; ++r) { q0[r] = __builtin_amdgcn_exp2f(q0[r] - mhat2); q1[r] = __builtin_amdgcn_exp2f(q1[r] - mhat2); }
                l_reg2 += rowsum(q0, q1);
                packp(pw2, q0, q1);
            }
            if (resc) {
                if (hi == 0) { wsf[r32] = f; wsf[32 + r32] = f2; }
#pragma unroll
                for (int d_ = 0; d_ < 2; ++d_)
#pragma unroll
                    for (int r = 0; r < 16; ++r) { o[d_][r] *= wsf[crow(r, hi)]; o2[d_][r] *= wsf[32 + crow(r, hi)]; }
            }
            started = true;
#pragma unroll
            for (int d0 = 0; d0 < 2; ++d0) {
                bf16x8 vf[4]; vfrags(vf, vb, d0);
#pragma unroll
                for (int ks = 0; ks < 4; ++ks) { o[d0] = ATT_MFMA(__builtin_bit_cast(bf16x8, pw.w[ks]), vf[ks], o[d0]); o2[d0] = ATT_MFMA(__builtin_bit_cast(bf16x8, pw2.w[ks]), vf[ks], o2[d0]); }
            }
        }
    }
    { auto rr = __builtin_amdgcn_permlane32_swap(__float_as_uint(l_reg), __float_as_uint(l_reg), false, false); l_reg = __uint_as_float(rr[0]) + __uint_as_float(rr[1]); }
    if (VAR == 1) { auto rr = __builtin_amdgcn_permlane32_swap(__float_as_uint(l_reg2), __float_as_uint(l_reg2), false, false); l_reg2 = __uint_as_float(rr[0]) + __uint_as_float(rr[1]); }
    if (hi == 0) { wsf[r32] = 1.f / l_reg; if (VAR == 1) wsf[32 + r32] = lc.lam / l_reg2; }
#pragma unroll
    for (int r = 0; r < 16; ++r) {
        const int orow = crow(r, hi); const float a1 = wsf[orow];
        if (VAR == 1) { const float a2 = wsf[32 + orow]; ost[orow * 64 + r32] = o[0][r] * a1 - o2[0][r] * a2; ost[orow * 64 + 32 + r32] = o[1][r] * a1 - o2[1][r] * a2; }
        else { ost[orow * 64 + r32] = o[0][r] * a1; ost[orow * 64 + 32 + r32] = o[1][r] * a1; }
    }
    asm volatile("s_waitcnt lgkmcnt(0)" ::: "memory");
    const size_t mrow0 = rowb + u.qrow0 + wid * 32;
#pragma unroll
    for (int i = 0; i < 4; ++i) {
        const int row = i * 8 + (lane >> 3), ch = lane & 7;
        const f32x4 x0 = *(const LAS f32x4*)(ost + row * 64 + ch * 8), x1 = *(const LAS f32x4*)(ost + row * 64 + ch * 8 + 4);
        float v[8] = {x0[0], x0[1], x0[2], x0[3], x1[0], x1[1], x1[2], x1[3]};
        if (VAR == 1) {
            float ss = 0.f;
#pragma unroll
            for (int e = 0; e < 8; ++e) ss += v[e] * v[e];
            ss += __shfl_xor(ss, 1); ss += __shfl_xor(ss, 2); ss += __shfl_xor(ss, 4);
            const float rs = rsqrtf(ss * (1.f / 64.f) + RMS_EPS) * lc.one_m_lam_init;
            const f32x4 g0 = *(const f32x4*)(p.subln_g + lc.l * 64 + ch * 8), g1 = *(const f32x4*)(p.subln_g + lc.l * 64 + ch * 8 + 4);
            const float gg[8] = {g0[0], g0[1], g0[2], g0[3], g1[0], g1[1], g1[2], g1[3]};
#pragma unroll
            for (int e = 0; e < 8; ++e) v[e] *= rs * gg[e];
        }
        const u32x4 gt = *(const u32x4*)(p.P + (mrow0 + row) * NP + GOFF + u.h * 64 + ch * 8);
        u32x4 w;
#pragma unroll
        for (int e = 0; e < 4; ++e) { const float ga = __uint_as_float(gt[e] << 16), gb = __uint_as_float(gt[e] & 0xffff0000u); w[e] = cvtpk(v[2 * e] * ga, v[2 * e + 1] * gb); }
        *(u32x4*)(p.A + (mrow0 + row) * D + YOFF + u.h * 64 + ch * 8) = w;
    }
    asm volatile("s_waitcnt lgkmcnt(0)\n\ts_barrier" ::: "memory");
#undef ATT_TROW
#undef ATT_DMA
}

__device__ __forceinline__ void attn_phase(const Params& p, int l, LAS unsigned char* lds, int v, int G, int tid_in) {
    float d1 = 0.f, d2 = 0.f;
    for (int i = 0; i < 32; ++i) { d1 += p.lq1[l * 32 + i] * p.lk1[l * 32 + i]; d2 += p.lq2[l * 32 + i] * p.lk2[l * 32 + i]; }
    const float lam_init = 0.8f - 0.6f * expf(-0.3f * (float)l);
    LayerConst lc{l, expf(d1) - expf(d2) + lam_init, 1.f - lam_init};
    const bool need_ctx = l < NL - 1;
    for (int uidx = v; uidx < 256; uidx += G) {
        { UnitDesc u; u.var = 0; u.b = uidx >> 6; u.kvh = (uidx >> 5) & 1; u.h = u.kvh * 2 + ((uidx >> 4) & 1); u.qrow0 = (uidx & 15) * 256; u.f0 = 0; u.n0 = 68; u.f1 = 0; u.n1 = 0; attn_unit<0>(p, u, lc, lds, tid_in); }
        { UnitDesc u; u.var = 1; u.b = uidx >> 6; u.h = (uidx >> 4) & 3; u.kvh = u.h; u.qrow0 = (uidx & 15) * 256; u.f0 = 0; u.n0 = 68; u.f1 = 0; u.n1 = 0; attn_unit<1>(p, u, lc, lds, tid_in); }
        { UnitDesc u; u.var = 2; u.b = uidx >> 6; u.h = (uidx >> 4) & 3; u.kvh = u.h; const int qb = uidx & 15; u.qrow0 = qb * 256;
          const int ra = min(max(4 * qb - 4, 0), 56), rb = min(max(4 * qb + 3 - 4, 0), 56) + 8; u.f0 = 64; u.n0 = 4; u.f1 = ra; u.n1 = rb - ra; attn_unit<2>(p, u, lc, lds, tid_in); }
    }
    if (need_ctx) {
        for (int uidx = v; uidx < 48; uidx += G) {
            const int var = uidx >> 4, b = (uidx >> 2) & 3, h = uidx & 3;
            UnitDesc u; u.var = var; u.b = b; u.h = h; u.kvh = var == 0 ? (h >> 1) : h; u.qrow0 = S; u.f0 = 64; u.n0 = 4; u.f1 = 0; u.n1 = 0;
            if (var == 0) attn_unit<0>(p, u, lc, lds, tid_in); else if (var == 1) attn_unit<1>(p, u, lc, lds, tid_in); else attn_unit<2>(p, u, lc, lds, tid_in);
        }
    }
}
}
namespace s5m {
typedef short bf16x8 __attribute__((ext_vector_type(8)));
constexpr int NCK = T / 16;
constexpr int TT_SZ = 31 * 256, E_SZ = 2 * 128 * 256, F_SZ = 2 * 256 * 128;
#define S5_MFMA(a, b, c) __builtin_amdgcn_mfma_f32_16x16x32_bf16(a, b, c, 0, 0, 0)
__device__ __forceinline__ void build_a(const Params& p, int gw, int ngw, int lane) {
    for (int it = gw * 64 + lane; it < NL * 2 * 16 * 64; it += ngw * 64) {
        const size_t ip = (size_t)it; const int ig = it >> 6;
        float* dsc = p.disc + ip * 34;
        const double ar = p.a_re[ip], ai = p.a_im[ip], dt = exp((double)p.log_dt[ig]);
        const double e = exp(ar * dt), lr = e * cos(ai * dt), li = e * sin(ai * dt);
        const double nr = lr - 1.0, ni = li, den = ar * ar + ai * ai; const double cr = (nr * ar + ni * ai) / den, ci = (ni * ar - nr * ai) / den;
        dsc[0] = (float)lr; dsc[1] = (float)li;
        for (int c = 0; c < 16; ++c) { const double br = p.b_re[ip * 16 + c], bi = p.b_im[ip * 16 + c]; dsc[2 + c] = (float)(cr * br - ci * bi); dsc[18 + c] = (float)(cr * bi + ci * br); }
        double pr = 1.0, pi = 0.0; float* lp = p.lampow + ip * 34;
        for (int k = 0; k <= 16; ++k) { lp[2 * k] = (float)pr; lp[2 * k + 1] = (float)pi; if (k < 16) { const double tr = pr * lr - pi * li, ti = pr * li + pi * lr; pr = tr; pi = ti; } }
        const double a_r = pr, a_i = pi; double qr = pr, qi = pi; float* ap = p.apow + ip * 32;
        for (int j = 1; j <= 16; ++j) { ap[2 * (j - 1)] = (float)qr; ap[2 * (j - 1) + 1] = (float)qi; const double tr = qr * a_r - qi * a_i, ti = qr * a_i + qi * a_r; qr = tr; qi = ti; }
    }
}
__device__ __forceinline__ void build_b(const Params& p, int gw, int ngw, int lane) {
    constexpr int NE = NL * 16 * 2 * 128 * 32;
    for (int it = gw * 64 + lane; it < NE; it += ngw * 64) {
        {
            const int half = it & 1, s = (it >> 1) & 15, row = (it >> 5) & 127, dir = (it >> 12) & 1, lg = it >> 13, g = lg & 15, l = lg >> 4;
            const int part = row & 1, st = row >> 1; const size_t ip = (size_t)((l * 2 + dir) * 16 + g) * 64 + st;
            const int k = dir == 0 ? 15 - s : s; const float wr = p.lampow[ip * 34 + 2 * k], wi = p.lampow[ip * 34 + 2 * k + 1];
            float v[8];
#pragma unroll
            for (int c = 0; c < 8; ++c) { const float br = p.disc[ip * 34 + 2 + half * 8 + c], bi = p.disc[ip * 34 + 18 + half * 8 + c]; v[c] = part == 0 ? wr * br - wi * bi : wr * bi + wi * br; }
            u32x4 o; o.x = pk2(v[0], v[1]); o.y = pk2(v[2], v[3]); o.z = pk2(v[4], v[5]); o.w = pk2(v[6], v[7]);
            *(u32x4*)(p.Etab + (size_t)it * 8) = o;
        }
        {
            const int k8 = it & 15, row = (it >> 4) & 255, dir = (it >> 12) & 1, lg = it >> 13, g = lg & 15, l = lg >> 4;
            const int st0 = k8 * 4, t = row >> 4, c = row & 15; const size_t ig = (size_t)((l * 2 + dir) * 16 + g);
            const int k = dir == 0 ? t + 1 : 16 - t;
            float v[8];
#pragma unroll
            for (int j = 0; j < 4; ++j) {
                const size_t ip = ig * 64 + st0 + j; const float wr = p.lampow[ip * 34 + 2 * k], wi = p.lampow[ip * 34 + 2 * k + 1];
                const float cr = p.c_re[(ig * 16 + c) * 64 + st0 + j], ci = p.c_im[(ig * 16 + c) * 64 + st0 + j];
                v[2 * j] = cr * wr - ci * wi; v[2 * j + 1] = -(cr * wi + ci * wr);
            }
            u32x4 o; o.x = pk2(v[0], v[1]); o.y = pk2(v[2], v[3]); o.z = pk2(v[4], v[5]); o.w = pk2(v[6], v[7]);
            *(u32x4*)(p.Ftab + (size_t)it * 8) = o;
        }
    }
    for (int it = gw * 64 + lane; it < NL * 16 * 31 * 256; it += ngw * 64) {
        const int cc = it & 15, c = (it >> 4) & 15, ti = (it >> 8) % 31, lg = it / (31 * 256), g = lg & 15, l = lg >> 4;
        float acc = 0.f;
        for (int dir = 0; dir < 2; ++dir) {
            if ((dir == 0 && ti < 15) || (dir == 1 && ti > 15)) continue;
            const int tau = dir == 0 ? ti - 15 : 15 - ti;
            const size_t ig = (size_t)((l * 2 + dir) * 16 + g);
            const float* cre = p.c_re + (ig * 16 + c) * 64; const float* cim = p.c_im + (ig * 16 + c) * 64;
            for (int st = 0; st < 64; ++st) {
                const size_t ip = ig * 64 + st;
                const float wr = p.lampow[ip * 34 + 2 * tau], wi = p.lampow[ip * 34 + 2 * tau + 1];
                const float br = p.disc[ip * 34 + 2 + cc], bi = p.disc[ip * 34 + 18 + cc];
                const float xr = wr * br - wi * bi, xi = wr * bi + wi * br;
                acc += cre[st] * xr - cim[st] * xi;
            }
        }
        p.Ttab[(size_t)it] = f2bf(acc);
    }
}
constexpr int L_HIN = 0, L_UT = NCK * 512, L_S5END = L_UT + 2 * 8192;
template <int CTRL> __device__ __forceinline__ float dppf(float x) { return __int_as_float(__builtin_amdgcn_update_dpp(0, __float_as_int(x), CTRL, 0xf, 0xf, true)); }
template <int CTRL> __device__ __forceinline__ void hs_stage(f32x4& X, float a0r, float a0i, float a1r, float a1i) {
    const float y0 = dppf<CTRL>(X[0]), y1 = dppf<CTRL>(X[1]), y2 = dppf<CTRL>(X[2]), y3 = dppf<CTRL>(X[3]);
    X[0] += a0r * y0 - a0i * y1; X[1] += a0r * y1 + a0i * y0; X[2] += a1r * y2 - a1i * y3; X[3] += a1r * y3 + a1i * y2;
}
template <int DIR> __device__ __forceinline__ void scan_tile(f32x4& X, f32x4& Cin, const float (&a1)[2][2], const float (&apos)[2][2], int lane, int nn) {
    constexpr int B = DIR == 0 ? 0x110 : 0x100;
    float p0r = a1[0][0], p0i = a1[0][1], p1r = a1[1][0], p1i = a1[1][1];
    hs_stage<B + 1>(X, p0r, p0i, p1r, p1i);
    { const float t0 = p0r * p0r - p0i * p0i, t1 = 2.f * p0r * p0i, t2 = p1r * p1r - p1i * p1i, t3 = 2.f * p1r * p1i; p0r = t0; p0i = t1; p1r = t2; p1i = t3; }
    hs_stage<B + 2>(X, p0r, p0i, p1r, p1i);
    { const float t0 = p0r * p0r - p0i * p0i, t1 = 2.f * p0r * p0i, t2 = p1r * p1r - p1i * p1i, t3 = 2.f * p1r * p1i; p0r = t0; p0i = t1; p1r = t2; p1i = t3; }
    hs_stage<B + 4>(X, p0r, p0i, p1r, p1i);
    { const float t0 = p0r * p0r - p0i * p0i, t1 = 2.f * p0r * p0i, t2 = p1r * p1r - p1i * p1i, t3 = 2.f * p1r * p1i; p0r = t0; p0i = t1; p1r = t2; p1i = t3; }
    hs_stage<B + 8>(X, p0r, p0i, p1r, p1i);
    f32x4 Tt;
    Tt[0] = X[0] + apos[0][0] * Cin[0] - apos[0][1] * Cin[1]; Tt[1] = X[1] + apos[0][0] * Cin[1] + apos[0][1] * Cin[0];
    Tt[2] = X[2] + apos[1][0] * Cin[2] - apos[1][1] * Cin[3]; Tt[3] = X[3] + apos[1][0] * Cin[3] + apos[1][1] * Cin[2];
    f32x4 Ex; const bool first = DIR == 0 ? nn == 0 : nn == 15;
#pragma unroll
    for (int i = 0; i < 4; ++i) { const float sh = dppf<B + 1>(Tt[i]); Ex[i] = first ? Cin[i] : sh; }
    const int src = DIR == 0 ? ((lane & 48) | 15) : (lane & 48);
#pragma unroll
    for (int i = 0; i < 4; ++i) Cin[i] = __shfl(Tt[i], src);
    X = Ex;
}
__device__ __forceinline__ void unit(const Params& p, int l, int b, int g, LAS unsigned char* lds, int tid_in) {
    const int tid = opaque_v(tid_in), lane = tid & 63, wave = __builtin_amdgcn_readfirstlane(tid >> 6), nn = lane & 15, kg = lane >> 4;
    const size_t rowb = (size_t)b * T;
    LAS unsigned char* HIN = lds + L_HIN; LAS unsigned char* UT = lds + L_UT;
    const int sj = tid >> 5, sq = tid & 31;
    const bf16_t* usrc = p.P + (rowb + sj * 16 + (sq >> 1)) * NP + DU + g * 16 + (sq & 1) * 8;
    const int udst = sj * 512 + ((sq ^ sj) * 16);
#define S5_ULOAD(cb) (*(const u32x4*)(usrc + (size_t)(cb) * 256 * NP))
#define S5_UWRITE(cb, r) (*(LAS u32x4*)(UT + ((cb) & 1) * 8192 + udst) = (r))
#define S5_UFRAG(cb, kb) (*(const LAS bf16x8*)(UT + ((cb) & 1) * 8192 + nn * 512 + ((((2 * (kb) + (kg >> 1)) * 2 + (kg & 1)) ^ nn) * 16)))
    const int kbase = 32 * wave + 4 * kg;
#define S5_SHADDR(cb, rb) (HIN + ((cb) * 16 + nn) * 512 + ((((kbase + 16 * (rb)) >> 3) ^ nn) * 16) + ((kbase + 16 * (rb)) & 7) * 2)
    {
        const bf16_t* E = p.Etab + (size_t)(l * 16 + g) * E_SZ;
        bf16x8 af[2][8];
#pragma unroll
        for (int rb = 0; rb < 2; ++rb)
#pragma unroll
            for (int kb = 0; kb < 8; ++kb) af[rb][kb] = *(const bf16x8*)(E + (size_t)(wave * 32 + rb * 16 + nn) * 256 + kb * 32 + kg * 8);
        u32x4 r1, r2;
        { const u32x4 r0 = S5_ULOAD(0); r1 = S5_ULOAD(1); S5_UWRITE(0, r0); } __syncthreads();
#pragma unroll 1
        for (int cb = 0; cb < 17; ++cb) {
            if (cb + 2 < 17) r2 = S5_ULOAD(cb + 2);
            f32x4 a0 = {0.f, 0.f, 0.f, 0.f}, a1 = {0.f, 0.f, 0.f, 0.f};
#pragma unroll
            for (int kb = 0; kb < 8; ++kb) { const bf16x8 bfr = S5_UFRAG(cb, kb); a0 = S5_MFMA(af[0][kb], bfr, a0); a1 = S5_MFMA(af[1][kb], bfr, a1); }
            { u32x2 w; w.x = pk2(a0[0], a0[1]); w.y = pk2(a0[2], a0[3]); *(LAS u32x2*)S5_SHADDR(cb, 0) = w; w.x = pk2(a1[0], a1[1]); w.y = pk2(a1[2], a1[3]); *(LAS u32x2*)S5_SHADDR(cb, 1) = w; }
            if (cb + 1 < 17) S5_UWRITE(cb + 1, r1);
            __syncthreads();
            r1 = r2;
        }
    }
    {
        const int dir = wave >> 2;
        float ap[2][2][2], apos[2][2][2];
#pragma unroll
        for (int rb = 0; rb < 2; ++rb)
#pragma unroll
            for (int j = 0; j < 2; ++j) {
                const int st = 16 * (wave & 3) + 8 * rb + 2 * kg + j; const float* t = p.apow + ((size_t)((l * 2 + dir) * 16 + g) * 64 + st) * 32;
                ap[rb][j][0] = t[0]; ap[rb][j][1] = t[1];
                const int e = dir == 0 ? nn : 15 - nn; apos[rb][j][0] = t[2 * e]; apos[rb][j][1] = t[2 * e + 1];
            }
        f32x4 C0 = {0.f, 0.f, 0.f, 0.f}, C1 = {0.f, 0.f, 0.f, 0.f};
#pragma unroll 1
        for (int i = 0; i < 17; ++i) {
            const int cb = i == 0 ? 16 : (dir == 0 ? i - 1 : 16 - i);
            LAS u32x2* q0 = (LAS u32x2*)S5_SHADDR(cb, 0); LAS u32x2* q1 = (LAS u32x2*)S5_SHADDR(cb, 1);
            const u32x2 s0 = *q0, s1 = *q1;
            f32x4 x0 = {__uint_as_float(s0.x << 16), __uint_as_float(s0.x & 0xffff0000u), __uint_as_float(s0.y << 16), __uint_as_float(s0.y & 0xffff0000u)};
            f32x4 x1 = {__uint_as_float(s1.x << 16), __uint_as_float(s1.x & 0xffff0000u), __uint_as_float(s1.y << 16), __uint_as_float(s1.y & 0xffff0000u)};
            if (dir == 0) { scan_tile<0>(x0, C0, ap[0], apos[0], lane, nn); scan_tile<0>(x1, C1, ap[1], apos[1], lane, nn); }
            else { scan_tile<1>(x0, C0, ap[0], apos[0], lane, nn); scan_tile<1>(x1, C1, ap[1], apos[1], lane, nn); }
            u32x2 w; w.x = pk2(x0[0], x0[1]); w.y = pk2(x0[2], x0[3]); *q0 = w; w.x = pk2(x1[0], x1[1]); w.y = pk2(x1[2], x1[3]); *q1 = w;
        }
    }
    __syncthreads();
    {
        const bf16_t* Tt = p.Ttab + (size_t)(l * 16 + g) * TT_SZ; const bf16_t* F = p.Ftab + (size_t)(l * 16 + g) * F_SZ;
        bf16x8 at[2][8], afq[2][8];
#pragma unroll
        for (int rb = 0; rb < 2; ++rb) {
            const int t = wave * 2 + rb;
#pragma unroll
            for (int kb = 0; kb < 8; ++kb) {
                const int s = 2 * kb + (kg >> 1), half = kg & 1, ti = t - s + 15;
                at[rb][kb] = *(const bf16x8*)(Tt + (size_t)(ti * 16 + nn) * 16 + half * 8);
                afq[rb][kb] = *(const bf16x8*)(F + (size_t)((kb >> 2) * 256 + t * 16 + nn) * 128 + (kb & 3) * 32 + kg * 8);
            }
        }
        const float* dsk = p.s5_d + l * 256 + g * 16 + kg * 4;
        const float d0 = dsk[0], d1 = dsk[1], d2 = dsk[2], d3 = dsk[3];
        u32x4 r0 = S5_ULOAD(0), r1 = S5_ULOAD(1), r2 = S5_ULOAD(2);
        S5_UWRITE(0, r0); __syncthreads();
#pragma unroll
        for (int cb = 0; cb < 17; ++cb) {
            if (cb + 3 < 17) r0 = S5_ULOAD(cb + 3);
            const int n = cb * 16 + nn;
            f32x4 a0 = {0.f, 0.f, 0.f, 0.f}, a1 = {0.f, 0.f, 0.f, 0.f};
#pragma unroll
            for (int kb = 0; kb < 8; ++kb) { const bf16x8 bfr = S5_UFRAG(cb, kb); a0 = S5_MFMA(at[0][kb], bfr, a0); a1 = S5_MFMA(at[1][kb], bfr, a1); }
#pragma unroll
            for (int kb = 0; kb < 8; ++kb) { const bf16x8 hf = *(const LAS bf16x8*)(HIN + n * 512 + (((kb * 4 + kg) ^ nn) * 16)); a0 = S5_MFMA(afq[0][kb], hf, a0); a1 = S5_MFMA(afq[1][kb], hf, a1); }
#pragma unroll
            for (int rb = 0; rb < 2; ++rb) {
                const int t = wave * 2 + rb; const f32x4 a = rb == 0 ? a0 : a1;
                const u32x2 uu = *(const LAS u32x2*)(UT + (cb & 1) * 8192 + nn * 512 + (((t * 2 + (kg >> 1)) ^ nn) * 16) + (kg & 1) * 8);
                const float u0 = __uint_as_float(uu.x << 16), u1 = __uint_as_float(uu.x & 0xffff0000u), u2 = __uint_as_float(uu.y << 16), u3 = __uint_as_float(uu.y & 0xffff0000u);
                u32x2 w; w.x = pk2(gelu_tanh(a[0] + d0 * u0), gelu_tanh(a[1] + d1 * u1)); w.y = pk2(gelu_tanh(a[2] + d2 * u2), gelu_tanh(a[3] + d3 * u3));
                *(u32x2*)(p.ys5 + (rowb + n * 16 + t) * 256 + g * 16 + kg * 4) = w;
            }
            if (cb + 1 < 17) S5_UWRITE(cb + 1, r1);
            __syncthreads();
            r1 = r2; r2 = r0;
        }
    }
#undef S5_ULOAD
#undef S5_UWRITE
#undef S5_UFRAG
#undef S5_SHADDR
}
}
constexpr int LDS_BYTES = 155648;
__device__ __forceinline__ void ph_inproj(const Params& p, int l, LAS unsigned char* lds, int G, int bx, int tid) {
    pg8::Gemm g{p.A, p.Win_t + (size_t)l * NP * D, MT, NP, D}; pg8::StaticOrder So; So.init(MT, NP, G, bx);
    pg8::EpiInProj E{p.P, p.tabA, p.tabB, p.qn_g + l * 64, p.kn_g + l * 64};
    pg8::gemm_phase<pg8::EpiInProj, pg8::StaticOrder, true, true>(lds, g, So, E, tid);
}
__device__ __forceinline__ void ph_outproj(const Params& p, int l, LAS unsigned char* lds, int G, int bx, int tid) {
    const int M = l == NL - 1 ? MT : MT;
    pg8::Gemm g{p.A, p.Wout_t + (size_t)l * D * D, M, D, D}; pg8::StaticOrder So; So.init(M, D, G, bx);
    pg8::EpiOutProj E{p.xl, p.xc, p.mod + (size_t)l * 5 * 3 * D};
    pg8::gemm_phase<pg8::EpiOutProj, pg8::StaticOrder, true, true>(lds, g, So, E, tid);
}
__device__ __forceinline__ void ph_glu(const Params& p, int l, LAS unsigned char* lds, int G, int bx, int tid) {
    pg8::Gemm g{p.ys5, p.Wglu_t + (size_t)l * 512 * 256, MT, 512, 256}; pg8::StaticOrder So; So.init(MT, 512, G, bx);
    pg8::EpiGlu E{p.A, p.P};
    pg8::gemm_phase<pg8::EpiGlu, pg8::StaticOrder, true, true>(lds, g, So, E, tid);
}
struct Ctx { int tid, lane, wave, G, bx, gw, ngw, v; };
__device__ __forceinline__ Ctx make_ctx(int wave0) {
    Ctx c; c.wave = opaque_s(wave0); c.lane = (int)__builtin_amdgcn_mbcnt_hi(~0u, __builtin_amdgcn_mbcnt_lo(~0u, (unsigned)opaque_v(0))); c.tid = c.wave * 64 + c.lane;
    c.G = opaque_s((int)gridDim.x); c.bx = opaque_s((int)blockIdx.x); c.gw = c.bx * NWAVES + c.wave; c.ngw = c.G * NWAVES;
    c.v = (c.G % 8 == 0) ? (c.bx % 8) * (c.G / 8) + (c.bx / 8) : c.bx;
    return c;
}
#define GRID_SYNC() cg::this_grid().sync()
__global__ void __launch_bounds__(NTHR, 2) mega(KArgs ka) {
    extern __shared__ __attribute__((aligned(16))) unsigned char lds_raw[];
    LAS unsigned char* lds = (LAS unsigned char*)lds_raw;
    const int wave0 = __builtin_amdgcn_readfirstlane((int)threadIdx.x >> 6);
    { const Params pp = make_params(ka, true);
      { const Ctx c = make_ctx(wave0); phase_prologue(pp, ka, lds, c.gw, c.ngw, c.wave, c.lane); s5m::build_a(pp, c.gw, c.ngw, c.lane); }
      GRID_SYNC();
      { const Ctx c = make_ctx(wave0); s5m::build_b(pp, c.gw, c.ngw, c.lane); phase_rows(pp, -1, 0, c.gw, c.ngw, c.lane); } }
    GRID_SYNC();
#pragma nounroll
    for (int l = 0; l < NL; ++l) {
        { const Ctx c = make_ctx(wave0); const Params p = make_params(ka, false); ph_inproj(p, l, lds, c.G, c.bx, c.tid); }
        GRID_SYNC();
        { const Ctx c = make_ctx(wave0); const Params p = make_params(ka, false); att::attn_phase(p, l, lds, c.v, c.G, c.tid); }
        { const Ctx c = make_ctx(wave0); const Params p = make_params(ka, false); for (int u = c.v; u < NB * 16; u += c.G) s5m::unit(p, l, u >> 4, u & 15, lds, c.tid); }
        GRID_SYNC();
        { const Ctx c = make_ctx(wave0); const Params p = make_params(ka, false); ph_glu(p, l, lds, c.G, c.bx, c.tid); }
        GRID_SYNC();
        { const Ctx c = make_ctx(wave0); const Params p = make_params(ka, false); ph_outproj(p, l, lds, c.G, c.bx, c.tid); }
        GRID_SYNC();
        { const Ctx c = make_ctx(wave0); const Params p = make_params(ka, false); phase_rows(p, l, l + 1, c.gw, c.ngw, c.lane); }
        if (l + 1 < NL) GRID_SYNC();
    }
}

extern "C" void kernel_launch(void* const* d_in, const int* in_sizes, int n_in, void* d_out, int out_size, void* d_ws, size_t ws_size, hipStream_t stream) {
    static int grid = 0;
    if (grid == 0) {
        int dev = 0, cus = 0, per_cu = 0;
        (void)hipGetDevice(&dev); (void)hipDeviceGetAttribute(&cus, hipDeviceAttributeMultiprocessorCount, dev);
        (void)hipFuncSetAttribute((const void*)mega, hipFuncAttributeMaxDynamicSharedMemorySize, LDS_BYTES);
        if (hipOccupancyMaxActiveBlocksPerMultiprocessor(&per_cu, (const void*)mega, NTHR, LDS_BYTES) != hipSuccess || per_cu < 1) { per_cu = 1; (void)hipGetLastError(); }
        if (per_cu > 1) per_cu = 1;
        grid = (cus > 0 ? cus : 256) * per_cu;
    }
    KArgs ka{};
    for (int i = 0; i < 27; ++i) ka.in[i] = (const float*)d_in[i];
    ka.out = (float*)d_out; ka.ws = (unsigned char*)d_ws;
    if (O_END > ws_size) { fprintf(stderr, "kernel_launch: workspace too small: need %zu have %zu\n", (size_t)O_END, ws_size); return; }
    void* args[] = {&ka};
    hipError_t e = hipLaunchCooperativeKernel((const void*)mega, dim3(grid), dim3(NTHR), args, LDS_BYTES, stream);
    if (e != hipSuccess) fprintf(stderr, "cooperative launch failed: %s (grid %d)\n", hipGetErrorString(e), grid);
}
```

```cpp
#include <hip/hip_runtime.h>
#include <hip/hip_cooperative_groups.h>
#include <cstdint>
#include <cstdio>
#include <math.h>
namespace cg = cooperative_groups;

constexpr int D = 1024, NB = 4, S = 4096, NL = 4, GW = 64, CT = 256;
constexpr int T = S + CT;
constexpr int MT = NB * T;
constexpr int NP = 3328;
constexpr int AQ = 0, AK = 256, AV = 384, AG = 512, BQ = 768, BK = 1024, BV = 1280, BG = 1536, CQ = 1792, CK = 2048, CV = 2304, CG = 2560, DU = 2816, DG = 3072;
constexpr float RMS_EPS = 1e-6f, LN_EPS = 1e-5f;
constexpr float ALPHA = 1.681792830507429f;
constexpr float LOG2E = 1.4426950408889634f;
constexpr float C2A = 0.125f * LOG2E;
constexpr float C2B = 0.17677669529663687f * LOG2E;
constexpr int NCH = T / 64;
constexpr int NWAVES = 8, NTHR = 512;

typedef unsigned short bf16_t;
typedef float f32x4 __attribute__((ext_vector_type(4)));
typedef unsigned u32x4 __attribute__((ext_vector_type(4)));
typedef unsigned u32x2 __attribute__((ext_vector_type(2)));
#define LAS __attribute__((address_space(3)))
__device__ __forceinline__ float bf2f(bf16_t v) { return __uint_as_float(((unsigned)v) << 16); }
__device__ __forceinline__ unsigned f2bf_u(float f) { unsigned u = __float_as_uint(f); return (u + 0x7fffu + ((u >> 16) & 1u)) >> 16; }
__device__ __forceinline__ bf16_t f2bf(float f) { return (bf16_t)f2bf_u(f); }
__device__ __forceinline__ unsigned pk2(float lo, float hi) { return f2bf_u(lo) | (f2bf_u(hi) << 16); }
__device__ __forceinline__ float silu_f(float v) { return v / (1.f + __expf(-v)); }
__device__ __forceinline__ float sigm_f(float v) { return 1.f / (1.f + __expf(-v)); }
__device__ __forceinline__ float gelu_tanh(float v) { return 0.5f * v * (1.f + tanhf(0.7978845608028654f * (v + 0.044715f * v * v * v))); }

__device__ __forceinline__ int opaque_v(int x) { asm volatile("" : "+v"(x)); return x; }
__device__ __forceinline__ int opaque_s(int x) { asm volatile("" : "+s"(x)); return x; }
struct Params {
    const float *x, *c, *ctx, *c_ctx, *w_ada, *b_ada, *w_in, *w_out, *ln_g, *ln_b, *qn_g, *kn_g, *lq1, *lk1, *lq2, *lk2, *subln_g, *rpb;
    const float *a_re, *a_im, *log_dt, *b_re, *b_im, *c_re, *c_im, *s5_d, *w_glu;
    float* xl;
    float* xc;
    float* mod;
    float* tabA;
    float* tabB;
    bf16_t* Win_t;
    bf16_t* Wout_t;
    bf16_t* Wglu_t;
    bf16_t* A;
    bf16_t* P;
    bf16_t* ys5;
    float* Sbuf;
    bf16_t* Hinb;
    bf16_t* Ttab; bf16_t* Etab; bf16_t* Ftab; float* apow; float* lampow;
    unsigned* ctl;
    float* disc;
};
struct KArgs { const float* in[27]; float* out; unsigned char* ws; };
constexpr size_t al256(size_t x) { return (x + 255) & ~(size_t)255; }
constexpr size_t O_CTL = 0, O_XC = O_CTL + (1 << 20), O_MOD = O_XC + al256((size_t)NB * CT * D * 4), O_TABA = O_MOD + al256((size_t)NL * 5 * 3 * D * 4), O_TABB = O_TABA + 8192,
    O_WIN = O_TABB + 4096, O_WOUT = O_WIN + al256((size_t)NL * NP * D * 2), O_WGLU = O_WOUT + al256((size_t)NL * D * D * 2), O_A = O_WGLU + al256((size_t)NL * 512 * 256 * 2),
    O_P = O_A + al256((size_t)MT * D * 2), O_YS5 = O_P + al256((size_t)MT * NP * 2), O_SBUF = O_YS5 + al256((size_t)MT * 256 * 2), O_HINB = O_SBUF + al256((size_t)NB * 16 * 272 * 256 * 4), O_TTAB = O_HINB + al256((size_t)NB * 16 * 272 * 256 * 2),
    O_ETAB = O_TTAB + al256((size_t)NL * 16 * 31 * 256 * 2), O_FTAB = O_ETAB + al256((size_t)NL * 16 * 2 * 128 * 256 * 2), O_LAM16 = O_FTAB + al256((size_t)NL * 16 * 2 * 256 * 128 * 2),
    O_LAMPOW = O_LAM16 + al256((size_t)NL * 2 * 16 * 64 * 32 * 4), O_SMALL = O_LAMPOW + al256((size_t)NL * 2 * 16 * 64 * 34 * 4);
constexpr int SM_N[18] = {NL * D, NL * D, NL * 64, NL * 64, NL * 32, NL * 32, NL * 32, NL * 32, NL * 64, NL * 4 * 15 * 31, NL * 2 * 16 * 64, NL * 2 * 16 * 64, NL * 2 * 16, NL * 2 * 16 * 64 * 16, NL * 2 * 16 * 64 * 16, NL * 2 * 16 * 16 * 64, NL * 2 * 16 * 16 * 64, NL * 256};
constexpr int sm_off(int i) { int o = 0; for (int k = 0; k < i; ++k) o += (SM_N[k] + 63) & ~63; return o; }
constexpr size_t O_DISC = O_SMALL + al256((size_t)sm_off(18) * 4);
constexpr size_t O_END = O_DISC + al256((size_t)NL * 2 * 16 * 64 * 34 * 4);
template <class Tp> __device__ __forceinline__ Tp* opaque_p(Tp* x) { asm volatile("" : "+s"(x)); return x; }
__device__ __forceinline__ Params make_params(const KArgs& ka, bool prologue) {
    Params p;
    const float** f = (const float**)&p;
    if (prologue) { for (int i = 0; i < 27; ++i) f[i] = ka.in[i]; }
    else {
        for (int i = 0; i < 27; ++i) f[i] = nullptr;
        const float* sm = (const float*)(opaque_p(ka.ws) + O_SMALL);
        p.ln_g = sm + sm_off(0); p.ln_b = sm + sm_off(1); p.qn_g = sm + sm_off(2); p.kn_g = sm + sm_off(3); p.lq1 = sm + sm_off(4); p.lk1 = sm + sm_off(5); p.lq2 = sm + sm_off(6); p.lk2 = sm + sm_off(7);
        p.subln_g = sm + sm_off(8); p.rpb = sm + sm_off(9); p.a_re = sm + sm_off(10); p.a_im = sm + sm_off(11); p.log_dt = sm + sm_off(12); p.b_re = sm + sm_off(13); p.b_im = sm + sm_off(14);
        p.c_re = sm + sm_off(15); p.c_im = sm + sm_off(16); p.s5_d = sm + sm_off(17);
    }
    unsigned char* ws = opaque_p(ka.ws);
    p.xl = opaque_p(ka.out); p.xc = (float*)(ws + O_XC); p.mod = (float*)(ws + O_MOD); p.tabA = (float*)(ws + O_TABA); p.tabB = (float*)(ws + O_TABB);
    p.Win_t = (bf16_t*)(ws + O_WIN); p.Wout_t = (bf16_t*)(ws + O_WOUT); p.Wglu_t = (bf16_t*)(ws + O_WGLU); p.A = (bf16_t*)(ws + O_A); p.P = (bf16_t*)(ws + O_P);
    p.ys5 = (bf16_t*)(ws + O_YS5); p.Sbuf = (float*)(ws + O_SBUF); p.Hinb = (bf16_t*)(ws + O_HINB); p.Ttab = (bf16_t*)(ws + O_TTAB); p.Etab = (bf16_t*)(ws + O_ETAB); p.Ftab = (bf16_t*)(ws + O_FTAB); p.apow = (float*)(ws + O_LAM16); p.lampow = (float*)(ws + O_LAMPOW); p.ctl = (unsigned*)(ws + O_CTL); p.disc = (float*)(ws + O_DISC);
    return p;
}
__device__ __forceinline__ float* xrow(const Params& p, int m) { const int b = m / T, t = m - b * T; return t < S ? p.xl + ((size_t)b * S + t) * D : p.xc + ((size_t)b * CT + (t - S)) * D; }
__device__ __forceinline__ int modrow(int m) { const int b = m / T, t = m - b * T; return t < S ? b : 4; }
namespace pg8 {
#define PG8_LAS __attribute__((address_space(3)))
typedef unsigned short bf16_t;
typedef short bf16x8 __attribute__((ext_vector_type(8)));
typedef float f32x4 __attribute__((ext_vector_type(4)));
typedef unsigned u32x4 __attribute__((ext_vector_type(4)));
constexpr int BM = 256, BK = 64, HALF = 128, HTB = HALF * BK * 2  , STAGE_BYTES = 8 * HTB, NXCD = 8, WGM = 8;

__host__ __device__ __forceinline__ int lds_byte(int r, int c) { const int st = (r >> 4) * 2 + (c >> 5), rr = r & 15, cc = c & 31, ob = rr * 64 + cc * 2; return st * 1024 + (ob ^ (((ob >> 9) & 1) << 5)); }
__host__ __device__ __forceinline__ void stage_rc(int b, int& R, int& C) { const int st = b / 1024, sb = b % 1024, swz = sb ^ (((sb >> 9) & 1) << 5); R = (st >> 1) * 16 + swz / 64; C = (st & 1) * 32 + (swz % 64) / 2; }
__host__ __device__ __forceinline__ int perm32(int rho) { const int n = rho >> 4, i = rho & 15; return 8 * (i >> 2) + 4 * n + (i & 3); }

struct Unit { int pm, pn; };
struct Gemm { const bf16_t* A; const bf16_t* Bt; int M, N, K; };

struct StaticOrder {
    int nM, nN, nwg, G, c;
    __host__ __device__ void init(int M, int N, int G_, int c_) { nM = M / BM; nN = N / BM; nwg = nM * nN; G = G_; c = c_; }
    __host__ __device__ bool next(int i, Unit& u) const {
        const long L = (long)i * G + c; if (L >= nwg) return false;
        int wgid = (int)L; { const int q = nwg / NXCD, r = nwg % NXCD, xcd = wgid % NXCD, off = wgid / NXCD; wgid = (xcd < r ? xcd * (q + 1) : r * (q + 1) + (xcd - r) * q) + off; }
        const int nig = WGM * nN, gid = wgid / nig, fm = gid * WGM, gsz = (nM - fm) < WGM ? (nM - fm) : WGM;
        u.pm = fm + ((wgid % nig) % gsz); u.pn = (wgid % nig) / gsz; return true;
    }
    __device__ __forceinline__ void a_ready(const Unit&) const {}
    __device__ __forceinline__ void done(const Unit&) const {}
};

__device__ __forceinline__ unsigned cvt_pk_bf16(float lo, float hi) { unsigned r; asm volatile("v_cvt_pk_bf16_f32 %0, %1, %2" : "=v"(r) : "v"(lo), "v"(hi)); return r; }
typedef float f32x2 __attribute__((ext_vector_type(2)));
template <class Epi, class Sched, bool ALIGN_EPI = false, bool SP2 = false>
__device__ __forceinline__ void gemm_phase(PG8_LAS unsigned char* lds, const Gemm g, const Sched& S, const Epi& E, int tid_in) {
    const int tid = tid_in, wid = __builtin_amdgcn_readfirstlane(tid >> 6), lane = tid & 63, wr = wid >> 2, wc = wid & 3, fr = lane & 15, fq = lane >> 4;
    const int K = g.K, nt = K / BK;
    unsigned voffA[2], voffB[2];
#pragma unroll
    for (int i = 0; i < 2; ++i) { int R, C; stage_rc(tid * 16 + i * 8192, R, C); const int Rb = Epi::PERM ? ((R & ~31) + perm32(R & 31)) : R;
        voffA[i] = (unsigned)(R * K + C) * 2u; voffB[i] = (unsigned)(Rb * K + C) * 2u; }
    const size_t kstep = (size_t)(BK * 2);
    const size_t hstep = (size_t)HALF * K * 2;
    const size_t tstep = 2 * hstep;
    const unsigned ldsw = (unsigned)wid * 1024u;
    const int aoff = lds_byte(wr * 64 + fr, fq * 8), boff = lds_byte(wc * 32 + fr, fq * 8);
#define PG8_SA(b, h) (((b) * 2 + (h)) * HTB)
#define PG8_SB(b, h) ((4 + (b) * 2 + (h)) * HTB)
#define PG8_STAGE(bufoff, gbase, voff) do { _Pragma("unroll") for (int _i = 0; _i < 2; ++_i) \
        __builtin_amdgcn_global_load_lds((const unsigned*)((const char*)(gbase) + (voff)[_i]), (PG8_LAS unsigned*)(lds + (bufoff) + ldsw + _i * 8192), 16, 0, 0); } while (0)
#define PG8_LDA(dst, b, h) do { _Pragma("unroll") for (int m = 0; m < 4; ++m) _Pragma("unroll") for (int k = 0; k < 2; ++k) dst[m][k] = *(const PG8_LAS bf16x8*)(lds + PG8_SA(b, h) + aoff + m * 2048 + k * 1024); } while (0)
#define PG8_LDB(dst, b, h) do { _Pragma("unroll") for (int n = 0; n < 2; ++n) _Pragma("unroll") for (int k = 0; k < 2; ++k) dst[n][k] = *(const PG8_LAS bf16x8*)(lds + PG8_SB(b, h) + boff + n * 2048 + k * 1024); } while (0)
#define PG8_MMA(ai, bj, At, Bt) do { __builtin_amdgcn_s_setprio(1); _Pragma("unroll") for (int m = 0; m < 4; ++m) _Pragma("unroll") for (int n = 0; n < 2; ++n) _Pragma("unroll") for (int k = 0; k < 2; ++k) \
        acc[ai][bj][m][n] = __builtin_amdgcn_mfma_f32_16x16x32_bf16(Bt[n][k], At[m][k], acc[ai][bj][m][n], 0, 0, 0); __builtin_amdgcn_s_setprio(0); } while (0)
#define PG8_WAIT_V(n) asm volatile("s_waitcnt vmcnt(" #n ")" ::: "memory")
#define PG8_WAIT_L(n) asm volatile("s_waitcnt lgkmcnt(" #n ")" ::: "memory")
#define PG8_BAR __builtin_amdgcn_s_barrier()
#define PG8_SCHED __builtin_amdgcn_sched_barrier(0)
    Unit cur, nxt; int ui = 0;
    if (!S.next(0, cur)) return;
    f32x4 acc[2][2][4][2];
#pragma unroll
    for (int a = 0; a < 2; ++a)
#pragma unroll
        for (int b = 0; b < 2; ++b)
#pragma unroll
            for (int m = 0; m < 4; ++m)
#pragma unroll
                for (int n = 0; n < 2; ++n) acc[a][b][m][n] = (f32x4){0.f, 0.f, 0.f, 0.f};
    bf16x8 At[4][2], B0[2][2], B1[2][2];
    const char* cA = (const char*)g.A + (size_t)cur.pm * tstep; const char* cB = (const char*)g.Bt + (size_t)cur.pn * tstep;
    S.a_ready(cur);
    if constexpr (SP2) {
        PG8_STAGE(PG8_SB(0, 0), cB, voffB); PG8_STAGE(PG8_SB(0, 1), cB + hstep, voffB); PG8_STAGE(PG8_SA(0, 0), cA, voffA); PG8_STAGE(PG8_SA(0, 1), cA + hstep, voffA);
        if (wr == 1) PG8_BAR;
        PG8_WAIT_V(2); PG8_BAR;
        PG8_STAGE(PG8_SB(1, 0), cB + kstep, voffB); PG8_STAGE(PG8_SA(1, 0), cA + kstep, voffA); PG8_STAGE(PG8_SB(1, 1), cB + hstep + kstep, voffB);
        PG8_WAIT_V(6); PG8_BAR;
    } else {
        PG8_STAGE(PG8_SB(0, 0), cB, voffB); PG8_STAGE(PG8_SA(0, 0), cA, voffA); PG8_STAGE(PG8_SB(0, 1), cB + hstep, voffB); PG8_STAGE(PG8_SA(0, 1), cA + hstep, voffA);
        if (wr == 1) PG8_BAR;
        PG8_WAIT_V(4); PG8_BAR;
        PG8_STAGE(PG8_SB(1, 0), cB + kstep, voffB); PG8_STAGE(PG8_SA(1, 0), cA + kstep, voffA); PG8_STAGE(PG8_SB(1, 1), cB + hstep + kstep, voffB);
        PG8_WAIT_V(6); PG8_BAR;
    }
    for (;;) {
        const bool has_next = S.next(ui + 1, nxt);
        const char* nA = has_next ? (const char*)g.A + (size_t)nxt.pm * tstep : cA; const char* nB = has_next ? (const char*)g.Bt + (size_t)nxt.pn * tstep : cB;
        for (int t = 0; t < nt; t += 2) {
            const bool last = (t == nt - 2);
            const char* a1 = cA + (size_t)(t + 1) * kstep;
            const char* a2 = last ? nA : cA + (size_t)(t + 2) * kstep; const char* b2 = last ? nB : cB + (size_t)(t + 2) * kstep;
            const char* a3 = a2 + kstep; const char* b3 = b2 + kstep;
            if (last && has_next) S.a_ready(nxt);
            if constexpr (SP2) {
            PG8_LDB(B0, 0, 0); PG8_LDB(B1, 0, 1); PG8_SCHED; PG8_LDA(At, 0, 0); PG8_STAGE(PG8_SA(1, 1), a1 + hstep, voffA);
            PG8_WAIT_V(8); PG8_WAIT_L(0); PG8_BAR; PG8_MMA(0, 0, At, B0); PG8_MMA(0, 1, At, B1); PG8_BAR; PG8_SCHED;
            PG8_LDA(At, 0, 1); PG8_STAGE(PG8_SB(0, 0), b2, voffB); PG8_STAGE(PG8_SB(0, 1), b2 + hstep, voffB); PG8_STAGE(PG8_SA(0, 0), a2, voffA);
            PG8_WAIT_V(8); PG8_WAIT_L(0); PG8_BAR; PG8_MMA(1, 0, At, B0); PG8_MMA(1, 1, At, B1); PG8_BAR; PG8_SCHED;
            PG8_LDB(B0, 1, 0); PG8_LDB(B1, 1, 1); PG8_SCHED; PG8_LDA(At, 1, 0); PG8_STAGE(PG8_SA(0, 1), a2 + hstep, voffA);
            PG8_WAIT_V(8); PG8_WAIT_L(0); PG8_BAR; PG8_MMA(0, 0, At, B0); PG8_MMA(0, 1, At, B1); PG8_BAR; PG8_SCHED;
            PG8_LDA(At, 1, 1); PG8_STAGE(PG8_SB(1, 0), b3, voffB); PG8_STAGE(PG8_SB(1, 1), b3 + hstep, voffB); PG8_STAGE(PG8_SA(1, 0), a3, voffA);
            PG8_WAIT_V(8); PG8_WAIT_L(0); PG8_BAR; PG8_MMA(1, 0, At, B0); PG8_MMA(1, 1, At, B1); PG8_BAR; PG8_SCHED;
            } else {
            PG8_LDB(B0, 0, 0); PG8_SCHED; PG8_LDA(At, 0, 0); PG8_STAGE(PG8_SA(1, 1), a1 + hstep, voffA);
            PG8_WAIT_L(8); PG8_BAR; PG8_WAIT_L(0); PG8_MMA(0, 0, At, B0); PG8_BAR; PG8_SCHED;
            PG8_LDB(B1, 0, 1); PG8_STAGE(PG8_SB(0, 0), b2, voffB);
            PG8_BAR; PG8_WAIT_L(0); PG8_MMA(0, 1, At, B1); PG8_BAR;
            PG8_LDA(At, 0, 1); PG8_STAGE(PG8_SA(0, 0), a2, voffA);
            PG8_BAR; PG8_WAIT_L(0); PG8_MMA(1, 0, At, B0); PG8_BAR; PG8_SCHED;
            PG8_STAGE(PG8_SB(0, 1), b2 + hstep, voffB);
            PG8_WAIT_V(6); PG8_BAR; PG8_MMA(1, 1, At, B1); PG8_BAR;
            PG8_LDB(B0, 1, 0); PG8_SCHED; PG8_LDA(At, 1, 0); PG8_STAGE(PG8_SA(0, 1), a2 + hstep, voffA);
            PG8_WAIT_L(8); PG8_BAR; PG8_WAIT_L(0); PG8_MMA(0, 0, At, B0); PG8_BAR; PG8_SCHED;
            PG8_LDB(B1, 1, 1); PG8_STAGE(PG8_SB(1, 0), b3, voffB);
            PG8_BAR; PG8_WAIT_L(0); PG8_MMA(0, 1, At, B1); PG8_BAR;
            PG8_LDA(At, 1, 1); PG8_STAGE(PG8_SA(1, 0), a3, voffA);
            PG8_BAR; PG8_WAIT_L(0); PG8_MMA(1, 0, At, B0); PG8_BAR; PG8_SCHED;
            PG8_STAGE(PG8_SB(1, 1), b3 + hstep, voffB);
            PG8_WAIT_V(6); PG8_BAR; PG8_MMA(1, 1, At, B1); PG8_BAR;
            }
        }
        if constexpr (ALIGN_EPI) { if (wr == 0) PG8_BAR; }
        if constexpr (!Epi::AFTER_DRAIN) { E(acc, cur, wr, wc, fr, fq); S.done(cur); }
        if (!has_next) break;
#pragma unroll
        for (int a = 0; a < 2; ++a)
#pragma unroll
            for (int b = 0; b < 2; ++b)
#pragma unroll
                for (int m = 0; m < 4; ++m)
#pragma unroll
                    for (int n = 0; n < 2; ++n) acc[a][b][m][n] = (f32x4){0.f, 0.f, 0.f, 0.f};
        cur = nxt; cA = nA; cB = nB; ++ui;
        if constexpr (ALIGN_EPI) { if (wr == 1) PG8_BAR; }
    }
    PG8_WAIT_V(0);
    if constexpr (!ALIGN_EPI) { if (wr == 0) PG8_BAR; }
    PG8_BAR;
    if constexpr (Epi::AFTER_DRAIN) { E.fused(acc, cur, wr, wc, fr, fq, lds, wid, lane); S.done(cur); }
#undef PG8_SA
#undef PG8_SB
#undef PG8_STAGE
#undef PG8_LDA
#undef PG8_LDB
#undef PG8_MMA
#undef PG8_WAIT_V
#undef PG8_WAIT_L
#undef PG8_BAR
#undef PG8_SCHED
}
}
namespace pg8 {
struct EpiInProj {
    static constexpr bool PERM = true, AFTER_DRAIN = false;
    ::bf16_t* P; const float* tabA; const float* tabB; const float* qn_g; const float* kn_g;
    __device__ __forceinline__ void operator()(const f32x4 (&acc)[2][2][4][2], const Unit& u, int wr_, int wc_, int fr_, int fq_) const {
        const int fr = opaque_v(fr_), fq = opaque_v(fq_), wr = opaque_s(wr_), wc = opaque_s(wc_);
        const int pn = u.pn, m0 = u.pm * BM; const int t0 = m0 % T; const bool lat = t0 < S;
        int type = 0; float qs = 1.f; const float* g = nullptr;
        if (pn == 0) { type = 3; qs = C2A; g = qn_g; }
        else if (pn == 1) { if (wc < 2) { type = 3; g = kn_g; } }
        else if (pn == 2 || pn == 6 || pn == 10 || pn == 12) type = 1;
        else if (pn == 3) { type = 4; qs = C2B; }
        else if (pn == 4) type = 4;
        else if (pn == 7) { type = 2; qs = C2A; }
        ::bf16_t* base = P + (size_t)(m0 + wr * 64 + fr) * NP + 256 * pn + 64 * wc + 8 * fq;
        f32x4 gv[2][2];
        if (type == 3) {
#pragma unroll
            for (int bj = 0; bj < 2; ++bj)
#pragma unroll
                for (int n = 0; n < 2; ++n) gv[bj][n] = *(const f32x4*)(g + 32 * bj + 16 * n + 4 * fq);
        }
#pragma unroll
        for (int ai = 0; ai < 2; ++ai) {
            const int prow = (t0 >> 6) + 2 * ai + wr;
#pragma unroll
            for (int m = 0; m < 4; ++m) {
                f32x4 v[2][2];
#pragma unroll
                for (int bj = 0; bj < 2; ++bj)
#pragma unroll
                    for (int n = 0; n < 2; ++n) v[bj][n] = acc[ai][bj][m][n];
                const int pcol = 16 * m + fr;
                if (type == 1) {
#pragma unroll
                    for (int bj = 0; bj < 2; ++bj)
#pragma unroll
                        for (int n = 0; n < 2; ++n)
#pragma unroll
                            for (int e = 0; e < 4; ++e) v[bj][n][e] = silu_f(v[bj][n][e]);
                } else if (type == 2) {
#pragma unroll
                    for (int bj = 0; bj < 2; ++bj)
#pragma unroll
                        for (int n = 0; n < 2; ++n) v[bj][n] = v[bj][n] * qs;
                } else if (type == 3) {
                    float ss = 0.f;
#pragma unroll
                    for (int bj = 0; bj < 2; ++bj)
#pragma unroll
                        for (int n = 0; n < 2; ++n) ss += (v[bj][n][0] * v[bj][n][0] + v[bj][n][1] * v[bj][n][1]) + (v[bj][n][2] * v[bj][n][2] + v[bj][n][3] * v[bj][n][3]);
                    ss += __shfl_xor(ss, 16); ss += __shfl_xor(ss, 32);
                    const float rs = rsqrtf(ss * (1.f / 64.f) + RMS_EPS);
#pragma unroll
                    for (int bj = 0; bj < 2; ++bj)
#pragma unroll
                        for (int n = 0; n < 2; ++n) v[bj][n] = v[bj][n] * rs * gv[bj][n];
                    if (lat) {
#pragma unroll
                        for (int bj = 0; bj < 2; ++bj) {
                            const int pos = bj == 0 ? prow : pcol;
                            const f32x4 t0v = *(const f32x4*)(tabA + (pos * 16 + 4 * fq) * 2), t1v = *(const f32x4*)(tabA + (pos * 16 + 4 * fq) * 2 + 4);
                            const float cs[4] = {t0v[0], t0v[2], t1v[0], t1v[2]}, sn[4] = {t0v[1], t0v[3], t1v[1], t1v[3]};
#pragma unroll
                            for (int e = 0; e < 4; ++e) { const float x1 = v[bj][0][e], x2 = v[bj][1][e]; v[bj][0][e] = x1 * cs[e] - x2 * sn[e]; v[bj][1][e] = x1 * sn[e] + x2 * cs[e]; }
                        }
                    }
                    if (qs != 1.f) {
#pragma unroll
                        for (int bj = 0; bj < 2; ++bj)
#pragma unroll
                            for (int n = 0; n < 2; ++n) v[bj][n] = v[bj][n] * qs;
                    }
                } else if (type == 4) {
                    if (lat) {
                        const int pos = (fq >> 1) == 0 ? prow : pcol;
                        const f32x4 t0v = *(const f32x4*)(tabB + (pos * 8 + 4 * (fq & 1)) * 2), t1v = *(const f32x4*)(tabB + (pos * 8 + 4 * (fq & 1)) * 2 + 4);
                        const float cs[4] = {t0v[0], t0v[2], t1v[0], t1v[2]}, sn[4] = {t0v[1], t0v[3], t1v[1], t1v[3]};
#pragma unroll
                        for (int bj = 0; bj < 2; ++bj)
#pragma unroll
                            for (int e = 0; e < 4; ++e) { const float x1 = v[bj][0][e], x2 = v[bj][1][e]; v[bj][0][e] = x1 * cs[e] - x2 * sn[e]; v[bj][1][e] = x1 * sn[e] + x2 * cs[e]; }
                    }
                    if (qs != 1.f) {
#pragma unroll
                        for (int bj = 0; bj < 2; ++bj)
#pragma unroll
                            for (int n = 0; n < 2; ++n) v[bj][n] = v[bj][n] * qs;
                    }
                }
                ::bf16_t* rowp = base + (size_t)(ai * HALF + m * 16) * NP;
#pragma unroll
                for (int bj = 0; bj < 2; ++bj) {
                    u32x4 w; w.x = cvt_pk_bf16(v[bj][0][0], v[bj][0][1]); w.y = cvt_pk_bf16(v[bj][0][2], v[bj][0][3]); w.z = cvt_pk_bf16(v[bj][1][0], v[bj][1][1]); w.w = cvt_pk_bf16(v[bj][1][2], v[bj][1][3]);
                    *(u32x4*)(rowp + 32 * bj) = w;
                }
            }
        }
    }
};
struct EpiOutProj {
    static constexpr bool PERM = false, AFTER_DRAIN = false;
    float* xl; float* xc; const float* mod_l;
    __device__ __forceinline__ void operator()(const f32x4 (&acc)[2][2][4][2], const Unit& u, int wr_, int wc_, int fr_, int fq_) const {
        const int fr = opaque_v(fr_), fq = opaque_v(fq_), wr = opaque_s(wr_), wc = opaque_s(wc_);
        const int m0 = u.pm * BM; const int b = m0 / T, t0 = m0 - b * T;
        float* xb = t0 < S ? xl + ((size_t)b * S + t0) * D : xc + ((size_t)b * CT + (t0 - S)) * D;
        const float* gate = mod_l + (size_t)(t0 < S ? b : 4) * 3 * D + 2 * D;
        const int col0 = u.pn * BM + wc * 32 + 4 * fq;
        f32x4 gv[2][2];
#pragma unroll
        for (int bj = 0; bj < 2; ++bj)
#pragma unroll
            for (int n = 0; n < 2; ++n) gv[bj][n] = *(const f32x4*)(gate + col0 + bj * HALF + n * 16);
#pragma unroll
        for (int ai = 0; ai < 2; ++ai)
#pragma unroll
            for (int m = 0; m < 4; ++m) {
                float* xr = xb + (size_t)(ai * HALF + wr * 64 + m * 16 + fr) * D + col0;
#pragma unroll
                for (int bj = 0; bj < 2; ++bj)
#pragma unroll
                    for (int n = 0; n < 2; ++n) { const f32x4 xv = *(const f32x4*)(xr + bj * HALF + n * 16); *(f32x4*)(xr + bj * HALF + n * 16) = xv * ALPHA + gv[bj][n] * acc[ai][bj][m][n]; }
            }
    }
};
struct EpiGlu {
    static constexpr bool PERM = true, AFTER_DRAIN = false;
    ::bf16_t* Y; const ::bf16_t* P;
    __device__ __forceinline__ void operator()(const f32x4 (&acc)[2][2][4][2], const Unit& u, int wr_, int wc_, int fr_, int fq_) const {
        const int fr = opaque_v(fr_), fq = opaque_v(fq_), wr = opaque_s(wr_), wc = opaque_s(wc_);
        const int m0 = u.pm * BM, col8 = 128 * u.pn + 32 * wc + 8 * fq;
#pragma unroll
        for (int ai = 0; ai < 2; ++ai)
#pragma unroll
            for (int m = 0; m < 4; ++m) {
                const size_t row = (size_t)(m0 + ai * HALF + wr * 64 + m * 16 + fr);
                const u32x4 gt = *(const u32x4*)(P + row * NP + DG + col8);
                float o[8];
#pragma unroll
                for (int n = 0; n < 2; ++n)
#pragma unroll
                    for (int e = 0; e < 4; ++e) { const float v = acc[ai][0][m][n][e], g = acc[ai][1][m][n][e]; o[4 * n + e] = v * sigm_f(g); }
                u32x4 w;
#pragma unroll
                for (int e = 0; e < 4; ++e) { const float ga = __uint_as_float(gt[e] << 16), gb = __uint_as_float(gt[e] & 0xffff0000u); w[e] = cvt_pk_bf16(o[2 * e] * ga, o[2 * e + 1] * gb); }
                *(u32x4*)(Y + row * D + 768 + col8) = w;
            }
    }
};
}
__device__ __forceinline__ float wave_sum(float v) {
#pragma unroll
    for (int o = 1; o < 64; o <<= 1) v += __shfl_xor(v, o);
    return v;
}
__device__ __forceinline__ void transpose_item(const float* W, int K, int N, bf16_t* WT, int kb, int nphys0, int lbase, int pt, LAS float* scr, int lane) {
    const int k0 = 64 * kb;
#pragma unroll 8
    for (int i = 0; i < 32; ++i) { const int kk = 2 * i + (lane >> 5); scr[kk * 33 + (lane & 31)] = W[(size_t)(k0 + kk) * N + lbase + (lane & 31)]; }
    asm volatile("s_waitcnt lgkmcnt(0)" ::: "memory");
    const int c = lane & 7;
#pragma unroll
    for (int j = 0; j < 4; ++j) {
        const int n = (lane >> 3) + 8 * j; const int fq = n >> 3, nn = (n >> 2) & 1, e = n & 3;
        const int lo = pt == 0 ? n : pt == 1 ? 16 * nn + 4 * fq + e : 16 * (fq >> 1) + 8 * nn + 4 * (fq & 1) + e;
        const LAS float* s = scr + (8 * c) * 33 + lo;
        u32x4 o; o.x = pk2(s[0 * 33], s[1 * 33]); o.y = pk2(s[2 * 33], s[3 * 33]); o.z = pk2(s[4 * 33], s[5 * 33]); o.w = pk2(s[6 * 33], s[7 * 33]);
        *(u32x4*)(WT + (size_t)(nphys0 + n) * K + k0 + 8 * c) = o;
    }
    asm volatile("s_waitcnt lgkmcnt(0)" ::: "memory");
}
__device__ __forceinline__ void phase_prologue(const Params& p, const KArgs& ka, LAS unsigned char* lds, int gw, int ngw, int wave, int lane) {
    {
        float* sm = (float*)(ka.ws + O_SMALL);
#pragma unroll
        for (int i = 0; i < 18; ++i) { const float* src = ka.in[8 + i]; float* dst = sm + sm_off(i); for (int e = gw * 64 + lane; e < SM_N[i]; e += ngw * 64) dst[e] = src[e]; }
    }
    LAS float* sc5 = (LAS float*)lds;
    LAS float* scr = (LAS float*)(lds + 20480 + wave * 9216);
    for (int i = threadIdx.x; i < 5 * D; i += NTHR) { const float v = i < 4 * D ? p.c[i] : p.c_ctx[i - 4 * D]; sc5[i] = v / (1.f + expf(-v)); }
    __syncthreads();
    for (int it = gw; it < NL * 48; it += ngw) {
        const int l = it / 48, j = (it % 48) * 64 + lane;
        const float* w = p.w_ada + (size_t)l * D * 3 * D + j;
        float a0 = 0.f, a1 = 0.f, a2 = 0.f, a3 = 0.f, a4 = 0.f;
#pragma unroll 8
        for (int k = 0; k < D; ++k) { const float wv = w[(size_t)k * 3 * D]; a0 += sc5[k] * wv; a1 += sc5[D + k] * wv; a2 += sc5[2 * D + k] * wv; a3 += sc5[3 * D + k] * wv; a4 += sc5[4 * D + k] * wv; }
        const float bb = p.b_ada[l * 3 * D + j]; float* o = p.mod + (size_t)l * 5 * 3 * D + j;
        o[0] = a0 + bb; o[3 * D] = a1 + bb; o[6 * D] = a2 + bb; o[9 * D] = a3 + bb; o[12 * D] = a4 + bb;
    }
    for (int i = gw * 64 + lane; i < 64 * 16 + 64 * 8; i += ngw * 64) {
        if (i < 1024) { const int pos = i >> 4, k = i & 15; const float an = (float)pos * powf(10000.f, -(float)k / 16.f); p.tabA[2 * i] = cosf(an); p.tabA[2 * i + 1] = sinf(an); }
        else { const int j = i - 1024, pos = j >> 3, k = j & 7; const float an = (float)pos * powf(10000.f, -(float)k / 8.f); p.tabB[2 * j] = cosf(an); p.tabB[2 * j + 1] = sinf(an); }
    }
    constexpr int I_IN = 16 * 104, I_OUT = 16 * 32, I_GLU = 4 * 16, I_L = I_IN + I_OUT + I_GLU;
    for (int it = gw; it < NL * I_L; it += ngw) {
        const int l = it / I_L; int r = it % I_L;
        if (r < I_IN) {
            const int kb = r / 104, nb = r % 104, c = 32 * nb, pn = c >> 8, bj = (c >> 7) & 1, wc = (c >> 5) & 3;
            const int pt = (pn == 0 || (pn == 1 && wc < 2)) ? 1 : (pn == 3 || pn == 4) ? 2 : 0;
            transpose_item(p.w_in + (size_t)l * D * NP, D, NP, p.Win_t + (size_t)l * NP * D, kb, c, 256 * pn + 64 * wc + 32 * bj, pt, scr, lane);
        } else if ((r -= I_IN) < I_OUT) {
            const int kb = r / 32, nb = r % 32;
            transpose_item(p.w_out + (size_t)l * D * D, D, D, p.Wout_t + (size_t)l * D * D, kb, 32 * nb, 32 * nb, 0, scr, lane);
        } else {
            r -= I_OUT; const int kb = r / 16, nb = r % 16, c = 32 * nb, pn = c >> 8, bj = (c >> 7) & 1, wc = (c >> 5) & 3;
            transpose_item(p.w_glu + (size_t)l * 256 * 512, 256, 512, p.Wglu_t + (size_t)l * 512 * 256, kb, c, 256 * bj + 128 * pn + 32 * wc, 0, scr, lane);
        }
    }
}
__device__ __forceinline__ void phase_rows(const Params& p, int l_prev, int l_next, int gw, int ngw, int lane) {
    for (int m = gw; m < MT; m += ngw) {
        const int b = m / T, t = m - b * T; const bool lat = t < S;
        if (l_next == NL && !lat) continue;
        float* xr = lat ? p.xl + ((size_t)b * S + t) * D : p.xc + ((size_t)b * CT + (t - S)) * D;
        f32x4 v[4];
        if (l_prev < 0) {
            const float* src = lat ? p.x + ((size_t)b * S + t) * D : p.ctx + ((size_t)b * CT + (t - S)) * D;
#pragma unroll
            for (int j = 0; j < 4; ++j) { v[j] = *(const f32x4*)(src + 4 * lane + 256 * j); *(f32x4*)(xr + 4 * lane + 256 * j) = v[j]; }
        } else {
            float s = 0.f;
#pragma unroll
            for (int j = 0; j < 4; ++j) { v[j] = *(const f32x4*)(xr + 4 * lane + 256 * j); s += (v[j][0] + v[j][1]) + (v[j][2] + v[j][3]); }
            const float mean = wave_sum(s) * (1.f / D); float q = 0.f;
#pragma unroll
            for (int j = 0; j < 4; ++j) { v[j] = v[j] - mean; q += (v[j][0] * v[j][0] + v[j][1] * v[j][1]) + (v[j][2] * v[j][2] + v[j][3] * v[j][3]); }
            const float rstd = rsqrtf(wave_sum(q) * (1.f / D) + LN_EPS);
#pragma unroll
            for (int j = 0; j < 4; ++j) {
                const f32x4 g = *(const f32x4*)(p.ln_g + l_prev * D + 4 * lane + 256 * j), be = *(const f32x4*)(p.ln_b + l_prev * D + 4 * lane + 256 * j);
                v[j] = v[j] * rstd * g + be; *(f32x4*)(xr + 4 * lane + 256 * j) = v[j];
            }
        }
        if (l_next < NL) {
            const float* md = p.mod + ((size_t)l_next * 5 + (lat ? b : 4)) * 3 * D;
            bf16_t* ar = p.A + (size_t)m * D;
#pragma unroll
            for (int j = 0; j < 4; ++j) {
                const f32x4 sh = *(const f32x4*)(md + 4 * lane + 256 * j), sc = *(const f32x4*)(md + D + 4 * lane + 256 * j);
                const f32x4 h = v[j] * (sc + 1.f) + sh;
                u32x2 w; w.x = pk2(h[0], h[1]); w.y = pk2(h[2], h[3]); *(u32x2*)(ar + 4 * lane + 256 * j) = w;
            }
        }
    }
}
namespace att {
typedef short bf16x8 __attribute__((ext_vector_type(8)));
typedef short s16x4 __attribute__((ext_vector_type(4)));
typedef float f32x16 __attribute__((ext_vector_type(16)));
typedef float f32x2_t __attribute__((ext_vector_type(2)));
typedef __bf16 bf16x2_t __attribute__((ext_vector_type(2)));
constexpr int SLOT = 16384, L_RING = 0, L_OST = 49152, L_WSF = L_OST + 8 * 8192, L_RPB = L_WSF + 8 * 256, L_END = L_RPB + 2048;
constexpr float THR = 6.f;
#define ATT_MFMA(a, b, c) __builtin_amdgcn_mfma_f32_32x32x16_bf16(a, b, c, 0, 0, 0)
#define ATT_WAIT_BAR(N) asm volatile("s_waitcnt vmcnt(" #N ") lgkmcnt(0)\n\ts_barrier" ::: "memory")
__device__ __forceinline__ int crow(int r, int hi) { return (r & 3) + 8 * (r >> 2) + 4 * hi; }
__device__ __forceinline__ unsigned cvtpk(float lo, float hi) { f32x2_t v = {lo, hi}; bf16x2_t b = __builtin_convertvector(v, bf16x2_t); return __builtin_bit_cast(unsigned, b); }
__device__ __forceinline__ void glds16(const void* g, unsigned lds_base) {
    unsigned sv; asm volatile("s_mov_b32 %0, m0\n\ts_mov_b32 m0, %2\n\ts_nop 0\n\tglobal_load_lds_dwordx4 %1, off\n\ts_mov_b32 m0, %0" : "=&s"(sv) : "v"(g), "s"(lds_base) : "memory"); }
#define ATT_MX3(a, b, c) __builtin_fmaxf(__builtin_fmaxf((a), (b)), (c))
__device__ __forceinline__ float rowmax(const f32x16& p0, const f32x16& p1) {
    float a = ATT_MX3(p0[0], p0[1], p1[0]), b = ATT_MX3(p0[2], p0[3], p1[1]); a = ATT_MX3(a, p1[2], p1[3]);
#pragma unroll
    for (int r = 4; r < 16; r += 4) { a = ATT_MX3(a, p0[r], p0[r + 1]); b = ATT_MX3(b, p0[r + 2], p0[r + 3]); a = ATT_MX3(a, p1[r], p1[r + 1]); b = ATT_MX3(b, p1[r + 2], p1[r + 3]); }
    float m = __builtin_fmaxf(a, b); auto rr = __builtin_amdgcn_permlane32_swap(__float_as_uint(m), __float_as_uint(m), false, false);
    return __builtin_fmaxf(__uint_as_float(rr[0]), __uint_as_float(rr[1])); }
__device__ __forceinline__ float rowsum(const f32x16& p0, const f32x16& p1) {
    float a = 0.f, b = 0.f;
#pragma unroll
    for (int r = 0; r < 16; r += 2) { a += p0[r] + p1[r]; b += p0[r + 1] + p1[r + 1]; }
    return a + b; }
__device__ __forceinline__ void vfrags(bf16x8 (&vf)[4], int vb, int d0) {
    s16x4 lo[4], hi[4];
    if (d0 == 0) {
#pragma unroll
        for (int ks = 0; ks < 4; ++ks) {
            asm volatile("ds_read_b64_tr_b16 %0,%1 offset:%c2" : "=&v"(lo[ks]) : "v"(vb), "i"(ks * 1024) : "memory");
            asm volatile("ds_read_b64_tr_b16 %0,%1 offset:%c2" : "=&v"(hi[ks]) : "v"(vb), "i"(ks * 1024 + 512) : "memory"); }
    } else {
#pragma unroll
        for (int ks = 0; ks < 4; ++ks) {
            asm volatile("ds_read_b64_tr_b16 %0,%1 offset:%c2" : "=&v"(lo[ks]) : "v"(vb), "i"(4096 + ks * 1024) : "memory");
            asm volatile("ds_read_b64_tr_b16 %0,%1 offset:%c2" : "=&v"(hi[ks]) : "v"(vb), "i"(4096 + ks * 1024 + 512) : "memory"); }
    }
    asm volatile("s_waitcnt lgkmcnt(0)" : "+v"(lo[0]), "+v"(lo[1]), "+v"(lo[2]), "+v"(lo[3]), "+v"(hi[0]), "+v"(hi[1]), "+v"(hi[2]), "+v"(hi[3]) :: "memory");
#pragma unroll
    for (int ks = 0; ks < 4; ++ks) vf[ks] = (bf16x8){lo[ks][0], lo[ks][1], lo[ks][2], lo[ks][3], hi[ks][0], hi[ks][1], hi[ks][2], hi[ks][3]};
}
struct PW { u32x4 w[4]; };
__device__ __forceinline__ void packp(PW& pw, const f32x16& p0, const f32x16& p1) {
#pragma unroll
    for (int i = 0; i < 4; ++i) { pw.w[0][i] = cvtpk(p0[2 * i], p0[2 * i + 1]); pw.w[1][i] = cvtpk(p0[8 + 2 * i], p0[9 + 2 * i]); pw.w[2][i] = cvtpk(p1[2 * i], p1[2 * i + 1]); pw.w[3][i] = cvtpk(p1[8 + 2 * i], p1[9 + 2 * i]); }
}
__device__ __forceinline__ bool softmax_tile(f32x16& p0, f32x16& p1, float& mhat, float& l_reg, float& f, bool first) {
    const float rm = rowmax(p0, p1);
    bool resc = false; f = 1.f;
    if (first || __any(rm > THR)) {
        const float dl = first ? rm : __builtin_fmaxf(rm, 0.f); mhat += dl;
#pragma unroll
        for (int r = 0; r < 16; ++r) { p0[r] -= dl; p1[r] -= dl; }
        if (!first) { f = __builtin_amdgcn_exp2f(-dl); l_reg *= f; resc = true; }
    }
#pragma unroll
    for (int r = 0; r < 16; ++r) { p0[r] = __builtin_amdgcn_exp2f(p0[r]); p1[r] = __builtin_amdgcn_exp2f(p1[r]); }
    l_reg += rowsum(p0, p1);
    return resc;
}
struct UnitDesc { int var, b, h, kvh, qrow0, f0, n0, f1, n1; };
struct LayerConst { int l; float lam, one_m_lam_init; };

template <int VAR> __device__ __forceinline__ void attn_unit(const Params& p, const UnitDesc& u, const LayerConst& lc, LAS unsigned char* lds, int tid_in) {
    const int tid = opaque_v(tid_in), lane = tid & 63, r32 = lane & 31, hi = lane >> 5; const int wid = __builtin_amdgcn_readfirstlane(tid >> 6);
    constexpr int QOFF = VAR == 0 ? AQ : VAR == 1 ? BQ : CQ, KOFF = VAR == 0 ? AK : VAR == 1 ? BK : CK, VOFF = VAR == 0 ? AV : VAR == 1 ? BV : CV, GOFF = VAR == 0 ? AG : VAR == 1 ? BG : CG, YOFF = VAR * 256;
    const size_t rowb = (size_t)u.b * T;
    const unsigned lds0 = (unsigned)(uintptr_t)lds;
    LAS float* wsf = (LAS float*)(lds + L_WSF) + wid * 64;
    LAS float* ost = (LAS float*)(lds + L_OST) + wid * 2048;
    LAS float* rpbL = (LAS float*)(lds + L_RPB);
    const int NT = u.n0 + u.n1;
    const bf16_t* kbase = p.P + (rowb + lane) * NP + KOFF + u.kvh * 64 + wid * 8;
    const bf16_t* vbase = p.P + (rowb + 16 * (wid & 3) + (lane >> 2)) * NP + VOFF + u.kvh * 64 + (wid >> 2) * 32 + (lane & 3) * 8;
#define ATT_TROW(j) (((j) < u.n0 ? u.f0 + (j) : u.f1 + ((j) - u.n0)) * 64)
#define ATT_DMA(j, slot) do { const size_t ro_ = (size_t)ATT_TROW(j) * NP; \
        glds16(kbase + ro_, (unsigned)__builtin_amdgcn_readfirstlane(lds0 + L_RING + (slot) * SLOT + wid * 1024)); \
        glds16(vbase + ro_, (unsigned)__builtin_amdgcn_readfirstlane(lds0 + L_RING + (slot) * SLOT + 8192 + wid * 1024)); } while (0)
    ATT_DMA(0, 0);
    if (NT > 1) ATT_DMA(1, 1);
    if (VAR == 2) { for (int i = tid; i < 15 * 31; i += NTHR) rpbL[i] = p.rpb[((size_t)lc.l * 4 + u.h) * 15 * 31 + i] * LOG2E; }
    const bf16_t* qp = p.P + (rowb + u.qrow0 + wid * 32 + r32) * NP + QOFF + u.h * 64 + hi * 8;
    bf16x8 qr[4];
#pragma unroll
    for (int d0 = 0; d0 < 4; ++d0) qr[d0] = *(const bf16x8*)(qp + d0 * 16);
    const int qt = u.qrow0 + wid * 32 + r32; const int gr = qt >> 6, gwc = qt & 63;
    const int rs0 = min(max(gr - 4, 0), 56), cs0 = min(max(gwc - 8, 0), 48);
    const bool latq = u.qrow0 < S;
    f32x16 o[2], o2[2]; o[0] = f32x16{}; o[1] = f32x16{}; o2[0] = f32x16{}; o2[1] = f32x16{};
    float mhat = 0.f, l_reg = 0.f, mhat2 = 0.f, l_reg2 = 0.f;
    f32x16 negm = f32x16{}, negm2 = f32x16{};
    bool started = false;
    for (int j = 0; j < NT; ++j) {
        if (j + 1 < NT) ATT_WAIT_BAR(2); else ATT_WAIT_BAR(0);
        if (j + 2 < NT) { const int s2 = (j + 2) % 3; ATT_DMA(j + 2, s2); }
        const int sl = (j % 3) * SLOT;
        const int trow = ATT_TROW(j);
        bool active = true; const bool wintile = (VAR == 2) && latq && trow < S;
        if (wintile) { const int kr = trow >> 6; active = (kr >= rs0) && (kr < rs0 + 8); }
        if (!active) continue;
        const LAS unsigned char* kp = lds + L_RING + sl + hi * 1024 + r32 * 16;
        const int vb = (int)(lds0 + L_RING + sl + 8192) + ((lane >> 4) & 1) * 32 + (lane & 3) * 8 + (4 * hi + ((lane & 15) >> 2)) * 64;
        if (VAR != 1) {
            f32x16 p0, p1;
#pragma unroll
            for (int d0 = 0; d0 < 4; ++d0) {
                const bf16x8 b0 = *(const LAS bf16x8*)(kp + d0 * 2048), b1 = *(const LAS bf16x8*)(kp + d0 * 2048 + 512);
                p0 = ATT_MFMA(b0, qr[d0], d0 == 0 ? negm : p0); p1 = ATT_MFMA(b1, qr[d0], d0 == 0 ? negm : p1);
            }
            if (wintile) {
                const int kr = trow >> 6; const LAS float* brow = rpbL + (kr - gr + 7) * 31 + 15 - gwc;
#pragma unroll
                for (int r = 0; r < 16; ++r) {
                    const int kc = crow(r, hi);
                    p0[r] = ((unsigned)(kc - cs0) < 16u) ? p0[r] + brow[kc] : -INFINITY;
                    p1[r] = ((unsigned)(kc + 32 - cs0) < 16u) ? p1[r] + brow[kc + 32] : -INFINITY;
                }
            }
            float f; const bool resc = softmax_tile(p0, p1, mhat, l_reg, f, !started);
            if (resc || !started) {
#pragma unroll
                for (int r = 0; r < 16; ++r) negm[r] = -mhat;
            }
            if (resc) {
                if (hi == 0) wsf[r32] = f;
#pragma unroll
                for (int d_ = 0; d_ < 2; ++d_)
#pragma unroll
                    for (int r = 0; r < 16; ++r) o[d_][r] *= wsf[crow(r, hi)];
            }
            started = true;
            PW pw; packp(pw, p0, p1);
#pragma unroll
            for (int d0 = 0; d0 < 2; ++d0) {
                bf16x8 vf[4]; vfrags(vf, vb, d0);
#pragma unroll
                for (int ks = 0; ks < 4; ++ks) o[d0] = ATT_MFMA(__builtin_bit_cast(bf16x8, pw.w[ks]), vf[ks], o[d0]);
            }
        } else {
            PW pw, pw2; float f = 1.f, f2 = 1.f; bool resc = false;
            {
                f32x16 p0 = f32x16{}, p1 = f32x16{};
#pragma unroll
                for (int d0 = 0; d0 < 2; ++d0) {
                    const bf16x8 b0 = *(const LAS bf16x8*)(kp + d0 * 2048), b1 = *(const LAS bf16x8*)(kp + d0 * 2048 + 512);
                    p0 = ATT_MFMA(b0, qr[d0], p0); p1 = ATT_MFMA(b1, qr[d0], p1);
                }
                const float rm = rowmax(p0, p1);
                if (!started) mhat = rm;
                else if (__any(rm - mhat > THR)) { const float mn = __builtin_fmaxf(mhat, rm); f = __builtin_amdgcn_exp2f(mhat - mn); mhat = mn; l_reg *= f; resc = true; }
#pragma unroll
                for (int r = 0; r < 16; ++r) { p0[r] = __builtin_amdgcn_exp2f(p0[r] - mhat); p1[r] = __builtin_amdgcn_exp2f(p1[r] - mhat); }
                l_reg += rowsum(p0, p1);
                packp(pw, p0, p1);
            }
            {
                f32x16 q0 = f32x16{}, q1 = f32x16{};
#pragma unroll
                for (int d0 = 2; d0 < 4; ++d0) {
                    const bf16x8 b0 = *(const LAS bf16x8*)(kp + d0 * 2048), b1 = *(const LAS bf16x8*)(kp + d0 * 2048 + 512);
                    q0 = ATT_MFMA(b0, qr[d0], q0); q1 = ATT_MFMA(b1, qr[d0], q1);
                }
                const float rm = rowmax(q0, q1);
                if (!started) mhat2 = rm;
                else if (__any(rm - mhat2 > THR)) { const float mn = __builtin_fmaxf(mhat2, rm); f2 = __builtin_amdgcn_exp2f(mhat2 - mn); mhat2 = mn; l_reg2 *= f2; resc = true; }
#pragma unroll
                for (int r = 0; r < 16; ++r) { q0[r] = __builtin_amdgcn_exp2f(q0[r] - mhat2); q1[r] = __builtin_amdgcn_exp2f(q1[r] - mhat2); }
                l_reg2 += rowsum(q0, q1);
                packp(pw2, q0, q1);
            }
            if (resc) {
                if (hi == 0) { wsf[r32] = f; wsf[32 + r32] = f2; }
#pragma unroll
                for (int d_ = 0; d_ < 2; ++d_)
#pragma unroll
                    for (int r = 0; r < 16; ++r) { o[d_][r] *= wsf[crow(r, hi)]; o2[d_][r] *= wsf[32 + crow(r, hi)]; }
            }
            started = true;
#pragma unroll
            for (int d0 = 0; d0 < 2; ++d0) {
                bf16x8 vf[4]; vfrags(vf, vb, d0);
#pragma unroll
                for (int ks = 0; ks < 4; ++ks) { o[d0] = ATT_MFMA(__builtin_bit_cast(bf16x8, pw.w[ks]), vf[ks], o[d0]); o2[d0] = ATT_MFMA(__builtin_bit_cast(bf16x8, pw2.w[ks]), vf[ks], o2[d0]); }
            }
        }
    }
    { auto rr = __builtin_amdgcn_permlane32_swap(__float_as_uint(l_reg), __float_as_uint(l_reg), false, false); l_reg = __uint_as_float(rr[0]) + __uint_as_float(rr[1]); }
    if (VAR == 1) { auto rr = __builtin_amdgcn_permlane32_swap(__float_as_uint(l_reg2), __float_as_uint(l_reg2), false, false); l_reg2 = __uint_as_float(rr[0]) + __uint_as_float(rr[1]); }
    if (hi == 0) { wsf[r32] = 1.f / l_reg; if (VAR == 1) wsf[32 + r32] = lc.lam / l_reg2; }
#pragma unroll
    for (int r = 0; r < 16; ++r) {
        const int orow = crow(r, hi); const float a1 = wsf[orow];
        if (VAR == 1) { const float a2 = wsf[32 + orow]; ost[orow * 64 + r32] = o[0][r] * a1 - o2[0][r] * a2; ost[orow * 64 + 32 + r32] = o[1][r] * a1 - o2[1][r] * a2; }
        else { ost[orow * 64 + r32] = o[0][r] * a1; ost[orow * 64 + 32 + r32] = o[1][r] * a1; }
    }
    asm volatile("s_waitcnt lgkmcnt(0)" ::: "memory");
    const size_t mrow0 = rowb + u.qrow0 + wid * 32;
#pragma unroll
    for (int i = 0; i < 4; ++i) {
        const int row = i * 8 + (lane >> 3), ch = lane & 7;
        const f32x4 x0 = *(const LAS f32x4*)(ost + row * 64 + ch * 8), x1 = *(const LAS f32x4*)(ost + row * 64 + ch * 8 + 4);
        float v[8] = {x0[0], x0[1], x0[2], x0[3], x1[0], x1[1], x1[2], x1[3]};
        if (VAR == 1) {
            float ss = 0.f;
#pragma unroll
            for (int e = 0; e < 8; ++e) ss += v[e] * v[e];
            ss += __shfl_xor(ss, 1); ss += __shfl_xor(ss, 2); ss += __shfl_xor(ss, 4);
            const float rs = rsqrtf(ss * (1.f / 64.f) + RMS_EPS) * lc.one_m_lam_init;
            const f32x4 g0 = *(const f32x4*)(p.subln_g + lc.l * 64 + ch * 8), g1 = *(const f32x4*)(p.subln_g + lc.l * 64 + ch * 8 + 4);
            const float gg[8] = {g0[0], g0[1], g0[2], g0[3], g1[0], g1[1], g1[2], g1[3]};
#pragma unroll
            for (int e = 0; e < 8; ++e) v[e] *= rs * gg[e];
        }
        const u32x4 gt = *(const u32x4*)(p.P + (mrow0 + row) * NP + GOFF + u.h * 64 + ch * 8);
        u32x4 w;
#pragma unroll
        for (int e = 0; e < 4; ++e) { const float ga = __uint_as_float(gt[e] << 16), gb = __uint_as_float(gt[e] & 0xffff0000u); w[e] = cvtpk(v[2 * e] * ga, v[2 * e + 1] * gb); }
        *(u32x4*)(p.A + (mrow0 + row) * D + YOFF + u.h * 64 + ch * 8) = w;
    }
    asm volatile("s_waitcnt lgkmcnt(0)\n\ts_barrier" ::: "memory");
#undef ATT_TROW
#undef ATT_DMA
}

__device__ __forceinline__ void attn_phase(const Params& p, int l, LAS unsigned char* lds, int v, int G, int tid_in) {
    float d1 = 0.f, d2 = 0.f;
    for (int i = 0; i < 32; ++i) { d1 += p.lq1[l * 32 + i] * p.lk1[l * 32 + i]; d2 += p.lq2[l * 32 + i] * p.lk2[l * 32 + i]; }
    const float lam_init = 0.8f - 0.6f * expf(-0.3f * (float)l);
    LayerConst lc{l, expf(d1) - expf(d2) + lam_init, 1.f - lam_init};
    const bool need_ctx = l < NL - 1;
    for (int uidx = v; uidx < 256; uidx += G) {
        { UnitDesc u; u.var = 0; u.b = uidx >> 6; u.kvh = (uidx >> 5) & 1; u.h = u.kvh * 2 + ((uidx >> 4) & 1); u.qrow0 = (uidx & 15) * 256; u.f0 = 0; u.n0 = 68; u.f1 = 0; u.n1 = 0; attn_unit<0>(p, u, lc, lds, tid_in); }
        { UnitDesc u; u.var = 1; u.b = uidx >> 6; u.h = (uidx >> 4) & 3; u.kvh = u.h; u.qrow0 = (uidx & 15) * 256; u.f0 = 0; u.n0 = 68; u.f1 = 0; u.n1 = 0; attn_unit<1>(p, u, lc, lds, tid_in); }
        { UnitDesc u; u.var = 2; u.b = uidx >> 6; u.h = (uidx >> 4) & 3; u.kvh = u.h; const int qb = uidx & 15; u.qrow0 = qb * 256;
          const int ra = min(max(4 * qb - 4, 0), 56), rb = min(max(4 * qb + 3 - 4, 0), 56) + 8; u.f0 = 64; u.n0 = 4; u.f1 = ra; u.n1 = rb - ra; attn_unit<2>(p, u, lc, lds, tid_in); }
    }
    if (need_ctx) {
        for (int uidx = v; uidx < 48; uidx += G) {
            const int var = uidx >> 4, b = (uidx >> 2) & 3, h = uidx & 3;
            UnitDesc u; u.var = var; u.b = b; u.h = h; u.kvh = var == 0 ? (h >> 1) : h; u.qrow0 = S; u.f0 = 64; u.n0 = 4; u.f1 = 0; u.n1 = 0;
            if (var == 0) attn_unit<0>(p, u, lc, lds, tid_in); else if (var == 1) attn_unit<1>(p, u, lc, lds, tid_in); else attn_unit<2>(p, u, lc, lds, tid_in);
        }
    }
}
}
namespace s5m {
typedef short bf16x8 __attribute__((ext_vector_type(8)));
constexpr int NCK = T / 16;
constexpr int TT_SZ = 31 * 256, E_SZ = 2 * 128 * 256, F_SZ = 2 * 256 * 128;
#define S5_MFMA(a, b, c) __builtin_amdgcn_mfma_f32_16x16x32_bf16(a, b, c, 0, 0, 0)
__device__ __forceinline__ void build_a(const Params& p, int gw, int ngw, int lane) {
    for (int it = gw * 64 + lane; it < NL * 2 * 16 * 64; it += ngw * 64) {
        const size_t ip = (size_t)it; const int ig = it >> 6;
        float* dsc = p.disc + ip * 34;
        const double ar = p.a_re[ip], ai = p.a_im[ip], dt = exp((double)p.log_dt[ig]);
        const double e = exp(ar * dt), lr = e * cos(ai * dt), li = e * sin(ai * dt);
        const double nr = lr - 1.0, ni = li, den = ar * ar + ai * ai; const double cr = (nr * ar + ni * ai) / den, ci = (ni * ar - nr * ai) / den;
        dsc[0] = (float)lr; dsc[1] = (float)li;
        for (int c = 0; c < 16; ++c) { const double br = p.b_re[ip * 16 + c], bi = p.b_im[ip * 16 + c]; dsc[2 + c] = (float)(cr * br - ci * bi); dsc[18 + c] = (float)(cr * bi + ci * br); }
        double pr = 1.0, pi = 0.0; float* lp = p.lampow + ip * 34;
        for (int k = 0; k <= 16; ++k) { lp[2 * k] = (float)pr; lp[2 * k + 1] = (float)pi; if (k < 16) { const double tr = pr * lr - pi * li, ti = pr * li + pi * lr; pr = tr; pi = ti; } }
        const double a_r = pr, a_i = pi; double qr = pr, qi = pi; float* ap = p.apow + ip * 32;
        for (int j = 1; j <= 16; ++j) { ap[2 * (j - 1)] = (float)qr; ap[2 * (j - 1) + 1] = (float)qi; const double tr = qr * a_r - qi * a_i, ti = qr * a_i + qi * a_r; qr = tr; qi = ti; }
    }
}
__device__ __forceinline__ void build_b(const Params& p, int gw, int ngw, int lane) {
    constexpr int NE = NL * 16 * 2 * 128 * 32;
    for (int it = gw * 64 + lane; it < NE; it += ngw * 64) {
        {
            const int half = it & 1, s = (it >> 1) & 15, row = (it >> 5) & 127, dir = (it >> 12) & 1, lg = it >> 13, g = lg & 15, l = lg >> 4;
            const int part = row & 1, st = row >> 1; const size_t ip = (size_t)((l * 2 + dir) * 16 + g) * 64 + st;
            const int k = dir == 0 ? 15 - s : s; const float wr = p.lampow[ip * 34 + 2 * k], wi = p.lampow[ip * 34 + 2 * k + 1];
            float v[8];
#pragma unroll
            for (int c = 0; c < 8; ++c) { const float br = p.disc[ip * 34 + 2 + half * 8 + c], bi = p.disc[ip * 34 + 18 + half * 8 + c]; v[c] = part == 0 ? wr * br - wi * bi : wr * bi + wi * br; }
            u32x4 o; o.x = pk2(v[0], v[1]); o.y = pk2(v[2], v[3]); o.z = pk2(v[4], v[5]); o.w = pk2(v[6], v[7]);
            *(u32x4*)(p.Etab + (size_t)it * 8) = o;
        }
        {
            const int k8 = it & 15, row = (it >> 4) & 255, dir = (it >> 12) & 1, lg = it >> 13, g = lg & 15, l = lg >> 4;
            const int st0 = k8 * 4, t = row >> 4, c = row & 15; const size_t ig = (size_t)((l * 2 + dir) * 16 + g);
            const int k = dir == 0 ? t + 1 : 16 - t;
            float v[8];
#pragma unroll
            for (int j = 0; j < 4; ++j) {
                const size_t ip = ig * 64 + st0 + j; const float wr = p.lampow[ip * 34 + 2 * k], wi = p.lampow[ip * 34 + 2 * k + 1];
                const float cr = p.c_re[(ig * 16 + c) * 64 + st0 + j], ci = p.c_im[(ig * 16 + c) * 64 + st0 + j];
                v[2 * j] = cr * wr - ci * wi; v[2 * j + 1] = -(cr * wi + ci * wr);
            }
            u32x4 o; o.x = pk2(v[0], v[1]); o.y = pk2(v[2], v[3]); o.z = pk2(v[4], v[5]); o.w = pk2(v[6], v[7]);
            *(u32x4*)(p.Ftab + (size_t)it * 8) = o;
        }
    }
    for (int it = gw * 64 + lane; it < NL * 16 * 31 * 256; it += ngw * 64) {
        const int cc = it & 15, c = (it >> 4) & 15, ti = (it >> 8) % 31, lg = it / (31 * 256), g = lg & 15, l = lg >> 4;
        float acc = 0.f;
        for (int dir = 0; dir < 2; ++dir) {
            if ((dir == 0 && ti < 15) || (dir == 1 && ti > 15)) continue;
            const int tau = dir == 0 ? ti - 15 : 15 - ti;
            const size_t ig = (size_t)((l * 2 + dir) * 16 + g);
            const float* cre = p.c_re + (ig * 16 + c) * 64; const float* cim = p.c_im + (ig * 16 + c) * 64;
            for (int st = 0; st < 64; ++st) {
                const size_t ip = ig * 64 + st;
                const float wr = p.lampow[ip * 34 + 2 * tau], wi = p.lampow[ip * 34 + 2 * tau + 1];
                const float br = p.disc[ip * 34 + 2 + cc], bi = p.disc[ip * 34 + 18 + cc];
                const float xr = wr * br - wi * bi, xi = wr * bi + wi * br;
                acc += cre[st] * xr - cim[st] * xi;
            }
        }
        p.Ttab[(size_t)it] = f2bf(acc);
    }
}
constexpr int L_HIN = 0, L_UT = NCK * 512, L_S5END = L_UT + 2 * 8192;
template <int CTRL> __device__ __forceinline__ float dppf(float x) { return __int_as_float(__builtin_amdgcn_update_dpp(0, __float_as_int(x), CTRL, 0xf, 0xf, true)); }
template <int CTRL> __device__ __forceinline__ void hs_stage(f32x4& X, float a0r, float a0i, float a1r, float a1i) {
    const float y0 = dppf<CTRL>(X[0]), y1 = dppf<CTRL>(X[1]), y2 = dppf<CTRL>(X[2]), y3 = dppf<CTRL>(X[3]);
    X[0] += a0r * y0 - a0i * y1; X[1] += a0r * y1 + a0i * y0; X[2] += a1r * y2 - a1i * y3; X[3] += a1r * y3 + a1i * y2;
}
template <int DIR> __device__ __forceinline__ void scan_tile(f32x4& X, f32x4& Cin, const float (&a1)[2][2], const float (&apos)[2][2], int lane, int nn) {
    constexpr int B = DIR == 0 ? 0x110 : 0x100;
    float p0r = a1[0][0], p0i = a1[0][1], p1r = a1[1][0], p1i = a1[1][1];
    hs_stage<B + 1>(X, p0r, p0i, p1r, p1i);
    { const float t0 = p0r * p0r - p0i * p0i, t1 = 2.f * p0r * p0i, t2 = p1r * p1r - p1i * p1i, t3 = 2.f * p1r * p1i; p0r = t0; p0i = t1; p1r = t2; p1i = t3; }
    hs_stage<B + 2>(X, p0r, p0i, p1r, p1i);
    { const float t0 = p0r * p0r - p0i * p0i, t1 = 2.f * p0r * p0i, t2 = p1r * p1r - p1i * p1i, t3 = 2.f * p1r * p1i; p0r = t0; p0i = t1; p1r = t2; p1i = t3; }
    hs_stage<B + 4>(X, p0r, p0i, p1r, p1i);
    { const float t0 = p0r * p0r - p0i * p0i, t1 = 2.f * p0r * p0i, t2 = p1r * p1r - p1i * p1i, t3 = 2.f * p1r * p1i; p0r = t0; p0i = t1; p1r = t2; p1i = t3; }
    hs_stage<B + 8>(X, p0r, p0i, p1r, p1i);
    f32x4 Tt;
    Tt[0] = X[0] + apos[0][0] * Cin[0] - apos[0][1] * Cin[1]; Tt[1] = X[1] + apos[0][0] * Cin[1] + apos[0][1] * Cin[0];
    Tt[2] = X[2] + apos[1][0] * Cin[2] - apos[1][1] * Cin[3]; Tt[3] = X[3] + apos[1][0] * Cin[3] + apos[1][1] * Cin[2];
    f32x4 Ex; const bool first = DIR == 0 ? nn == 0 : nn == 15;
#pragma unroll
    for (int i = 0; i < 4; ++i) { const float sh = dppf<B + 1>(Tt[i]); Ex[i] = first ? Cin[i] : sh; }
    const int src = DIR == 0 ? ((lane & 48) | 15) : (lane & 48);
#pragma unroll
    for (int i = 0; i < 4; ++i) Cin[i] = __shfl(Tt[i], src);
    X = Ex;
}
__device__ __forceinline__ void unit(const Params& p, int l, int b, int g, LAS unsigned char* lds, int tid_in) {
    const int tid = opaque_v(tid_in), lane = tid & 63, wave = __builtin_amdgcn_readfirstlane(tid >> 6), nn = lane & 15, kg = lane >> 4;
    const size_t rowb = (size_t)b * T;
    LAS unsigned char* HIN = lds + L_HIN; LAS unsigned char* UT = lds + L_UT;
    const int sj = tid >> 5, sq = tid & 31;
    const bf16_t* usrc = p.P + (rowb + sj * 16 + (sq >> 1)) * NP + DU + g * 16 + (sq & 1) * 8;
    const int udst = sj * 512 + ((sq ^ sj) * 16);
#define S5_ULOAD(cb) (*(const u32x4*)(usrc + (size_t)(cb) * 256 * NP))
#define S5_UWRITE(cb, r) (*(LAS u32x4*)(UT + ((cb) & 1) * 8192 + udst) = (r))
#define S5_UFRAG(cb, kb) (*(const LAS bf16x8*)(UT + ((cb) & 1) * 8192 + nn * 512 + ((((2 * (kb) + (kg >> 1)) * 2 + (kg & 1)) ^ nn) * 16)))
    const int kbase = 32 * wave + 4 * kg;
#define S5_SHADDR(cb, rb) (HIN + ((cb) * 16 + nn) * 512 + ((((kbase + 16 * (rb)) >> 3) ^ nn) * 16) + ((kbase + 16 * (rb)) & 7) * 2)
    {
        const bf16_t* E = p.Etab + (size_t)(l * 16 + g) * E_SZ;
        bf16x8 af[2][8];
#pragma unroll
        for (int rb = 0; rb < 2; ++rb)
#pragma unroll
            for (int kb = 0; kb < 8; ++kb) af[rb][kb] = *(const bf16x8*)(E + (size_t)(wave * 32 + rb * 16 + nn) * 256 + kb * 32 + kg * 8);
        u32x4 r1, r2;
        { const u32x4 r0 = S5_ULOAD(0); r1 = S5_ULOAD(1); S5_UWRITE(0, r0); } __syncthreads();
#pragma unroll 1
        for (int cb = 0; cb < 17; ++cb) {
            if (cb + 2 < 17) r2 = S5_ULOAD(cb + 2);
            f32x4 a0 = {0.f, 0.f, 0.f, 0.f}, a1 = {0.f, 0.f, 0.f, 0.f};
#pragma unroll
            for (int kb = 0; kb < 8; ++kb) { const bf16x8 bfr = S5_UFRAG(cb, kb); a0 = S5_MFMA(af[0][kb], bfr, a0); a1 = S5_MFMA(af[1][kb], bfr, a1); }
            { u32x2 w; w.x = pk2(a0[0], a0[1]); w.y = pk2(a0[2], a0[3]); *(LAS u32x2*)S5_SHADDR(cb, 0) = w; w.x = pk2(a1[0], a1[1]); w.y = pk2(a1[2], a1[3]); *(LAS u32x2*)S5_SHADDR(cb, 1) = w; }
            if (cb + 1 < 17) S5_UWRITE(cb + 1, r1);
            __syncthreads();
            r1 = r2;
        }
    }
    {
        const int dir = wave >> 2;
        float ap[2][2][2], apos[2][2][2];
#pragma unroll
        for (int rb = 0; rb < 2; ++rb)
#pragma unroll
            for (int j = 0; j < 2; ++j) {
                const int st = 16 * (wave & 3) + 8 * rb + 2 * kg + j; const float* t = p.apow + ((size_t)((l * 2 + dir) * 16 + g) * 64 + st) * 32;
                ap[rb][j][0] = t[0]; ap[rb][j][1] = t[1];
                const int e = dir == 0 ? nn : 15 - nn; apos[rb][j][0] = t[2 * e]; apos[rb][j][1] = t[2 * e + 1];
            }
        f32x4 C0 = {0.f, 0.f, 0.f, 0.f}, C1 = {0.f, 0.f, 0.f, 0.f};
#pragma unroll 1
        for (int i = 0; i < 17; ++i) {
            const int cb = i == 0 ? 16 : (dir == 0 ? i - 1 : 16 - i);
            LAS u32x2* q0 = (LAS u32x2*)S5_SHADDR(cb, 0); LAS u32x2* q1 = (LAS u32x2*)S5_SHADDR(cb, 1);
            const u32x2 s0 = *q0, s1 = *q1;
            f32x4 x0 = {__uint_as_float(s0.x << 16), __uint_as_float(s0.x & 0xffff0000u), __uint_as_float(s0.y << 16), __uint_as_float(s0.y & 0xffff0000u)};
            f32x4 x1 = {__uint_as_float(s1.x << 16), __uint_as_float(s1.x & 0xffff0000u), __uint_as_float(s1.y << 16), __uint_as_float(s1.y & 0xffff0000u)};
            if (dir == 0) { scan_tile<0>(x0, C0, ap[0], apos[0], lane, nn); scan_tile<0>(x1, C1, ap[1], apos[1], lane, nn); }
            else { scan_tile<1>(x0, C0, ap[0], apos[0], lane, nn); scan_tile<1>(x1, C1, ap[1], apos[1], lane, nn); }
            u32x2 w; w.x = pk2(x0[0], x0[1]); w.y = pk2(x0[2], x0[3]); *q0 = w; w.x = pk2(x1[0], x1[1]); w.y = pk2(x1[2], x1[3]); *q1 = w;
        }
    }
    __syncthreads();
    {
        const bf16_t* Tt = p.Ttab + (size_t)(l * 16 + g) * TT_SZ; const bf16_t* F = p.Ftab + (size_t)(l * 16 + g) * F_SZ;
        bf16x8 at[2][8], afq[2][8];
#pragma unroll
        for (int rb = 0; rb < 2; ++rb) {
            const int t = wave * 2 + rb;
#pragma unroll
            for (int kb = 0; kb < 8; ++kb) {
                const int s = 2 * kb + (kg >> 1), half = kg & 1, ti = t - s + 15;
                at[rb][kb] = *(const bf16x8*)(Tt + (size_t)(ti * 16 + nn) * 16 + half * 8);
                afq[rb][kb] = *(const bf16x8*)(F + (size_t)((kb >> 2) * 256 + t * 16 + nn) * 128 + (kb & 3) * 32 + kg * 8);
            }
        }
        const float* dsk = p.s5_d + l * 256 + g * 16 + kg * 4;
        const float d0 = dsk[0], d1 = dsk[1], d2 = dsk[2], d3 = dsk[3];
        u32x4 r0 = S5_ULOAD(0), r1 = S5_ULOAD(1), r2 = S5_ULOAD(2);
        S5_UWRITE(0, r0); __syncthreads();
#pragma unroll
        for (int cb = 0; cb < 17; ++cb) {
            if (cb + 3 < 17) r0 = S5_ULOAD(cb + 3);
            const int n = cb * 16 + nn;
            f32x4 a0 = {0.f, 0.f, 0.f, 0.f}, a1 = {0.f, 0.f, 0.f, 0.f};
#pragma unroll
            for (int kb = 0; kb < 8; ++kb) { const bf16x8 bfr = S5_UFRAG(cb, kb); a0 = S5_MFMA(at[0][kb], bfr, a0); a1 = S5_MFMA(at[1][kb], bfr, a1); }
#pragma unroll
            for (int kb = 0; kb < 8; ++kb) { const bf16x8 hf = *(const LAS bf16x8*)(HIN + n * 512 + (((kb * 4 + kg) ^ nn) * 16)); a0 = S5_MFMA(afq[0][kb], hf, a0); a1 = S5_MFMA(afq[1][kb], hf, a1); }
#pragma unroll
            for (int rb = 0; rb < 2; ++rb) {
                const int t = wave * 2 + rb; const f32x4 a = rb == 0 ? a0 : a1;
                const u32x2 uu = *(const LAS u32x2*)(UT + (cb & 1) * 8192 + nn * 512 + (((t * 2 + (kg >> 1)) ^ nn) * 16) + (kg & 1) * 8);
                const float u0 = __uint_as_float(uu.x << 16), u1 = __uint_as_float(uu.x & 0xffff0000u), u2 = __uint_as_float(uu.y << 16), u3 = __uint_as_float(uu.y & 0xffff0000u);
                u32x2 w; w.x = pk2(gelu_tanh(a[0] + d0 * u0), gelu_tanh(a[1] + d1 * u1)); w.y = pk2(gelu_tanh(a[2] + d2 * u2), gelu_tanh(a[3] + d3 * u3));
                *(u32x2*)(p.ys5 + (rowb + n * 16 + t) * 256 + g * 16 + kg * 4) = w;
            }
            if (cb + 1 < 17) S5_UWRITE(cb + 1, r1);
            __syncthreads();
            r1 = r2; r2 = r0;
        }
    }
#undef S5_ULOAD
#undef S5_UWRITE
#undef S5_UFRAG
#undef S5_SHADDR
}
}
#define XB_TMO      128
#define XB_XCNT(j)  (256  + 64 * (j))
#define XB_XSUB(j)  (1280 + 64 * (j))
#define XB_XGEN(j)  (2304 + 64 * (j))
#define XB_TOP      3328
#define XB_TOPGEN   3392
#define XCD_BAR_WORDS 3456
#define XB_SPIN_CAP (1u << 18)
constexpr int CW_BAR = 4096;
constexpr int CTL_ZERO_BYTES = 65536;
__device__ __forceinline__ unsigned xb_ld(unsigned* p)              { return __hip_atomic_load(p, __ATOMIC_RELAXED, __HIP_MEMORY_SCOPE_AGENT); }
__device__ __forceinline__ unsigned xb_add(unsigned* p, unsigned v) { return __hip_atomic_fetch_add(p, v, __ATOMIC_RELAXED, __HIP_MEMORY_SCOPE_AGENT); }
__device__ __forceinline__ unsigned xb_xcc_id() { return (unsigned)__builtin_amdgcn_s_getreg((3 << 11) | 20) & 0xFu; }
#define XB_SPIN(cond, bar) do { unsigned _sp = 0; while (cond) { __builtin_amdgcn_s_sleep(1); \
    if ((++_sp & 255u) == 0u) { if (xb_ld(&(bar)[XB_TMO])) break; if (_sp > XB_SPIN_CAP) { atomicAdd(&(bar)[XB_TMO], 1u); break; } } } } while (0)
__device__ __forceinline__ void xcd_barrier_post(unsigned* bar, bool leader) { if (leader) (void)xb_add(&bar[XB_XCNT(xb_xcc_id())], 1u); }
__device__ __forceinline__ void xcd_barrier_complete(unsigned* bar, unsigned x, unsigned& nloc, unsigned& nx) {
    const unsigned G = gridDim.x * gridDim.y * gridDim.z;
    unsigned sum, cnt, mine, sp = 0u;
    for (;;) {
        sum = 0u; cnt = 0u; mine = 0u;
#pragma unroll
        for (unsigned j = 0; j < 16; ++j) { const unsigned c = xb_ld(&bar[XB_XCNT(j)]); sum += c; cnt += (c > 0u) ? 1u : 0u; mine = (j == x) ? c : mine; }
        if (sum == G) break;
        __builtin_amdgcn_s_sleep(1);
        if ((++sp & 255u) == 0u) { if (xb_ld(&bar[XB_TMO])) break; if (sp > XB_SPIN_CAP) { atomicAdd(&bar[XB_TMO], 1u); break; } }
    }
    nloc = mine > 0u ? mine : 1u; nx = cnt > 0u ? cnt : 1u;
}
__device__ __forceinline__ void xcd_barrier(unsigned* bar, volatile LAS unsigned* st, bool leader) {
    asm volatile("s_waitcnt vmcnt(0)" ::: "memory");
    __syncthreads();
    if (leader) {
        const unsigned x = xb_xcc_id();
        __builtin_amdgcn_s_waitcnt(0);
        unsigned nloc = st[0], nx = st[1];
        if (nloc == 0u) { xcd_barrier_complete(bar, x, nloc, nx); st[0] = nloc; st[1] = nx; }
        const unsigned old = xb_add(&bar[XB_XSUB(x)], 1u);
        const unsigned gen = old / nloc;
        if (old + 1u == (gen + 1u) * nloc) {
            __builtin_amdgcn_fence(__ATOMIC_RELEASE, "agent");
            asm volatile("s_waitcnt vmcnt(0)" ::: "memory");
            const unsigned og = xb_add(&bar[XB_TOP], 1u);
            const unsigned tg = og / nx;
            if (og + 1u == (tg + 1u) * nx) xb_add(&bar[XB_TOPGEN], 1u);
            else XB_SPIN(xb_ld(&bar[XB_TOPGEN]) == tg, bar);
            __builtin_amdgcn_fence(__ATOMIC_ACQUIRE, "agent");
            xb_add(&bar[XB_XGEN(x)], 1u);
            asm volatile("s_waitcnt vmcnt(0)" ::: "memory");
        } else {
            XB_SPIN(xb_ld(&bar[XB_XGEN(x)]) == gen, bar);
            __builtin_amdgcn_fence(__ATOMIC_ACQUIRE, "agent");
            asm volatile("s_waitcnt vmcnt(0)" ::: "memory");
        }
    }
    __syncthreads();
}
constexpr int LDS_MISC = 155648;
constexpr int LDS_BYTES = 155648 + 256;
__device__ __forceinline__ void ph_inproj(const Params& p, int l, LAS unsigned char* lds, int G, int bx, int tid) {
    pg8::Gemm g{p.A, p.Win_t + (size_t)l * NP * D, MT, NP, D}; pg8::StaticOrder So; So.init(MT, NP, G, bx);
    pg8::EpiInProj E{p.P, p.tabA, p.tabB, p.qn_g + l * 64, p.kn_g + l * 64};
    pg8::gemm_phase<pg8::EpiInProj, pg8::StaticOrder, true, true>(lds, g, So, E, tid);
}
__device__ __forceinline__ void ph_outproj(const Params& p, int l, LAS unsigned char* lds, int G, int bx, int tid) {
    const int M = l == NL - 1 ? MT : MT;
    pg8::Gemm g{p.A, p.Wout_t + (size_t)l * D * D, M, D, D}; pg8::StaticOrder So; So.init(M, D, G, bx);
    pg8::EpiOutProj E{p.xl, p.xc, p.mod + (size_t)l * 5 * 3 * D};
    pg8::gemm_phase<pg8::EpiOutProj, pg8::StaticOrder, true, true>(lds, g, So, E, tid);
}
__device__ __forceinline__ void ph_glu(const Params& p, int l, LAS unsigned char* lds, int G, int bx, int tid) {
    pg8::Gemm g{p.ys5, p.Wglu_t + (size_t)l * 512 * 256, MT, 512, 256}; pg8::StaticOrder So; So.init(MT, 512, G, bx);
    pg8::EpiGlu E{p.A, p.P};
    pg8::gemm_phase<pg8::EpiGlu, pg8::StaticOrder, true, true>(lds, g, So, E, tid);
}
struct Ctx { int tid, lane, wave, G, bx, gw, ngw, v; };
__device__ __forceinline__ Ctx make_ctx(int wave0) {
    Ctx c; c.wave = opaque_s(wave0); c.lane = (int)__builtin_amdgcn_mbcnt_hi(~0u, __builtin_amdgcn_mbcnt_lo(~0u, (unsigned)opaque_v(0))); c.tid = c.wave * 64 + c.lane;
    c.G = opaque_s((int)gridDim.x); c.bx = opaque_s((int)blockIdx.x); c.gw = c.bx * NWAVES + c.wave; c.ngw = c.G * NWAVES;
    c.v = (c.G % 8 == 0) ? (c.bx % 8) * (c.G / 8) + (c.bx / 8) : c.bx;
    return c;
}
#define GRID_SYNC() do { const Ctx cb_ = make_ctx(wave0); xcd_barrier((unsigned*)(opaque_p(ka.ws) + O_CTL) + CW_BAR, (volatile LAS unsigned*)(lds + LDS_MISC), cb_.tid == 0); } while (0)
__global__ void __launch_bounds__(NTHR, 2) mega(KArgs ka) {
    extern __shared__ __attribute__((aligned(16))) unsigned char lds_raw[];
    LAS unsigned char* lds = (LAS unsigned char*)lds_raw;
    const int wave0 = __builtin_amdgcn_readfirstlane((int)threadIdx.x >> 6);
    if (threadIdx.x < 64) ((LAS unsigned*)(lds + LDS_MISC))[threadIdx.x] = 0u;
    __syncthreads();
    xcd_barrier_post((unsigned*)(ka.ws + O_CTL) + CW_BAR, threadIdx.x == 0);
    { const Params pp = make_params(ka, true);
      { const Ctx c = make_ctx(wave0); phase_prologue(pp, ka, lds, c.gw, c.ngw, c.wave, c.lane); s5m::build_a(pp, c.gw, c.ngw, c.lane); }
      cg::this_grid().sync();
      { const Ctx c = make_ctx(wave0); s5m::build_b(pp, c.gw, c.ngw, c.lane); phase_rows(pp, -1, 0, c.gw, c.ngw, c.lane); } }
    GRID_SYNC();
#pragma nounroll
    for (int l = 0; l < NL; ++l) {
        { const Ctx c = make_ctx(wave0); const Params p = make_params(ka, false); ph_inproj(p, l, lds, c.G, c.bx, c.tid); }
        GRID_SYNC();
        { const Ctx c = make_ctx(wave0); const Params p = make_params(ka, false); att::attn_phase(p, l, lds, c.v, c.G, c.tid); }
        { const Ctx c = make_ctx(wave0); const Params p = make_params(ka, false); for (int u = c.v; u < NB * 16; u += c.G) s5m::unit(p, l, u >> 4, u & 15, lds, c.tid); }
        GRID_SYNC();
        { const Ctx c = make_ctx(wave0); const Params p = make_params(ka, false); ph_glu(p, l, lds, c.G, c.bx, c.tid); }
        GRID_SYNC();
        { const Ctx c = make_ctx(wave0); const Params p = make_params(ka, false); ph_outproj(p, l, lds, c.G, c.bx, c.tid); }
        GRID_SYNC();
        { const Ctx c = make_ctx(wave0); const Params p = make_params(ka, false); phase_rows(p, l, l + 1, c.gw, c.ngw, c.lane); }
        if (l + 1 < NL) GRID_SYNC();
    }
}

extern "C" void kernel_launch(void* const* d_in, const int* in_sizes, int n_in, void* d_out, int out_size, void* d_ws, size_t ws_size, hipStream_t stream) {
    static int grid = 0;
    if (grid == 0) {
        int dev = 0, cus = 0, per_cu = 0;
        (void)hipGetDevice(&dev); (void)hipDeviceGetAttribute(&cus, hipDeviceAttributeMultiprocessorCount, dev);
        (void)hipFuncSetAttribute((const void*)mega, hipFuncAttributeMaxDynamicSharedMemorySize, LDS_BYTES);
        if (hipOccupancyMaxActiveBlocksPerMultiprocessor(&per_cu, (const void*)mega, NTHR, LDS_BYTES) != hipSuccess || per_cu < 1) { per_cu = 1; (void)hipGetLastError(); }
        if (per_cu > 1) per_cu = 1;
        grid = (cus > 0 ? cus : 256) * per_cu;
    }
    KArgs ka{};
    for (int i = 0; i < 27; ++i) ka.in[i] = (const float*)d_in[i];
    ka.out = (float*)d_out; ka.ws = (unsigned char*)d_ws;
    if (O_END > ws_size) { fprintf(stderr, "kernel_launch: workspace too small: need %zu have %zu\n", (size_t)O_END, ws_size); return; }
    (void)hipMemsetAsync((unsigned char*)d_ws + O_CTL, 0, CTL_ZERO_BYTES, stream);
    void* args[] = {&ka};
    hipError_t e = hipLaunchCooperativeKernel((const void*)mega, dim3(grid), dim3(NTHR), args, LDS_BYTES, stream);
    if (e != hipSuccess) fprintf(stderr, "cooperative launch failed: %s (grid %d)\n", hipGetErrorString(e), grid);
}
```

```cpp
#include <hip/hip_runtime.h>
#include <hip/hip_cooperative_groups.h>
#include <cstdint>
#include <cstdio>
#include <math.h>
namespace cg = cooperative_groups;

constexpr int D = 1024, NB = 4, S = 4096, NL = 4, GW = 64, CT = 256;
constexpr int T = S + CT;
constexpr int MT = NB * T;
constexpr int NP = 3328;
constexpr int AQ = 0, AK = 256, AV = 384, AG = 512, BQ = 768, BK = 1024, BV = 1280, BG = 1536, CQ = 1792, CK = 2048, CV = 2304, CG = 2560, DU = 2816, DG = 3072;
constexpr float RMS_EPS = 1e-6f, LN_EPS = 1e-5f;
constexpr float ALPHA = 1.681792830507429f;
constexpr float LOG2E = 1.4426950408889634f;
constexpr float C2A = 0.125f * LOG2E;
constexpr float C2B = 0.17677669529663687f * LOG2E;
constexpr int NCH = T / 64;
constexpr int NWAVES = 8, NTHR = 512;

typedef unsigned short bf16_t;
typedef float f32x4 __attribute__((ext_vector_type(4)));
typedef unsigned u32x4 __attribute__((ext_vector_type(4)));
typedef unsigned u32x2 __attribute__((ext_vector_type(2)));
#define LAS __attribute__((address_space(3)))
__device__ __forceinline__ float bf2f(bf16_t v) { return __uint_as_float(((unsigned)v) << 16); }
__device__ __forceinline__ unsigned f2bf_u(float f) { unsigned u = __float_as_uint(f); return (u + 0x7fffu + ((u >> 16) & 1u)) >> 16; }
__device__ __forceinline__ bf16_t f2bf(float f) { return (bf16_t)f2bf_u(f); }
__device__ __forceinline__ unsigned pk2(float lo, float hi) { return f2bf_u(lo) | (f2bf_u(hi) << 16); }
__device__ __forceinline__ float silu_f(float v) { return v / (1.f + __expf(-v)); }
__device__ __forceinline__ float sigm_f(float v) { return 1.f / (1.f + __expf(-v)); }
__device__ __forceinline__ float gelu_tanh(float v) { return 0.5f * v * (1.f + tanhf(0.7978845608028654f * (v + 0.044715f * v * v * v))); }

__device__ __forceinline__ int opaque_v(int x) { asm volatile("" : "+v"(x)); return x; }
__device__ __forceinline__ int opaque_s(int x) { asm volatile("" : "+s"(x)); return x; }
struct Params {
    const float *x, *c, *ctx, *c_ctx, *w_ada, *b_ada, *w_in, *w_out, *ln_g, *ln_b, *qn_g, *kn_g, *lq1, *lk1, *lq2, *lk2, *subln_g, *rpb;
    const float *a_re, *a_im, *log_dt, *b_re, *b_im, *c_re, *c_im, *s5_d, *w_glu;
    float* xl;
    float* xc;
    float* mod;
    float* tabA;
    float* tabB;
    bf16_t* Win_t;
    bf16_t* Wout_t;
    bf16_t* Wglu_t;
    bf16_t* A;
    bf16_t* P;
    bf16_t* ys5;
    float* Sbuf;
    bf16_t* Hinb;
    bf16_t* Ttab; bf16_t* Etab; bf16_t* Ftab; float* apow; float* lampow;
    unsigned* ctl;
    float* disc;
    float* lamv;
};
struct KArgs { const float* in[27]; float* out; unsigned char* ws; };
constexpr size_t al256(size_t x) { return (x + 255) & ~(size_t)255; }
constexpr size_t O_CTL = 0, O_XC = O_CTL + (1 << 20), O_MOD = O_XC + al256((size_t)NB * CT * D * 4), O_TABA = O_MOD + al256((size_t)NL * 5 * 3 * D * 4), O_TABB = O_TABA + 8192,
    O_WIN = O_TABB + 4096, O_WOUT = O_WIN + al256((size_t)NL * NP * D * 2), O_WGLU = O_WOUT + al256((size_t)NL * D * D * 2), O_A = O_WGLU + al256((size_t)NL * 512 * 256 * 2),
    O_P = O_A + al256((size_t)MT * D * 2), O_YS5 = O_P + al256((size_t)MT * NP * 2), O_SBUF = O_YS5 + al256((size_t)MT * 256 * 2), O_HINB = O_SBUF + al256((size_t)NB * 16 * 272 * 256 * 4), O_TTAB = O_HINB + al256((size_t)NB * 16 * 272 * 256 * 2),
    O_ETAB = O_TTAB + al256((size_t)NL * 16 * 31 * 256 * 2), O_FTAB = O_ETAB + al256((size_t)NL * 16 * 2 * 128 * 256 * 2), O_LAM16 = O_FTAB + al256((size_t)NL * 16 * 2 * 256 * 128 * 2),
    O_LAMPOW = O_LAM16 + al256((size_t)NL * 2 * 16 * 64 * 32 * 4), O_SMALL = O_LAMPOW + al256((size_t)NL * 2 * 16 * 64 * 34 * 4);
constexpr int SM_N[18] = {NL * D, NL * D, NL * 64, NL * 64, NL * 32, NL * 32, NL * 32, NL * 32, NL * 64, NL * 4 * 15 * 31, NL * 2 * 16 * 64, NL * 2 * 16 * 64, NL * 2 * 16, NL * 2 * 16 * 64 * 16, NL * 2 * 16 * 64 * 16, NL * 2 * 16 * 16 * 64, NL * 2 * 16 * 16 * 64, NL * 256};
constexpr int sm_off(int i) { int o = 0; for (int k = 0; k < i; ++k) o += (SM_N[k] + 63) & ~63; return o; }
constexpr size_t O_DISC = O_SMALL + al256((size_t)sm_off(18) * 4);
constexpr size_t O_LAMV = O_DISC + al256((size_t)NL * 2 * 16 * 64 * 34 * 4);
constexpr size_t O_END = O_LAMV + 256;
template <class Tp> __device__ __forceinline__ Tp* opaque_p(Tp* x) { asm volatile("" : "+s"(x)); return x; }
__device__ __forceinline__ Params make_params(const KArgs& ka, bool prologue) {
    Params p;
    const float** f = (const float**)&p;
    if (prologue) { for (int i = 0; i < 27; ++i) f[i] = ka.in[i]; }
    else {
        for (int i = 0; i < 27; ++i) f[i] = nullptr;
        const float* sm = (const float*)(opaque_p(ka.ws) + O_SMALL);
        p.ln_g = sm + sm_off(0); p.ln_b = sm + sm_off(1); p.qn_g = sm + sm_off(2); p.kn_g = sm + sm_off(3); p.lq1 = sm + sm_off(4); p.lk1 = sm + sm_off(5); p.lq2 = sm + sm_off(6); p.lk2 = sm + sm_off(7);
        p.subln_g = sm + sm_off(8); p.rpb = sm + sm_off(9); p.a_re = sm + sm_off(10); p.a_im = sm + sm_off(11); p.log_dt = sm + sm_off(12); p.b_re = sm + sm_off(13); p.b_im = sm + sm_off(14);
        p.c_re = sm + sm_off(15); p.c_im = sm + sm_off(16); p.s5_d = sm + sm_off(17);
    }
    unsigned char* ws = opaque_p(ka.ws);
    p.xl = opaque_p(ka.out); p.xc = (float*)(ws + O_XC); p.mod = (float*)(ws + O_MOD); p.tabA = (float*)(ws + O_TABA); p.tabB = (float*)(ws + O_TABB);
    p.Win_t = (bf16_t*)(ws + O_WIN); p.Wout_t = (bf16_t*)(ws + O_WOUT); p.Wglu_t = (bf16_t*)(ws + O_WGLU); p.A = (bf16_t*)(ws + O_A); p.P = (bf16_t*)(ws + O_P);
    p.ys5 = (bf16_t*)(ws + O_YS5); p.Sbuf = (float*)(ws + O_SBUF); p.Hinb = (bf16_t*)(ws + O_HINB); p.Ttab = (bf16_t*)(ws + O_TTAB); p.Etab = (bf16_t*)(ws + O_ETAB); p.Ftab = (bf16_t*)(ws + O_FTAB); p.apow = (float*)(ws + O_LAM16); p.lampow = (float*)(ws + O_LAMPOW); p.ctl = (unsigned*)(ws + O_CTL); p.disc = (float*)(ws + O_DISC); p.lamv = (float*)(ws + O_LAMV);
    return p;
}
__device__ __forceinline__ float* xrow(const Params& p, int m) { const int b = m / T, t = m - b * T; return t < S ? p.xl + ((size_t)b * S + t) * D : p.xc + ((size_t)b * CT + (t - S)) * D; }
__device__ __forceinline__ int modrow(int m) { const int b = m / T, t = m - b * T; return t < S ? b : 4; }
namespace pg8 {
#define PG8_LAS __attribute__((address_space(3)))
typedef unsigned short bf16_t;
typedef short bf16x8 __attribute__((ext_vector_type(8)));
typedef float f32x4 __attribute__((ext_vector_type(4)));
typedef unsigned u32x4 __attribute__((ext_vector_type(4)));
constexpr int BM = 256, BK = 64, HALF = 128, HTB = HALF * BK * 2  , STAGE_BYTES = 8 * HTB, NXCD = 8, WGM = 8;

__host__ __device__ __forceinline__ int lds_byte(int r, int c) { const int st = (r >> 4) * 2 + (c >> 5), rr = r & 15, cc = c & 31, ob = rr * 64 + cc * 2; return st * 1024 + (ob ^ (((ob >> 9) & 1) << 5)); }
__host__ __device__ __forceinline__ void stage_rc(int b, int& R, int& C) { const int st = b / 1024, sb = b % 1024, swz = sb ^ (((sb >> 9) & 1) << 5); R = (st >> 1) * 16 + swz / 64; C = (st & 1) * 32 + (swz % 64) / 2; }
__host__ __device__ __forceinline__ int perm32(int rho) { const int n = rho >> 4, i = rho & 15; return 8 * (i >> 2) + 4 * n + (i & 3); }

struct Unit { int pm, pn; };
struct Gemm { const bf16_t* A; const bf16_t* Bt; int M, N, K; };

struct StaticOrder {
    int nM, nN, nwg, G, c;
    __host__ __device__ void init(int M, int N, int G_, int c_) { nM = M / BM; nN = N / BM; nwg = nM * nN; G = G_; c = c_; }
    __host__ __device__ bool next(int i, Unit& u) const {
        const long L = (long)i * G + c; if (L >= nwg) return false;
        int wgid = (int)L; { const int q = nwg / NXCD, r = nwg % NXCD, xcd = wgid % NXCD, off = wgid / NXCD; wgid = (xcd < r ? xcd * (q + 1) : r * (q + 1) + (xcd - r) * q) + off; }
        const int nig = WGM * nN, gid = wgid / nig, fm = gid * WGM, gsz = (nM - fm) < WGM ? (nM - fm) : WGM;
        u.pm = fm + ((wgid % nig) % gsz); u.pn = (wgid % nig) / gsz; return true;
    }
    __device__ __forceinline__ void a_ready(const Unit&) const {}
    __device__ __forceinline__ void done(const Unit&) const {}
};

__device__ __forceinline__ unsigned cvt_pk_bf16(float lo, float hi) { unsigned r; asm volatile("v_cvt_pk_bf16_f32 %0, %1, %2" : "=v"(r) : "v"(lo), "v"(hi)); return r; }
typedef float f32x2 __attribute__((ext_vector_type(2)));
template <class Epi, class Sched, bool ALIGN_EPI = false, bool SP2 = false>
__device__ __forceinline__ void gemm_phase(PG8_LAS unsigned char* lds, const Gemm g, const Sched& S, const Epi& E, int tid_in) {
    const int tid = tid_in, wid = __builtin_amdgcn_readfirstlane(tid >> 6), lane = tid & 63, wr = wid >> 2, wc = wid & 3, fr = lane & 15, fq = lane >> 4;
    const int K = g.K, nt = K / BK;
    unsigned voffA[2], voffB[2];
#pragma unroll
    for (int i = 0; i < 2; ++i) { int R, C; stage_rc(tid * 16 + i * 8192, R, C); const int Rb = Epi::PERM ? ((R & ~31) + perm32(R & 31)) : R;
        voffA[i] = (unsigned)(R * K + C) * 2u; voffB[i] = (unsigned)(Rb * K + C) * 2u; }
    const size_t kstep = (size_t)(BK * 2);
    const size_t hstep = (size_t)HALF * K * 2;
    const size_t tstep = 2 * hstep;
    const unsigned ldsw = (unsigned)wid * 1024u;
    const int aoff = lds_byte(wr * 64 + fr, fq * 8), boff = lds_byte(wc * 32 + fr, fq * 8);
#define PG8_SA(b, h) (((b) * 2 + (h)) * HTB)
#define PG8_SB(b, h) ((4 + (b) * 2 + (h)) * HTB)
#define PG8_STAGE(bufoff, gbase, voff) do { _Pragma("unroll") for (int _i = 0; _i < 2; ++_i) \
        __builtin_amdgcn_global_load_lds((const unsigned*)((const char*)(gbase) + (voff)[_i]), (PG8_LAS unsigned*)(lds + (bufoff) + ldsw + _i * 8192), 16, 0, 0); } while (0)
#define PG8_LDA(dst, b, h) do { _Pragma("unroll") for (int m = 0; m < 4; ++m) _Pragma("unroll") for (int k = 0; k < 2; ++k) dst[m][k] = *(const PG8_LAS bf16x8*)(lds + PG8_SA(b, h) + aoff + m * 2048 + k * 1024); } while (0)
#define PG8_LDB(dst, b, h) do { _Pragma("unroll") for (int n = 0; n < 2; ++n) _Pragma("unroll") for (int k = 0; k < 2; ++k) dst[n][k] = *(const PG8_LAS bf16x8*)(lds + PG8_SB(b, h) + boff + n * 2048 + k * 1024); } while (0)
#define PG8_MMA(ai, bj, At, Bt) do { __builtin_amdgcn_s_setprio(1); _Pragma("unroll") for (int m = 0; m < 4; ++m) _Pragma("unroll") for (int n = 0; n < 2; ++n) _Pragma("unroll") for (int k = 0; k < 2; ++k) \
        acc[ai][bj][m][n] = __builtin_amdgcn_mfma_f32_16x16x32_bf16(Bt[n][k], At[m][k], acc[ai][bj][m][n], 0, 0, 0); __builtin_amdgcn_s_setprio(0); } while (0)
#define PG8_WAIT_V(n) asm volatile("s_waitcnt vmcnt(" #n ")" ::: "memory")
#define PG8_WAIT_L(n) asm volatile("s_waitcnt lgkmcnt(" #n ")" ::: "memory")
#define PG8_BAR __builtin_amdgcn_s_barrier()
#define PG8_SCHED __builtin_amdgcn_sched_barrier(0)
    Unit cur, nxt; int ui = 0;
    if (!S.next(0, cur)) return;
    f32x4 acc[2][2][4][2];
#pragma unroll
    for (int a = 0; a < 2; ++a)
#pragma unroll
        for (int b = 0; b < 2; ++b)
#pragma unroll
            for (int m = 0; m < 4; ++m)
#pragma unroll
                for (int n = 0; n < 2; ++n) acc[a][b][m][n] = (f32x4){0.f, 0.f, 0.f, 0.f};
    bf16x8 At[4][2], B0[2][2], B1[2][2];
    const char* cA = (const char*)g.A + (size_t)cur.pm * tstep; const char* cB = (const char*)g.Bt + (size_t)cur.pn * tstep;
    S.a_ready(cur);
    if constexpr (SP2) {
        PG8_STAGE(PG8_SB(0, 0), cB, voffB); PG8_STAGE(PG8_SB(0, 1), cB + hstep, voffB); PG8_STAGE(PG8_SA(0, 0), cA, voffA); PG8_STAGE(PG8_SA(0, 1), cA + hstep, voffA);
        if (wr == 1) PG8_BAR;
        PG8_WAIT_V(2); PG8_BAR;
        PG8_STAGE(PG8_SB(1, 0), cB + kstep, voffB); PG8_STAGE(PG8_SA(1, 0), cA + kstep, voffA); PG8_STAGE(PG8_SB(1, 1), cB + hstep + kstep, voffB);
        PG8_WAIT_V(6); PG8_BAR;
    } else {
        PG8_STAGE(PG8_SB(0, 0), cB, voffB); PG8_STAGE(PG8_SA(0, 0), cA, voffA); PG8_STAGE(PG8_SB(0, 1), cB + hstep, voffB); PG8_STAGE(PG8_SA(0, 1), cA + hstep, voffA);
        if (wr == 1) PG8_BAR;
        PG8_WAIT_V(4); PG8_BAR;
        PG8_STAGE(PG8_SB(1, 0), cB + kstep, voffB); PG8_STAGE(PG8_SA(1, 0), cA + kstep, voffA); PG8_STAGE(PG8_SB(1, 1), cB + hstep + kstep, voffB);
        PG8_WAIT_V(6); PG8_BAR;
    }
    for (;;) {
        const bool has_next = S.next(ui + 1, nxt);
        const char* nA = has_next ? (const char*)g.A + (size_t)nxt.pm * tstep : cA; const char* nB = has_next ? (const char*)g.Bt + (size_t)nxt.pn * tstep : cB;
        for (int t = 0; t < nt; t += 2) {
            const bool last = (t == nt - 2);
            const char* a1 = cA + (size_t)(t + 1) * kstep;
            const char* a2 = last ? nA : cA + (size_t)(t + 2) * kstep; const char* b2 = last ? nB : cB + (size_t)(t + 2) * kstep;
            const char* a3 = a2 + kstep; const char* b3 = b2 + kstep;
            if (last && has_next) S.a_ready(nxt);
            if constexpr (SP2) {
            PG8_LDB(B0, 0, 0); PG8_LDB(B1, 0, 1); PG8_SCHED; PG8_LDA(At, 0, 0); PG8_STAGE(PG8_SA(1, 1), a1 + hstep, voffA);
            PG8_WAIT_V(8); PG8_WAIT_L(0); PG8_BAR; PG8_MMA(0, 0, At, B0); PG8_MMA(0, 1, At, B1); PG8_BAR; PG8_SCHED;
            PG8_LDA(At, 0, 1); PG8_STAGE(PG8_SB(0, 0), b2, voffB); PG8_STAGE(PG8_SB(0, 1), b2 + hstep, voffB); PG8_STAGE(PG8_SA(0, 0), a2, voffA);
            PG8_WAIT_V(8); PG8_WAIT_L(0); PG8_BAR; PG8_MMA(1, 0, At, B0); PG8_MMA(1, 1, At, B1); PG8_BAR; PG8_SCHED;
            PG8_LDB(B0, 1, 0); PG8_LDB(B1, 1, 1); PG8_SCHED; PG8_LDA(At, 1, 0); PG8_STAGE(PG8_SA(0, 1), a2 + hstep, voffA);
            PG8_WAIT_V(8); PG8_WAIT_L(0); PG8_BAR; PG8_MMA(0, 0, At, B0); PG8_MMA(0, 1, At, B1); PG8_BAR; PG8_SCHED;
            PG8_LDA(At, 1, 1); PG8_STAGE(PG8_SB(1, 0), b3, voffB); PG8_STAGE(PG8_SB(1, 1), b3 + hstep, voffB); PG8_STAGE(PG8_SA(1, 0), a3, voffA);
            PG8_WAIT_V(8); PG8_WAIT_L(0); PG8_BAR; PG8_MMA(1, 0, At, B0); PG8_MMA(1, 1, At, B1); PG8_BAR; PG8_SCHED;
            } else {
            PG8_LDB(B0, 0, 0); PG8_SCHED; PG8_LDA(At, 0, 0); PG8_STAGE(PG8_SA(1, 1), a1 + hstep, voffA);
            PG8_WAIT_L(8); PG8_BAR; PG8_WAIT_L(0); PG8_MMA(0, 0, At, B0); PG8_BAR; PG8_SCHED;
            PG8_LDB(B1, 0, 1); PG8_STAGE(PG8_SB(0, 0), b2, voffB);
            PG8_BAR; PG8_WAIT_L(0); PG8_MMA(0, 1, At, B1); PG8_BAR;
            PG8_LDA(At, 0, 1); PG8_STAGE(PG8_SA(0, 0), a2, voffA);
            PG8_BAR; PG8_WAIT_L(0); PG8_MMA(1, 0, At, B0); PG8_BAR; PG8_SCHED;
            PG8_STAGE(PG8_SB(0, 1), b2 + hstep, voffB);
            PG8_WAIT_V(6); PG8_BAR; PG8_MMA(1, 1, At, B1); PG8_BAR;
            PG8_LDB(B0, 1, 0); PG8_SCHED; PG8_LDA(At, 1, 0); PG8_STAGE(PG8_SA(0, 1), a2 + hstep, voffA);
            PG8_WAIT_L(8); PG8_BAR; PG8_WAIT_L(0); PG8_MMA(0, 0, At, B0); PG8_BAR; PG8_SCHED;
            PG8_LDB(B1, 1, 1); PG8_STAGE(PG8_SB(1, 0), b3, voffB);
            PG8_BAR; PG8_WAIT_L(0); PG8_MMA(0, 1, At, B1); PG8_BAR;
            PG8_LDA(At, 1, 1); PG8_STAGE(PG8_SA(1, 0), a3, voffA);
            PG8_BAR; PG8_WAIT_L(0); PG8_MMA(1, 0, At, B0); PG8_BAR; PG8_SCHED;
            PG8_STAGE(PG8_SB(1, 1), b3 + hstep, voffB);
            PG8_WAIT_V(6); PG8_BAR; PG8_MMA(1, 1, At, B1); PG8_BAR;
            }
        }
        if constexpr (ALIGN_EPI) { if (wr == 0) PG8_BAR; }
        if constexpr (!Epi::AFTER_DRAIN) { E(acc, cur, wr, wc, fr, fq); S.done(cur); }
        if (!has_next) break;
#pragma unroll
        for (int a = 0; a < 2; ++a)
#pragma unroll
            for (int b = 0; b < 2; ++b)
#pragma unroll
                for (int m = 0; m < 4; ++m)
#pragma unroll
                    for (int n = 0; n < 2; ++n) acc[a][b][m][n] = (f32x4){0.f, 0.f, 0.f, 0.f};
        cur = nxt; cA = nA; cB = nB; ++ui;
        if constexpr (ALIGN_EPI) { if (wr == 1) PG8_BAR; }
    }
    PG8_WAIT_V(0);
    if constexpr (!ALIGN_EPI) { if (wr == 0) PG8_BAR; }
    PG8_BAR;
    if constexpr (Epi::AFTER_DRAIN) { E.fused(acc, cur, wr, wc, fr, fq, lds, wid, lane); S.done(cur); }
#undef PG8_SA
#undef PG8_SB
#undef PG8_STAGE
#undef PG8_LDA
#undef PG8_LDB
#undef PG8_MMA
#undef PG8_WAIT_V
#undef PG8_WAIT_L
#undef PG8_BAR
#undef PG8_SCHED
}
}
namespace pg8 {
struct EpiInProj {
    static constexpr bool PERM = true, AFTER_DRAIN = false;
    ::bf16_t* P; const float* tabA; const float* tabB; const float* qn_g; const float* kn_g;
    __device__ __forceinline__ void operator()(const f32x4 (&acc)[2][2][4][2], const Unit& u, int wr_, int wc_, int fr_, int fq_) const {
        const int fr = opaque_v(fr_), fq = opaque_v(fq_), wr = opaque_s(wr_), wc = opaque_s(wc_);
        const int pn = u.pn, m0 = u.pm * BM; const int t0 = m0 % T; const bool lat = t0 < S;
        int type = 0; float qs = 1.f; const float* g = nullptr;
        if (pn == 0) { type = 3; qs = C2A; g = qn_g; }
        else if (pn == 1) { if (wc < 2) { type = 3; g = kn_g; } }
        else if (pn == 2 || pn == 6 || pn == 10 || pn == 12) type = 1;
        else if (pn == 3) { type = 4; qs = C2B; }
        else if (pn == 4) type = 4;
        else if (pn == 7) { type = 2; qs = C2A; }
        ::bf16_t* base = P + (size_t)(m0 + wr * 64 + fr) * NP + 256 * pn + 64 * wc + 8 * fq;
        f32x4 gv[2][2];
        if (type == 3) {
#pragma unroll
            for (int bj = 0; bj < 2; ++bj)
#pragma unroll
                for (int n = 0; n < 2; ++n) gv[bj][n] = *(const f32x4*)(g + 32 * bj + 16 * n + 4 * fq);
        }
#pragma unroll
        for (int ai = 0; ai < 2; ++ai) {
            const int prow = (t0 >> 6) + 2 * ai + wr;
#pragma unroll
            for (int m = 0; m < 4; ++m) {
                f32x4 v[2][2];
#pragma unroll
                for (int bj = 0; bj < 2; ++bj)
#pragma unroll
                    for (int n = 0; n < 2; ++n) v[bj][n] = acc[ai][bj][m][n];
                const int pcol = 16 * m + fr;
                if (type == 1) {
#pragma unroll
                    for (int bj = 0; bj < 2; ++bj)
#pragma unroll
                        for (int n = 0; n < 2; ++n)
#pragma unroll
                            for (int e = 0; e < 4; ++e) v[bj][n][e] = silu_f(v[bj][n][e]);
                } else if (type == 2) {
#pragma unroll
                    for (int bj = 0; bj < 2; ++bj)
#pragma unroll
                        for (int n = 0; n < 2; ++n) v[bj][n] = v[bj][n] * qs;
                } else if (type == 3) {
                    float ss = 0.f;
#pragma unroll
                    for (int bj = 0; bj < 2; ++bj)
#pragma unroll
                        for (int n = 0; n < 2; ++n) ss += (v[bj][n][0] * v[bj][n][0] + v[bj][n][1] * v[bj][n][1]) + (v[bj][n][2] * v[bj][n][2] + v[bj][n][3] * v[bj][n][3]);
                    ss += __shfl_xor(ss, 16); ss += __shfl_xor(ss, 32);
                    const float rs = rsqrtf(ss * (1.f / 64.f) + RMS_EPS);
#pragma unroll
                    for (int bj = 0; bj < 2; ++bj)
#pragma unroll
                        for (int n = 0; n < 2; ++n) v[bj][n] = v[bj][n] * rs * gv[bj][n];
                    if (lat) {
#pragma unroll
                        for (int bj = 0; bj < 2; ++bj) {
                            const int pos = bj == 0 ? prow : pcol;
                            const f32x4 t0v = *(const f32x4*)(tabA + (pos * 16 + 4 * fq) * 2), t1v = *(const f32x4*)(tabA + (pos * 16 + 4 * fq) * 2 + 4);
                            const float cs[4] = {t0v[0], t0v[2], t1v[0], t1v[2]}, sn[4] = {t0v[1], t0v[3], t1v[1], t1v[3]};
#pragma unroll
                            for (int e = 0; e < 4; ++e) { const float x1 = v[bj][0][e], x2 = v[bj][1][e]; v[bj][0][e] = x1 * cs[e] - x2 * sn[e]; v[bj][1][e] = x1 * sn[e] + x2 * cs[e]; }
                        }
                    }
                    if (qs != 1.f) {
#pragma unroll
                        for (int bj = 0; bj < 2; ++bj)
#pragma unroll
                            for (int n = 0; n < 2; ++n) v[bj][n] = v[bj][n] * qs;
                    }
                } else if (type == 4) {
                    if (lat) {
                        const int pos = (fq >> 1) == 0 ? prow : pcol;
                        const f32x4 t0v = *(const f32x4*)(tabB + (pos * 8 + 4 * (fq & 1)) * 2), t1v = *(const f32x4*)(tabB + (pos * 8 + 4 * (fq & 1)) * 2 + 4);
                        const float cs[4] = {t0v[0], t0v[2], t1v[0], t1v[2]}, sn[4] = {t0v[1], t0v[3], t1v[1], t1v[3]};
#pragma unroll
                        for (int bj = 0; bj < 2; ++bj)
#pragma unroll
                            for (int e = 0; e < 4; ++e) { const float x1 = v[bj][0][e], x2 = v[bj][1][e]; v[bj][0][e] = x1 * cs[e] - x2 * sn[e]; v[bj][1][e] = x1 * sn[e] + x2 * cs[e]; }
                    }
                    if (qs != 1.f) {
#pragma unroll
                        for (int bj = 0; bj < 2; ++bj)
#pragma unroll
                            for (int n = 0; n < 2; ++n) v[bj][n] = v[bj][n] * qs;
                    }
                }
                ::bf16_t* rowp = base + (size_t)(ai * HALF + m * 16) * NP;
#pragma unroll
                for (int bj = 0; bj < 2; ++bj) {
                    u32x4 w; w.x = cvt_pk_bf16(v[bj][0][0], v[bj][0][1]); w.y = cvt_pk_bf16(v[bj][0][2], v[bj][0][3]); w.z = cvt_pk_bf16(v[bj][1][0], v[bj][1][1]); w.w = cvt_pk_bf16(v[bj][1][2], v[bj][1][3]);
                    *(u32x4*)(rowp + 32 * bj) = w;
                }
            }
        }
    }
};
struct EpiOutProj {
    static constexpr bool PERM = false, AFTER_DRAIN = false;
    float* xl; float* xc; const float* mod_l;
    __device__ __forceinline__ void operator()(const f32x4 (&acc)[2][2][4][2], const Unit& u, int wr_, int wc_, int fr_, int fq_) const {
        const int fr = opaque_v(fr_), fq = opaque_v(fq_), wr = opaque_s(wr_), wc = opaque_s(wc_);
        const int m0 = u.pm * BM; const int b = m0 / T, t0 = m0 - b * T;
        float* xb = t0 < S ? xl + ((size_t)b * S + t0) * D : xc + ((size_t)b * CT + (t0 - S)) * D;
        const float* gate = mod_l + (size_t)(t0 < S ? b : 4) * 3 * D + 2 * D;
        const int col0 = u.pn * BM + wc * 32 + 4 * fq;
        f32x4 gv[2][2];
#pragma unroll
        for (int bj = 0; bj < 2; ++bj)
#pragma unroll
            for (int n = 0; n < 2; ++n) gv[bj][n] = *(const f32x4*)(gate + col0 + bj * HALF + n * 16);
#pragma unroll
        for (int ai = 0; ai < 2; ++ai)
#pragma unroll
            for (int m = 0; m < 4; ++m) {
                float* xr = xb + (size_t)(ai * HALF + wr * 64 + m * 16 + fr) * D + col0;
#pragma unroll
                for (int bj = 0; bj < 2; ++bj)
#pragma unroll
                    for (int n = 0; n < 2; ++n) { const f32x4 xv = *(const f32x4*)(xr + bj * HALF + n * 16); *(f32x4*)(xr + bj * HALF + n * 16) = xv * ALPHA + gv[bj][n] * acc[ai][bj][m][n]; }
            }
    }
};
struct EpiGlu {
    static constexpr bool PERM = true, AFTER_DRAIN = false;
    ::bf16_t* Y; const ::bf16_t* P;
    __device__ __forceinline__ void operator()(const f32x4 (&acc)[2][2][4][2], const Unit& u, int wr_, int wc_, int fr_, int fq_) const {
        const int fr = opaque_v(fr_), fq = opaque_v(fq_), wr = opaque_s(wr_), wc = opaque_s(wc_);
        const int m0 = u.pm * BM, col8 = 128 * u.pn + 32 * wc + 8 * fq;
#pragma unroll
        for (int ai = 0; ai < 2; ++ai)
#pragma unroll
            for (int m = 0; m < 4; ++m) {
                const size_t row = (size_t)(m0 + ai * HALF + wr * 64 + m * 16 + fr);
                const u32x4 gt = *(const u32x4*)(P + row * NP + DG + col8);
                float o[8];
#pragma unroll
                for (int n = 0; n < 2; ++n)
#pragma unroll
                    for (int e = 0; e < 4; ++e) { const float v = acc[ai][0][m][n][e], g = acc[ai][1][m][n][e]; o[4 * n + e] = v * sigm_f(g); }
                u32x4 w;
#pragma unroll
                for (int e = 0; e < 4; ++e) { const float ga = __uint_as_float(gt[e] << 16), gb = __uint_as_float(gt[e] & 0xffff0000u); w[e] = cvt_pk_bf16(o[2 * e] * ga, o[2 * e + 1] * gb); }
                *(u32x4*)(Y + row * D + 768 + col8) = w;
            }
    }
};
}
__device__ __forceinline__ float wave_sum(float v) {
#pragma unroll
    for (int o = 1; o < 64; o <<= 1) v += __shfl_xor(v, o);
    return v;
}
__device__ __forceinline__ void transpose_item(const float* W, int K, int N, bf16_t* WT, int kb, int nphys0, int lbase, int pt, LAS float* scr, int lane) {
    const int k0 = 64 * kb;
#pragma unroll 8
    for (int i = 0; i < 32; ++i) { const int kk = 2 * i + (lane >> 5); scr[kk * 33 + (lane & 31)] = W[(size_t)(k0 + kk) * N + lbase + (lane & 31)]; }
    asm volatile("s_waitcnt lgkmcnt(0)" ::: "memory");
    const int c = lane & 7;
#pragma unroll
    for (int j = 0; j < 4; ++j) {
        const int n = (lane >> 3) + 8 * j; const int fq = n >> 3, nn = (n >> 2) & 1, e = n & 3;
        const int lo = pt == 0 ? n : pt == 1 ? 16 * nn + 4 * fq + e : 16 * (fq >> 1) + 8 * nn + 4 * (fq & 1) + e;
        const LAS float* s = scr + (8 * c) * 33 + lo;
        u32x4 o; o.x = pk2(s[0 * 33], s[1 * 33]); o.y = pk2(s[2 * 33], s[3 * 33]); o.z = pk2(s[4 * 33], s[5 * 33]); o.w = pk2(s[6 * 33], s[7 * 33]);
        *(u32x4*)(WT + (size_t)(nphys0 + n) * K + k0 + 8 * c) = o;
    }
    asm volatile("s_waitcnt lgkmcnt(0)" ::: "memory");
}
__device__ __forceinline__ void phase_prologue(const Params& p, const KArgs& ka, LAS unsigned char* lds, int gw, int ngw, int wave, int lane) {
    {
        float* sm = (float*)(ka.ws + O_SMALL);
#pragma unroll
        for (int i = 0; i < 18; ++i) { const float* src = ka.in[8 + i]; float* dst = sm + sm_off(i); for (int e = gw * 64 + lane; e < SM_N[i]; e += ngw * 64) dst[e] = src[e]; }
    }
    LAS float* sc5 = (LAS float*)lds;
    LAS float* scr = (LAS float*)(lds + 20480 + wave * 9216);
    for (int i = threadIdx.x; i < 5 * D; i += NTHR) { const float v = i < 4 * D ? p.c[i] : p.c_ctx[i - 4 * D]; sc5[i] = v / (1.f + expf(-v)); }
    __syncthreads();
    for (int it = gw; it < NL * 48; it += ngw) {
        const int l = it / 48, j = (it % 48) * 64 + lane;
        const float* w = p.w_ada + (size_t)l * D * 3 * D + j;
        float a0 = 0.f, a1 = 0.f, a2 = 0.f, a3 = 0.f, a4 = 0.f;
#pragma unroll 8
        for (int k = 0; k < D; ++k) { const float wv = w[(size_t)k * 3 * D]; a0 += sc5[k] * wv; a1 += sc5[D + k] * wv; a2 += sc5[2 * D + k] * wv; a3 += sc5[3 * D + k] * wv; a4 += sc5[4 * D + k] * wv; }
        const float bb = p.b_ada[l * 3 * D + j]; float* o = p.mod + (size_t)l * 5 * 3 * D + j;
        o[0] = a0 + bb; o[3 * D] = a1 + bb; o[6 * D] = a2 + bb; o[9 * D] = a3 + bb; o[12 * D] = a4 + bb;
    }
    if (gw == 0 && lane < NL) {
        float d1 = 0.f, d2 = 0.f;
        for (int i = 0; i < 32; ++i) { d1 += p.lq1[lane * 32 + i] * p.lk1[lane * 32 + i]; d2 += p.lq2[lane * 32 + i] * p.lk2[lane * 32 + i]; }
        p.lamv[lane] = expf(d1) - expf(d2) + (0.8f - 0.6f * expf(-0.3f * (float)lane));
    }
    for (int i = gw * 64 + lane; i < 64 * 16 + 64 * 8; i += ngw * 64) {
        if (i < 1024) { const int pos = i >> 4, k = i & 15; const float an = (float)pos * powf(10000.f, -(float)k / 16.f); p.tabA[2 * i] = cosf(an); p.tabA[2 * i + 1] = sinf(an); }
        else { const int j = i - 1024, pos = j >> 3, k = j & 7; const float an = (float)pos * powf(10000.f, -(float)k / 8.f); p.tabB[2 * j] = cosf(an); p.tabB[2 * j + 1] = sinf(an); }
    }
    constexpr int I_IN = 16 * 104, I_OUT = 16 * 32, I_GLU = 4 * 16, I_L = I_IN + I_OUT + I_GLU;
    for (int it = gw; it < NL * I_L; it += ngw) {
        const int l = it / I_L; int r = it % I_L;
        if (r < I_IN) {
            const int kb = r / 104, nb = r % 104, c = 32 * nb, pn = c >> 8, bj = (c >> 7) & 1, wc = (c >> 5) & 3;
            const int pt = (pn == 0 || (pn == 1 && wc < 2)) ? 1 : (pn == 3 || pn == 4) ? 2 : 0;
            transpose_item(p.w_in + (size_t)l * D * NP, D, NP, p.Win_t + (size_t)l * NP * D, kb, c, 256 * pn + 64 * wc + 32 * bj, pt, scr, lane);
        } else if ((r -= I_IN) < I_OUT) {
            const int kb = r / 32, nb = r % 32;
            transpose_item(p.w_out + (size_t)l * D * D, D, D, p.Wout_t + (size_t)l * D * D, kb, 32 * nb, 32 * nb, 0, scr, lane);
        } else {
            r -= I_OUT; const int kb = r / 16, nb = r % 16, c = 32 * nb, pn = c >> 8, bj = (c >> 7) & 1, wc = (c >> 5) & 3;
            transpose_item(p.w_glu + (size_t)l * 256 * 512, 256, 512, p.Wglu_t + (size_t)l * 512 * 256, kb, c, 256 * bj + 128 * pn + 32 * wc, 0, scr, lane);
        }
    }
}
__device__ __forceinline__ void phase_rows(const Params& p, int l_prev, int l_next, int gw, int ngw, int lane) {
    for (int m = gw; m < MT; m += ngw) {
        const int b = m / T, t = m - b * T; const bool lat = t < S;
        if (l_next == NL && !lat) continue;
        float* xr = lat ? p.xl + ((size_t)b * S + t) * D : p.xc + ((size_t)b * CT + (t - S)) * D;
        f32x4 v[4];
        if (l_prev < 0) {
            const float* src = lat ? p.x + ((size_t)b * S + t) * D : p.ctx + ((size_t)b * CT + (t - S)) * D;
#pragma unroll
            for (int j = 0; j < 4; ++j) { v[j] = *(const f32x4*)(src + 4 * lane + 256 * j); *(f32x4*)(xr + 4 * lane + 256 * j) = v[j]; }
        } else {
            float s = 0.f;
#pragma unroll
            for (int j = 0; j < 4; ++j) { v[j] = *(const f32x4*)(xr + 4 * lane + 256 * j); s += (v[j][0] + v[j][1]) + (v[j][2] + v[j][3]); }
            const float mean = wave_sum(s) * (1.f / D); float q = 0.f;
#pragma unroll
            for (int j = 0; j < 4; ++j) { v[j] = v[j] - mean; q += (v[j][0] * v[j][0] + v[j][1] * v[j][1]) + (v[j][2] * v[j][2] + v[j][3] * v[j][3]); }
            const float rstd = rsqrtf(wave_sum(q) * (1.f / D) + LN_EPS);
#pragma unroll
            for (int j = 0; j < 4; ++j) {
                const f32x4 g = *(const f32x4*)(p.ln_g + l_prev * D + 4 * lane + 256 * j), be = *(const f32x4*)(p.ln_b + l_prev * D + 4 * lane + 256 * j);
                v[j] = v[j] * rstd * g + be; *(f32x4*)(xr + 4 * lane + 256 * j) = v[j];
            }
        }
        if (l_next < NL) {
            const float* md = p.mod + ((size_t)l_next * 5 + (lat ? b : 4)) * 3 * D;
            bf16_t* ar = p.A + (size_t)m * D;
#pragma unroll
            for (int j = 0; j < 4; ++j) {
                const f32x4 sh = *(const f32x4*)(md + 4 * lane + 256 * j), sc = *(const f32x4*)(md + D + 4 * lane + 256 * j);
                const f32x4 h = v[j] * (sc + 1.f) + sh;
                u32x2 w; w.x = pk2(h[0], h[1]); w.y = pk2(h[2], h[3]); *(u32x2*)(ar + 4 * lane + 256 * j) = w;
            }
        }
    }
}
namespace att {
typedef short bf16x8 __attribute__((ext_vector_type(8)));
typedef short s16x4 __attribute__((ext_vector_type(4)));
typedef float f32x16 __attribute__((ext_vector_type(16)));
typedef float f32x2_t __attribute__((ext_vector_type(2)));
typedef __bf16 bf16x2_t __attribute__((ext_vector_type(2)));
constexpr int SLOT = 16384, L_RING = 0, L_OST = 49152, L_WSF = L_OST + 8 * 8192, L_RPB = L_WSF + 8 * 256, L_END = L_RPB + 2048;
constexpr float THR = 6.f;
#define ATT_MFMA(a, b, c) __builtin_amdgcn_mfma_f32_32x32x16_bf16(a, b, c, 0, 0, 0)
#define ATT_WAIT_BAR(N) asm volatile("s_waitcnt vmcnt(" #N ") lgkmcnt(0)\n\ts_barrier" ::: "memory")
__device__ __forceinline__ int crow(int r, int hi) { return (r & 3) + 8 * (r >> 2) + 4 * hi; }
__device__ __forceinline__ unsigned cvtpk(float lo, float hi) { f32x2_t v = {lo, hi}; bf16x2_t b = __builtin_convertvector(v, bf16x2_t); return __builtin_bit_cast(unsigned, b); }
__device__ __forceinline__ void glds16(const void* g, unsigned lds_base) {
    unsigned sv; asm volatile("s_mov_b32 %0, m0\n\ts_mov_b32 m0, %2\n\ts_nop 0\n\tglobal_load_lds_dwordx4 %1, off\n\ts_mov_b32 m0, %0" : "=&s"(sv) : "v"(g), "s"(lds_base) : "memory"); }
#define ATT_MX3(a, b, c) __builtin_fmaxf(__builtin_fmaxf((a), (b)), (c))
__device__ __forceinline__ float rowmax(const f32x16& p0, const f32x16& p1) {
    float a = ATT_MX3(p0[0], p0[1], p1[0]), b = ATT_MX3(p0[2], p0[3], p1[1]); a = ATT_MX3(a, p1[2], p1[3]);
#pragma unroll
    for (int r = 4; r < 16; r += 4) { a = ATT_MX3(a, p0[r], p0[r + 1]); b = ATT_MX3(b, p0[r + 2], p0[r + 3]); a = ATT_MX3(a, p1[r], p1[r + 1]); b = ATT_MX3(b, p1[r + 2], p1[r + 3]); }
    float m = __builtin_fmaxf(a, b); auto rr = __builtin_amdgcn_permlane32_swap(__float_as_uint(m), __float_as_uint(m), false, false);
    return __builtin_fmaxf(__uint_as_float(rr[0]), __uint_as_float(rr[1])); }
__device__ __forceinline__ float rowsum(const f32x16& p0, const f32x16& p1) {
    float a = 0.f, b = 0.f;
#pragma unroll
    for (int r = 0; r < 16; r += 2) { a += p0[r] + p1[r]; b += p0[r + 1] + p1[r + 1]; }
    return a + b; }
__device__ __forceinline__ void vfrags(bf16x8 (&vf)[4], int vb, int d0) {
    s16x4 lo[4], hi[4];
    if (d0 == 0) {
#pragma unroll
        for (int ks = 0; ks < 4; ++ks) {
            asm volatile("ds_read_b64_tr_b16 %0,%1 offset:%c2" : "=&v"(lo[ks]) : "v"(vb), "i"(ks * 1024) : "memory");
            asm volatile("ds_read_b64_tr_b16 %0,%1 offset:%c2" : "=&v"(hi[ks]) : "v"(vb), "i"(ks * 1024 + 512) : "memory"); }
    } else {
#pragma unroll
        for (int ks = 0; ks < 4; ++ks) {
            asm volatile("ds_read_b64_tr_b16 %0,%1 offset:%c2" : "=&v"(lo[ks]) : "v"(vb), "i"(4096 + ks * 1024) : "memory");
            asm volatile("ds_read_b64_tr_b16 %0,%1 offset:%c2" : "=&v"(hi[ks]) : "v"(vb), "i"(4096 + ks * 1024 + 512) : "memory"); }
    }
    asm volatile("s_waitcnt lgkmcnt(0)" : "+v"(lo[0]), "+v"(lo[1]), "+v"(lo[2]), "+v"(lo[3]), "+v"(hi[0]), "+v"(hi[1]), "+v"(hi[2]), "+v"(hi[3]) :: "memory");
#pragma unroll
    for (int ks = 0; ks < 4; ++ks) vf[ks] = (bf16x8){lo[ks][0], lo[ks][1], lo[ks][2], lo[ks][3], hi[ks][0], hi[ks][1], hi[ks][2], hi[ks][3]};
}
struct PW { u32x4 w[4]; };
__device__ __forceinline__ void packp(PW& pw, const f32x16& p0, const f32x16& p1) {
#pragma unroll
    for (int i = 0; i < 4; ++i) { pw.w[0][i] = cvtpk(p0[2 * i], p0[2 * i + 1]); pw.w[1][i] = cvtpk(p0[8 + 2 * i], p0[9 + 2 * i]); pw.w[2][i] = cvtpk(p1[2 * i], p1[2 * i + 1]); pw.w[3][i] = cvtpk(p1[8 + 2 * i], p1[9 + 2 * i]); }
}
__device__ __forceinline__ bool softmax_tile(f32x16& p0, f32x16& p1, float& mhat, float& l_reg, float& f, bool first) {
    const float rm = rowmax(p0, p1);
    bool resc = false; f = 1.f;
    if (first || __any(rm > THR)) {
        const float dl = first ? rm : __builtin_fmaxf(rm, 0.f); mhat += dl;
#pragma unroll
        for (int r = 0; r < 16; ++r) { p0[r] -= dl; p1[r] -= dl; }
        if (!first) { f = __builtin_amdgcn_exp2f(-dl); l_reg *= f; resc = true; }
    }
#pragma unroll
    for (int r = 0; r < 16; ++r) { p0[r] = __builtin_amdgcn_exp2f(p0[r]); p1[r] = __builtin_amdgcn_exp2f(p1[r]); }
    l_reg += rowsum(p0, p1);
    return resc;
}
struct UnitDesc { int var, b, h, kvh, qrow0, f0, n0, f1, n1; };
struct LayerConst { int l; float lam, one_m_lam_init; };

template <int VAR> __device__ __forceinline__ void attn_unit(const Params& p, const UnitDesc& u, const LayerConst& lc, LAS unsigned char* lds, int tid_in) {
    const int tid = opaque_v(tid_in), lane = tid & 63, r32 = lane & 31, hi = lane >> 5; const int wid = __builtin_amdgcn_readfirstlane(tid >> 6);
    constexpr int QOFF = VAR == 0 ? AQ : VAR == 1 ? BQ : CQ, KOFF = VAR == 0 ? AK : VAR == 1 ? BK : CK, VOFF = VAR == 0 ? AV : VAR == 1 ? BV : CV, GOFF = VAR == 0 ? AG : VAR == 1 ? BG : CG, YOFF = VAR * 256;
    const size_t rowb = (size_t)u.b * T;
    const unsigned lds0 = (unsigned)(uintptr_t)lds;
    LAS float* wsf = (LAS float*)(lds + L_WSF) + wid * 64;
    LAS float* ost = (LAS float*)(lds + L_OST) + wid * 2048;
    LAS float* rpbL = (LAS float*)(lds + L_RPB);
    const int NT = u.n0 + u.n1;
    const bf16_t* kbase = p.P + (rowb + lane) * NP + KOFF + u.kvh * 64 + wid * 8;
    const bf16_t* vbase = p.P + (rowb + 16 * (wid & 3) + (lane >> 2)) * NP + VOFF + u.kvh * 64 + (wid >> 2) * 32 + (lane & 3) * 8;
#define ATT_TROW(j) (((j) < u.n0 ? u.f0 + (j) : u.f1 + ((j) - u.n0)) * 64)
#define ATT_DMA(j, slot) do { const size_t ro_ = (size_t)ATT_TROW(j) * NP; \
        glds16(kbase + ro_, (unsigned)__builtin_amdgcn_readfirstlane(lds0 + L_RING + (slot) * SLOT + wid * 1024)); \
        glds16(vbase + ro_, (unsigned)__builtin_amdgcn_readfirstlane(lds0 + L_RING + (slot) * SLOT + 8192 + wid * 1024)); } while (0)
    ATT_DMA(0, 0);
    if (NT > 1) ATT_DMA(1, 1);
    if (VAR == 2) { for (int i = tid; i < 15 * 31; i += NTHR) rpbL[i] = p.rpb[((size_t)lc.l * 4 + u.h) * 15 * 31 + i] * LOG2E; }
    const bf16_t* qp = p.P + (rowb + u.qrow0 + wid * 32 + r32) * NP + QOFF + u.h * 64 + hi * 8;
    bf16x8 qr[4];
#pragma unroll
    for (int d0 = 0; d0 < 4; ++d0) qr[d0] = *(const bf16x8*)(qp + d0 * 16);
    const int qt = u.qrow0 + wid * 32 + r32; const int gr = qt >> 6, gwc = qt & 63;
    const int rs0 = min(max(gr - 4, 0), 56), cs0 = min(max(gwc - 8, 0), 48);
    const bool latq = u.qrow0 < S;
    f32x16 o[2], o2[2]; o[0] = f32x16{}; o[1] = f32x16{}; o2[0] = f32x16{}; o2[1] = f32x16{};
    float mhat = 0.f, l_reg = 0.f, mhat2 = 0.f, l_reg2 = 0.f;
    f32x16 negm = f32x16{}, negm2 = f32x16{};
    bool started = false;
    for (int j = 0; j < NT; ++j) {
        if (j + 1 < NT) ATT_WAIT_BAR(2); else ATT_WAIT_BAR(0);
        if (j + 2 < NT) { const int s2 = (j + 2) % 3; ATT_DMA(j + 2, s2); }
        const int sl = (j % 3) * SLOT;
        const int trow = ATT_TROW(j);
        bool active = true; const bool wintile = (VAR == 2) && latq && trow < S;
        if (wintile) { const int kr = trow >> 6; active = (kr >= rs0) && (kr < rs0 + 8); }
        if (!active) continue;
        const LAS unsigned char* kp = lds + L_RING + sl + hi * 1024 + r32 * 16;
        const int vb = (int)(lds0 + L_RING + sl + 8192) + ((lane >> 4) & 1) * 32 + (lane & 3) * 8 + (4 * hi + ((lane & 15) >> 2)) * 64;
        if (VAR != 1) {
            f32x16 p0, p1;
#pragma unroll
            for (int d0 = 0; d0 < 4; ++d0) {
                const bf16x8 b0 = *(const LAS bf16x8*)(kp + d0 * 2048), b1 = *(const LAS bf16x8*)(kp + d0 * 2048 + 512);
                p0 = ATT_MFMA(b0, qr[d0], d0 == 0 ? negm : p0); p1 = ATT_MFMA(b1, qr[d0], d0 == 0 ? negm : p1);
            }
            if (wintile) {
                const int kr = trow >> 6; const LAS float* brow = rpbL + (kr - gr + 7) * 31 + 15 - gwc;
#pragma unroll
                for (int r = 0; r < 16; ++r) {
                    const int kc = crow(r, hi);
                    p0[r] = ((unsigned)(kc - cs0) < 16u) ? p0[r] + brow[kc] : -INFINITY;
                    p1[r] = ((unsigned)(kc + 32 - cs0) < 16u) ? p1[r] + brow[kc + 32] : -INFINITY;
                }
            }
            float f; const bool resc = softmax_tile(p0, p1, mhat, l_reg, f, !started);
            if (resc || !started) {
#pragma unroll
                for (int r = 0; r < 16; ++r) negm[r] = -mhat;
            }
            if (resc) {
                if (hi == 0) wsf[r32] = f;
#pragma unroll
                for (int d_ = 0; d_ < 2; ++d_)
#pragma unroll
                    for (int r = 0; r < 16; ++r) o[d_][r] *= wsf[crow(r, hi)];
            }
            started = true;
            PW pw; packp(pw, p0, p1);
#pragma unroll
            for (int d0 = 0; d0 < 2; ++d0) {
                bf16x8 vf[4]; vfrags(vf, vb, d0);
#pragma unroll
                for (int ks = 0; ks < 4; ++ks) o[d0] = ATT_MFMA(__builtin_bit_cast(bf16x8, pw.w[ks]), vf[ks], o[d0]);
            }
        } else {
            PW pw, pw2; float f = 1.f, f2 = 1.f; bool resc = false;
            {
                f32x16 p0 = f32x16{}, p1 = f32x16{};
#pragma unroll
                for (int d0 = 0; d0 < 2; ++d0) {
                    const bf16x8 b0 = *(const LAS bf16x8*)(kp + d0 * 2048), b1 = *(const LAS bf16x8*)(kp + d0 * 2048 + 512);
                    p0 = ATT_MFMA(b0, qr[d0], p0); p1 = ATT_MFMA(b1, qr[d0], p1);
                }
                const float rm = rowmax(p0, p1);
                if (!started) mhat = rm;
                else if (__any(rm - mhat > THR)) { const float mn = __builtin_fmaxf(mhat, rm); f = __builtin_amdgcn_exp2f(mhat - mn); mhat = mn; l_reg *= f; resc = true; }
#pragma unroll
                for (int r = 0; r < 16; ++r) { p0[r] = __builtin_amdgcn_exp2f(p0[r] - mhat); p1[r] = __builtin_amdgcn_exp2f(p1[r] - mhat); }
                l_reg += rowsum(p0, p1);
                packp(pw, p0, p1);
            }
            {
                f32x16 q0 = f32x16{}, q1 = f32x16{};
#pragma unroll
                for (int d0 = 2; d0 < 4; ++d0) {
                    const bf16x8 b0 = *(const LAS bf16x8*)(kp + d0 * 2048), b1 = *(const LAS bf16x8*)(kp + d0 * 2048 + 512);
                    q0 = ATT_MFMA(b0, qr[d0], q0); q1 = ATT_MFMA(b1, qr[d0], q1);
                }
                const float rm = rowmax(q0, q1);
                if (!started) mhat2 = rm;
                else if (__any(rm - mhat2 > THR)) { const float mn = __builtin_fmaxf(mhat2, rm); f2 = __builtin_amdgcn_exp2f(mhat2 - mn); mhat2 = mn; l_reg2 *= f2; resc = true; }
#pragma unroll
                for (int r = 0; r < 16; ++r) { q0[r] = __builtin_amdgcn_exp2f(q0[r] - mhat2); q1[r] = __builtin_amdgcn_exp2f(q1[r] - mhat2); }
                l_reg2 += rowsum(q0, q1);
                packp(pw2, q0, q1);
            }
            if (resc) {
                if (hi == 0) { wsf[r32] = f; wsf[32 + r32] = f2; }
#pragma unroll
                for (int d_ = 0; d_ < 2; ++d_)
#pragma unroll
                    for (int r = 0; r < 16; ++r) { o[d_][r] *= wsf[crow(r, hi)]; o2[d_][r] *= wsf[32 + crow(r, hi)]; }
            }
            started = true;
#pragma unroll
            for (int d0 = 0; d0 < 2; ++d0) {
                bf16x8 vf[4]; vfrags(vf, vb, d0);
#pragma unroll
                for (int ks = 0; ks < 4; ++ks) { o[d0] = ATT_MFMA(__builtin_bit_cast(bf16x8, pw.w[ks]), vf[ks], o[d0]); o2[d0] = ATT_MFMA(__builtin_bit_cast(bf16x8, pw2.w[ks]), vf[ks], o2[d0]); }
            }
        }
    }
    { auto rr = __builtin_amdgcn_permlane32_swap(__float_as_uint(l_reg), __float_as_uint(l_reg), false, false); l_reg = __uint_as_float(rr[0]) + __uint_as_float(rr[1]); }
    if (VAR == 1) { auto rr = __builtin_amdgcn_permlane32_swap(__float_as_uint(l_reg2), __float_as_uint(l_reg2), false, false); l_reg2 = __uint_as_float(rr[0]) + __uint_as_float(rr[1]); }
    if (hi == 0) { wsf[r32] = 1.f / l_reg; if (VAR == 1) wsf[32 + r32] = lc.lam / l_reg2; }
#pragma unroll
    for (int r = 0; r < 16; ++r) {
        const int orow = crow(r, hi); const float a1 = wsf[orow];
        if (VAR == 1) { const float a2 = wsf[32 + orow]; ost[orow * 64 + r32] = o[0][r] * a1 - o2[0][r] * a2; ost[orow * 64 + 32 + r32] = o[1][r] * a1 - o2[1][r] * a2; }
        else { ost[orow * 64 + r32] = o[0][r] * a1; ost[orow * 64 + 32 + r32] = o[1][r] * a1; }
    }
    asm volatile("s_waitcnt lgkmcnt(0)" ::: "memory");
    const size_t mrow0 = rowb + u.qrow0 + wid * 32;
#pragma unroll
    for (int i = 0; i < 4; ++i) {
        const int row = i * 8 + (lane >> 3), ch = lane & 7;
        const f32x4 x0 = *(const LAS f32x4*)(ost + row * 64 + ch * 8), x1 = *(const LAS f32x4*)(ost + row * 64 + ch * 8 + 4);
        float v[8] = {x0[0], x0[1], x0[2], x0[3], x1[0], x1[1], x1[2], x1[3]};
        if (VAR == 1) {
            float ss = 0.f;
#pragma unroll
            for (int e = 0; e < 8; ++e) ss += v[e] * v[e];
            ss += __shfl_xor(ss, 1); ss += __shfl_xor(ss, 2); ss += __shfl_xor(ss, 4);
            const float rs = rsqrtf(ss * (1.f / 64.f) + RMS_EPS) * lc.one_m_lam_init;
            const f32x4 g0 = *(const f32x4*)(p.subln_g + lc.l * 64 + ch * 8), g1 = *(const f32x4*)(p.subln_g + lc.l * 64 + ch * 8 + 4);
            const float gg[8] = {g0[0], g0[1], g0[2], g0[3], g1[0], g1[1], g1[2], g1[3]};
#pragma unroll
            for (int e = 0; e < 8; ++e) v[e] *= rs * gg[e];
        }
        const u32x4 gt = *(const u32x4*)(p.P + (mrow0 + row) * NP + GOFF + u.h * 64 + ch * 8);
        u32x4 w;
#pragma unroll
        for (int e = 0; e < 4; ++e) { const float ga = __uint_as_float(gt[e] << 16), gb = __uint_as_float(gt[e] & 0xffff0000u); w[e] = cvtpk(v[2 * e] * ga, v[2 * e + 1] * gb); }
        *(u32x4*)(p.A + (mrow0 + row) * D + YOFF + u.h * 64 + ch * 8) = w;
    }
    asm volatile("s_waitcnt lgkmcnt(0)\n\ts_barrier" ::: "memory");
#undef ATT_TROW
#undef ATT_DMA
}

__device__ __forceinline__ LayerConst make_lc(const Params& p, int l) {
    const float lam_init = 0.8f - 0.6f * __expf(-0.3f * (float)l);
    return LayerConst{l, p.lamv[l], 1.f - lam_init};
}
__device__ __forceinline__ void unit_a(const Params& p, const LayerConst& lc, int uidx, LAS unsigned char* lds, int tid_in) {
    UnitDesc u; u.var = 0; u.b = uidx >> 6; u.kvh = (uidx >> 5) & 1; u.h = u.kvh * 2 + ((uidx >> 4) & 1); u.qrow0 = (uidx & 15) * 256; u.f0 = 0; u.n0 = 68; u.f1 = 0; u.n1 = 0; attn_unit<0>(p, u, lc, lds, tid_in); }
__device__ __forceinline__ void unit_b(const Params& p, const LayerConst& lc, int uidx, LAS unsigned char* lds, int tid_in) {
    UnitDesc u; u.var = 1; u.b = uidx >> 6; u.h = (uidx >> 4) & 3; u.kvh = u.h; u.qrow0 = (uidx & 15) * 256; u.f0 = 0; u.n0 = 68; u.f1 = 0; u.n1 = 0; attn_unit<1>(p, u, lc, lds, tid_in); }
__device__ __forceinline__ void unit_c(const Params& p, const LayerConst& lc, int uidx, LAS unsigned char* lds, int tid_in) {
    UnitDesc u; u.var = 2; u.b = uidx >> 6; u.h = (uidx >> 4) & 3; u.kvh = u.h; const int qb = uidx & 15; u.qrow0 = qb * 256;
    const int ra = min(max(4 * qb - 4, 0), 56), rb = min(max(4 * qb + 3 - 4, 0), 56) + 8; u.f0 = 64; u.n0 = 4; u.f1 = ra; u.n1 = rb - ra; attn_unit<2>(p, u, lc, lds, tid_in); }
__device__ __forceinline__ void unit_ctx(const Params& p, const LayerConst& lc, int uidx, LAS unsigned char* lds, int tid_in) {
    const int var = uidx >> 4, b = (uidx >> 2) & 3, h = uidx & 3;
    UnitDesc u; u.var = var; u.b = b; u.h = h; u.kvh = var == 0 ? (h >> 1) : h; u.qrow0 = S; u.f0 = 64; u.n0 = 4; u.f1 = 0; u.n1 = 0;
    if (var == 0) attn_unit<0>(p, u, lc, lds, tid_in); else if (var == 1) attn_unit<1>(p, u, lc, lds, tid_in); else attn_unit<2>(p, u, lc, lds, tid_in);
}
}
namespace s5m {
typedef short bf16x8 __attribute__((ext_vector_type(8)));
constexpr int NCK = T / 16;
constexpr int TT_SZ = 31 * 256, E_SZ = 2 * 128 * 256, F_SZ = 2 * 256 * 128;
#define S5_MFMA(a, b, c) __builtin_amdgcn_mfma_f32_16x16x32_bf16(a, b, c, 0, 0, 0)
__device__ __forceinline__ void build_a(const Params& p, int gw, int ngw, int lane) {
    for (int it = gw * 64 + lane; it < NL * 2 * 16 * 64; it += ngw * 64) {
        const size_t ip = (size_t)it; const int ig = it >> 6;
        float* dsc = p.disc + ip * 34;
        const double ar = p.a_re[ip], ai = p.a_im[ip], dt = exp((double)p.log_dt[ig]);
        const double e = exp(ar * dt), lr = e * cos(ai * dt), li = e * sin(ai * dt);
        const double nr = lr - 1.0, ni = li, den = ar * ar + ai * ai; const double cr = (nr * ar + ni * ai) / den, ci = (ni * ar - nr * ai) / den;
        dsc[0] = (float)lr; dsc[1] = (float)li;
        for (int c = 0; c < 16; ++c) { const double br = p.b_re[ip * 16 + c], bi = p.b_im[ip * 16 + c]; dsc[2 + c] = (float)(cr * br - ci * bi); dsc[18 + c] = (float)(cr * bi + ci * br); }
        double pr = 1.0, pi = 0.0; float* lp = p.lampow + ip * 34;
        for (int k = 0; k <= 16; ++k) { lp[2 * k] = (float)pr; lp[2 * k + 1] = (float)pi; if (k < 16) { const double tr = pr * lr - pi * li, ti = pr * li + pi * lr; pr = tr; pi = ti; } }
        const double a_r = pr, a_i = pi; double qr = pr, qi = pi; float* ap = p.apow + ip * 32;
        for (int j = 1; j <= 16; ++j) { ap[2 * (j - 1)] = (float)qr; ap[2 * (j - 1) + 1] = (float)qi; const double tr = qr * a_r - qi * a_i, ti = qr * a_i + qi * a_r; qr = tr; qi = ti; }
    }
}
__device__ __forceinline__ void build_b(const Params& p, int gw, int ngw, int lane) {
    constexpr int NE = NL * 16 * 2 * 128 * 32;
    for (int it = gw * 64 + lane; it < NE; it += ngw * 64) {
        {
            const int half = it & 1, s = (it >> 1) & 15, row = (it >> 5) & 127, dir = (it >> 12) & 1, lg = it >> 13, g = lg & 15, l = lg >> 4;
            const int part = row & 1, st = row >> 1; const size_t ip = (size_t)((l * 2 + dir) * 16 + g) * 64 + st;
            const int k = dir == 0 ? 15 - s : s; const float wr = p.lampow[ip * 34 + 2 * k], wi = p.lampow[ip * 34 + 2 * k + 1];
            float v[8];
#pragma unroll
            for (int c = 0; c < 8; ++c) { const float br = p.disc[ip * 34 + 2 + half * 8 + c], bi = p.disc[ip * 34 + 18 + half * 8 + c]; v[c] = part == 0 ? wr * br - wi * bi : wr * bi + wi * br; }
            u32x4 o; o.x = pk2(v[0], v[1]); o.y = pk2(v[2], v[3]); o.z = pk2(v[4], v[5]); o.w = pk2(v[6], v[7]);
            *(u32x4*)(p.Etab + (size_t)it * 8) = o;
        }
        {
            const int k8 = it & 15, row = (it >> 4) & 255, dir = (it >> 12) & 1, lg = it >> 13, g = lg & 15, l = lg >> 4;
            const int st0 = k8 * 4, t = row >> 4, c = row & 15; const size_t ig = (size_t)((l * 2 + dir) * 16 + g);
            const int k = dir == 0 ? t + 1 : 16 - t;
            float v[8];
#pragma unroll
            for (int j = 0; j < 4; ++j) {
                const size_t ip = ig * 64 + st0 + j; const float wr = p.lampow[ip * 34 + 2 * k], wi = p.lampow[ip * 34 + 2 * k + 1];
                const float cr = p.c_re[(ig * 16 + c) * 64 + st0 + j], ci = p.c_im[(ig * 16 + c) * 64 + st0 + j];
                v[2 * j] = cr * wr - ci * wi; v[2 * j + 1] = -(cr * wi + ci * wr);
            }
            u32x4 o; o.x = pk2(v[0], v[1]); o.y = pk2(v[2], v[3]); o.z = pk2(v[4], v[5]); o.w = pk2(v[6], v[7]);
            *(u32x4*)(p.Ftab + (size_t)it * 8) = o;
        }
    }
    for (int it = gw * 64 + lane; it < NL * 16 * 256; it += ngw * 64) {
        const int cc = it & 15, c = (it >> 4) & 15, lg = it >> 8, g = lg & 15, l = lg >> 4;
        float kf[16], kb[16];
#pragma unroll
        for (int t = 0; t < 16; ++t) { kf[t] = 0.f; kb[t] = 0.f; }
#pragma unroll
        for (int dir = 0; dir < 2; ++dir) {
            const size_t ig = (size_t)((l * 2 + dir) * 16 + g);
            const float* cre = p.c_re + (ig * 16 + c) * 64; const float* cim = p.c_im + (ig * 16 + c) * 64;
            for (int st = 0; st < 64; ++st) {
                const size_t ip = ig * 64 + st;
                const float lr = p.disc[ip * 34], li = p.disc[ip * 34 + 1], br = p.disc[ip * 34 + 2 + cc], bi = p.disc[ip * 34 + 18 + cc];
                float wr = cre[st] * br - cim[st] * bi, wi = cre[st] * bi + cim[st] * br;
#pragma unroll
                for (int t = 0; t < 16; ++t) { if (dir == 0) kf[t] += wr; else kb[t] += wr; const float nr = wr * lr - wi * li, ni = wr * li + wi * lr; wr = nr; wi = ni; }
            }
        }
        bf16_t* o = p.Ttab + (size_t)lg * TT_SZ + c * 16 + cc;
#pragma unroll
        for (int t = 1; t < 16; ++t) { o[(15 + t) * 256] = f2bf(kf[t]); o[(15 - t) * 256] = f2bf(kb[t]); }
        o[15 * 256] = f2bf(kf[0] + kb[0]);
    }
}
constexpr int L_HIN = 0, L_UT = NCK * 512, L_S5END = L_UT + 2 * 8192;
template <int CTRL> __device__ __forceinline__ float dppf(float x) { return __int_as_float(__builtin_amdgcn_update_dpp(0, __float_as_int(x), CTRL, 0xf, 0xf, true)); }
template <int CTRL> __device__ __forceinline__ void hs_stage(f32x4& X, float a0r, float a0i, float a1r, float a1i) {
    const float y0 = dppf<CTRL>(X[0]), y1 = dppf<CTRL>(X[1]), y2 = dppf<CTRL>(X[2]), y3 = dppf<CTRL>(X[3]);
    X[0] += a0r * y0 - a0i * y1; X[1] += a0r * y1 + a0i * y0; X[2] += a1r * y2 - a1i * y3; X[3] += a1r * y3 + a1i * y2;
}
template <int DIR> __device__ __forceinline__ void scan_tile(f32x4& X, f32x4& Cin, const float (&a1)[2][2], const float (&apos)[2][2], int lane, int nn) {
    constexpr int B = DIR == 0 ? 0x110 : 0x100;
    float p0r = a1[0][0], p0i = a1[0][1], p1r = a1[1][0], p1i = a1[1][1];
    hs_stage<B + 1>(X, p0r, p0i, p1r, p1i);
    { const float t0 = p0r * p0r - p0i * p0i, t1 = 2.f * p0r * p0i, t2 = p1r * p1r - p1i * p1i, t3 = 2.f * p1r * p1i; p0r = t0; p0i = t1; p1r = t2; p1i = t3; }
    hs_stage<B + 2>(X, p0r, p0i, p1r, p1i);
    { const float t0 = p0r * p0r - p0i * p0i, t1 = 2.f * p0r * p0i, t2 = p1r * p1r - p1i * p1i, t3 = 2.f * p1r * p1i; p0r = t0; p0i = t1; p1r = t2; p1i = t3; }
    hs_stage<B + 4>(X, p0r, p0i, p1r, p1i);
    { const float t0 = p0r * p0r - p0i * p0i, t1 = 2.f * p0r * p0i, t2 = p1r * p1r - p1i * p1i, t3 = 2.f * p1r * p1i; p0r = t0; p0i = t1; p1r = t2; p1i = t3; }
    hs_stage<B + 8>(X, p0r, p0i, p1r, p1i);
    f32x4 Tt;
    Tt[0] = X[0] + apos[0][0] * Cin[0] - apos[0][1] * Cin[1]; Tt[1] = X[1] + apos[0][0] * Cin[1] + apos[0][1] * Cin[0];
    Tt[2] = X[2] + apos[1][0] * Cin[2] - apos[1][1] * Cin[3]; Tt[3] = X[3] + apos[1][0] * Cin[3] + apos[1][1] * Cin[2];
    f32x4 Ex; const bool first = DIR == 0 ? nn == 0 : nn == 15;
#pragma unroll
    for (int i = 0; i < 4; ++i) { const float sh = dppf<B + 1>(Tt[i]); Ex[i] = first ? Cin[i] : sh; }
    const int src = DIR == 0 ? ((lane & 48) | 15) : (lane & 48);
#pragma unroll
    for (int i = 0; i < 4; ++i) Cin[i] = __shfl(Tt[i], src);
    X = Ex;
}
__device__ __forceinline__ void unit(const Params& p, int l, int b, int g, LAS unsigned char* lds, int tid_in) {
    const int tid = opaque_v(tid_in), lane = tid & 63, wave = __builtin_amdgcn_readfirstlane(tid >> 6), nn = lane & 15, kg = lane >> 4;
    const size_t rowb = (size_t)b * T;
    LAS unsigned char* HIN = lds + L_HIN; LAS unsigned char* UT = lds + L_UT;
    const int sj = tid >> 5, sq = tid & 31;
    const bf16_t* usrc = p.P + (rowb + sj * 16 + (sq >> 1)) * NP + DU + g * 16 + (sq & 1) * 8;
    const int udst = sj * 512 + ((sq ^ sj) * 16);
#define S5_ULOAD(cb) (*(const u32x4*)(usrc + (size_t)(cb) * 256 * NP))
#define S5_UWRITE(cb, r) (*(LAS u32x4*)(UT + ((cb) & 1) * 8192 + udst) = (r))
#define S5_UFRAG(cb, kb) (*(const LAS bf16x8*)(UT + ((cb) & 1) * 8192 + nn * 512 + ((((2 * (kb) + (kg >> 1)) * 2 + (kg & 1)) ^ nn) * 16)))
    const int kbase = 32 * wave + 4 * kg;
#define S5_SHADDR(cb, rb) (HIN + ((cb) * 16 + nn) * 512 + ((((kbase + 16 * (rb)) >> 3) ^ nn) * 16) + ((kbase + 16 * (rb)) & 7) * 2)
    {
        const bf16_t* E = p.Etab + (size_t)(l * 16 + g) * E_SZ;
        bf16x8 af[2][8];
#pragma unroll
        for (int rb = 0; rb < 2; ++rb)
#pragma unroll
            for (int kb = 0; kb < 8; ++kb) af[rb][kb] = *(const bf16x8*)(E + (size_t)(wave * 32 + rb * 16 + nn) * 256 + kb * 32 + kg * 8);
        u32x4 r1, r2;
        { const u32x4 r0 = S5_ULOAD(0); r1 = S5_ULOAD(1); S5_UWRITE(0, r0); } __syncthreads();
#pragma unroll 1
        for (int cb = 0; cb < 17; ++cb) {
            if (cb + 2 < 17) r2 = S5_ULOAD(cb + 2);
            f32x4 a0 = {0.f, 0.f, 0.f, 0.f}, a1 = {0.f, 0.f, 0.f, 0.f};
#pragma unroll
            for (int kb = 0; kb < 8; ++kb) { const bf16x8 bfr = S5_UFRAG(cb, kb); a0 = S5_MFMA(af[0][kb], bfr, a0); a1 = S5_MFMA(af[1][kb], bfr, a1); }
            { u32x2 w; w.x = pk2(a0[0], a0[1]); w.y = pk2(a0[2], a0[3]); *(LAS u32x2*)S5_SHADDR(cb, 0) = w; w.x = pk2(a1[0], a1[1]); w.y = pk2(a1[2], a1[3]); *(LAS u32x2*)S5_SHADDR(cb, 1) = w; }
            if (cb + 1 < 17) S5_UWRITE(cb + 1, r1);
            __syncthreads();
            r1 = r2;
        }
    }
    {
        const int dir = wave >> 2;
        float ap[2][2][2], apos[2][2][2];
#pragma unroll
        for (int rb = 0; rb < 2; ++rb)
#pragma unroll
            for (int j = 0; j < 2; ++j) {
                const int st = 16 * (wave & 3) + 8 * rb + 2 * kg + j; const float* t = p.apow + ((size_t)((l * 2 + dir) * 16 + g) * 64 + st) * 32;
                ap[rb][j][0] = t[0]; ap[rb][j][1] = t[1];
                const int e = dir == 0 ? nn : 15 - nn; apos[rb][j][0] = t[2 * e]; apos[rb][j][1] = t[2 * e + 1];
            }
        f32x4 C0 = {0.f, 0.f, 0.f, 0.f}, C1 = {0.f, 0.f, 0.f, 0.f};
#pragma unroll 1
        for (int i = 0; i < 17; ++i) {
            const int cb = i == 0 ? 16 : (dir == 0 ? i - 1 : 16 - i);
            LAS u32x2* q0 = (LAS u32x2*)S5_SHADDR(cb, 0); LAS u32x2* q1 = (LAS u32x2*)S5_SHADDR(cb, 1);
            const u32x2 s0 = *q0, s1 = *q1;
            f32x4 x0 = {__uint_as_float(s0.x << 16), __uint_as_float(s0.x & 0xffff0000u), __uint_as_float(s0.y << 16), __uint_as_float(s0.y & 0xffff0000u)};
            f32x4 x1 = {__uint_as_float(s1.x << 16), __uint_as_float(s1.x & 0xffff0000u), __uint_as_float(s1.y << 16), __uint_as_float(s1.y & 0xffff0000u)};
            if (dir == 0) { scan_tile<0>(x0, C0, ap[0], apos[0], lane, nn); scan_tile<0>(x1, C1, ap[1], apos[1], lane, nn); }
            else { scan_tile<1>(x0, C0, ap[0], apos[0], lane, nn); scan_tile<1>(x1, C1, ap[1], apos[1], lane, nn); }
            u32x2 w; w.x = pk2(x0[0], x0[1]); w.y = pk2(x0[2], x0[3]); *q0 = w; w.x = pk2(x1[0], x1[1]); w.y = pk2(x1[2], x1[3]); *q1 = w;
        }
    }
    __syncthreads();
    {
        const bf16_t* Tt = p.Ttab + (size_t)(l * 16 + g) * TT_SZ; const bf16_t* F = p.Ftab + (size_t)(l * 16 + g) * F_SZ;
        bf16x8 at[2][8], afq[2][8];
#pragma unroll
        for (int rb = 0; rb < 2; ++rb) {
            const int t = wave * 2 + rb;
#pragma unroll
            for (int kb = 0; kb < 8; ++kb) {
                const int s = 2 * kb + (kg >> 1), half = kg & 1, ti = t - s + 15;
                at[rb][kb] = *(const bf16x8*)(Tt + (size_t)(ti * 16 + nn) * 16 + half * 8);
                afq[rb][kb] = *(const bf16x8*)(F + (size_t)((kb >> 2) * 256 + t * 16 + nn) * 128 + (kb & 3) * 32 + kg * 8);
            }
        }
        const float* dsk = p.s5_d + l * 256 + g * 16 + kg * 4;
        const float d0 = dsk[0], d1 = dsk[1], d2 = dsk[2], d3 = dsk[3];
        u32x4 r0 = S5_ULOAD(0), r1 = S5_ULOAD(1), r2 = S5_ULOAD(2);
        S5_UWRITE(0, r0); __syncthreads();
#pragma unroll
        for (int cb = 0; cb < 17; ++cb) {
            if (cb + 3 < 17) r0 = S5_ULOAD(cb + 3);
            const int n = cb * 16 + nn;
            f32x4 a0 = {0.f, 0.f, 0.f, 0.f}, a1 = {0.f, 0.f, 0.f, 0.f};
#pragma unroll
            for (int kb = 0; kb < 8; ++kb) { const bf16x8 bfr = S5_UFRAG(cb, kb); a0 = S5_MFMA(at[0][kb], bfr, a0); a1 = S5_MFMA(at[1][kb], bfr, a1); }
#pragma unroll
            for (int kb = 0; kb < 8; ++kb) { const bf16x8 hf = *(const LAS bf16x8*)(HIN + n * 512 + (((kb * 4 + kg) ^ nn) * 16)); a0 = S5_MFMA(afq[0][kb], hf, a0); a1 = S5_MFMA(afq[1][kb], hf, a1); }
#pragma unroll
            for (int rb = 0; rb < 2; ++rb) {
                const int t = wave * 2 + rb; const f32x4 a = rb == 0 ? a0 : a1;
                const u32x2 uu = *(const LAS u32x2*)(UT + (cb & 1) * 8192 + nn * 512 + (((t * 2 + (kg >> 1)) ^ nn) * 16) + (kg & 1) * 8);
                const float u0 = __uint_as_float(uu.x << 16), u1 = __uint_as_float(uu.x & 0xffff0000u), u2 = __uint_as_float(uu.y << 16), u3 = __uint_as_float(uu.y & 0xffff0000u);
                u32x2 w; w.x = pk2(gelu_tanh(a[0] + d0 * u0), gelu_tanh(a[1] + d1 * u1)); w.y = pk2(gelu_tanh(a[2] + d2 * u2), gelu_tanh(a[3] + d3 * u3));
                *(u32x2*)(p.ys5 + (rowb + n * 16 + t) * 256 + g * 16 + kg * 4) = w;
            }
            if (cb + 1 < 17) S5_UWRITE(cb + 1, r1);
            __syncthreads();
            r1 = r2; r2 = r0;
        }
    }
#undef S5_ULOAD
#undef S5_UWRITE
#undef S5_UFRAG
#undef S5_SHADDR
}
}
#define XB_TMO      128
#define XB_XCNT(j)  (256  + 64 * (j))
#define XB_XSUB(j)  (1280 + 64 * (j))
#define XB_XGEN(j)  (2304 + 64 * (j))
#define XB_TOP      3328
#define XB_TOPGEN   3392
#define XCD_BAR_WORDS 3456
#define XB_SPIN_CAP (1u << 18)
constexpr int CW_BAR = 4096;
constexpr int CTL_ZERO_BYTES = 65536;
constexpr int CW_QUEUE = 8192;
__device__ __forceinline__ unsigned xb_ld(unsigned* p)              { return __hip_atomic_load(p, __ATOMIC_RELAXED, __HIP_MEMORY_SCOPE_AGENT); }
__device__ __forceinline__ unsigned xb_add(unsigned* p, unsigned v) { return __hip_atomic_fetch_add(p, v, __ATOMIC_RELAXED, __HIP_MEMORY_SCOPE_AGENT); }
__device__ __forceinline__ unsigned xb_xcc_id() { return (unsigned)__builtin_amdgcn_s_getreg((3 << 11) | 20) & 0xFu; }
#define XB_SPIN(cond, bar) do { unsigned _sp = 0; while (cond) { __builtin_amdgcn_s_sleep(1); \
    if ((++_sp & 255u) == 0u) { if (xb_ld(&(bar)[XB_TMO])) break; if (_sp > XB_SPIN_CAP) { atomicAdd(&(bar)[XB_TMO], 1u); break; } } } } while (0)
__device__ __forceinline__ void xcd_barrier_post(unsigned* bar, bool leader) { if (leader) (void)xb_add(&bar[XB_XCNT(xb_xcc_id())], 1u); }
__device__ __forceinline__ void xcd_barrier_complete(unsigned* bar, unsigned x, unsigned& nloc, unsigned& nx) {
    const unsigned G = gridDim.x * gridDim.y * gridDim.z;
    unsigned sum, cnt, mine, sp = 0u;
    for (;;) {
        sum = 0u; cnt = 0u; mine = 0u;
#pragma unroll
        for (unsigned j = 0; j < 16; ++j) { const unsigned c = xb_ld(&bar[XB_XCNT(j)]); sum += c; cnt += (c > 0u) ? 1u : 0u; mine = (j == x) ? c : mine; }
        if (sum == G) break;
        __builtin_amdgcn_s_sleep(1);
        if ((++sp & 255u) == 0u) { if (xb_ld(&bar[XB_TMO])) break; if (sp > XB_SPIN_CAP) { atomicAdd(&bar[XB_TMO], 1u); break; } }
    }
    nloc = mine > 0u ? mine : 1u; nx = cnt > 0u ? cnt : 1u;
}
__device__ __forceinline__ void xcd_barrier(unsigned* bar, volatile LAS unsigned* st, bool leader) {
    asm volatile("s_waitcnt vmcnt(0)" ::: "memory");
    __syncthreads();
    if (leader) {
        const unsigned x = xb_xcc_id();
        __builtin_amdgcn_s_waitcnt(0);
        unsigned nloc = st[0], nx = st[1];
        if (nloc == 0u) { xcd_barrier_complete(bar, x, nloc, nx); st[0] = nloc; st[1] = nx; }
        const unsigned old = xb_add(&bar[XB_XSUB(x)], 1u);
        const unsigned gen = old / nloc;
        if (old + 1u == (gen + 1u) * nloc) {
            __builtin_amdgcn_fence(__ATOMIC_RELEASE, "agent");
            asm volatile("s_waitcnt vmcnt(0)" ::: "memory");
            const unsigned og = xb_add(&bar[XB_TOP], 1u);
            const unsigned tg = og / nx;
            if (og + 1u == (tg + 1u) * nx) xb_add(&bar[XB_TOPGEN], 1u);
            else XB_SPIN(xb_ld(&bar[XB_TOPGEN]) == tg, bar);
            __builtin_amdgcn_fence(__ATOMIC_ACQUIRE, "agent");
            xb_add(&bar[XB_XGEN(x)], 1u);
            asm volatile("s_waitcnt vmcnt(0)" ::: "memory");
        } else {
            XB_SPIN(xb_ld(&bar[XB_XGEN(x)]) == gen, bar);
            __builtin_amdgcn_fence(__ATOMIC_ACQUIRE, "agent");
            asm volatile("s_waitcnt vmcnt(0)" ::: "memory");
        }
    }
    __syncthreads();
}
constexpr int LDS_MISC = 155648;
constexpr int LDS_BYTES = 155648 + 256;
__device__ __forceinline__ void ph_inproj(const Params& p, int l, LAS unsigned char* lds, int G, int bx, int tid) {
    pg8::Gemm g{p.A, p.Win_t + (size_t)l * NP * D, MT, NP, D}; pg8::StaticOrder So; So.init(MT, NP, G, bx);
    pg8::EpiInProj E{p.P, p.tabA, p.tabB, p.qn_g + l * 64, p.kn_g + l * 64};
    pg8::gemm_phase<pg8::EpiInProj, pg8::StaticOrder, true, true>(lds, g, So, E, tid);
}
__device__ __forceinline__ void ph_outproj(const Params& p, int l, LAS unsigned char* lds, int G, int bx, int tid) {
    const int M = l == NL - 1 ? MT : MT;
    pg8::Gemm g{p.A, p.Wout_t + (size_t)l * D * D, M, D, D}; pg8::StaticOrder So; So.init(M, D, G, bx);
    pg8::EpiOutProj E{p.xl, p.xc, p.mod + (size_t)l * 5 * 3 * D};
    pg8::gemm_phase<pg8::EpiOutProj, pg8::StaticOrder, true, true>(lds, g, So, E, tid);
}
__device__ __forceinline__ void ph_glu(const Params& p, int l, LAS unsigned char* lds, int G, int bx, int tid) {
    pg8::Gemm g{p.ys5, p.Wglu_t + (size_t)l * 512 * 256, MT, 512, 256}; pg8::StaticOrder So; So.init(MT, 512, G, bx);
    pg8::EpiGlu E{p.A, p.P};
    pg8::gemm_phase<pg8::EpiGlu, pg8::StaticOrder, true, true>(lds, g, So, E, tid);
}
struct Ctx { int tid, lane, wave, G, bx, gw, ngw, v; };
__device__ __forceinline__ Ctx make_ctx(int wave0) {
    Ctx c; c.wave = opaque_s(wave0); c.lane = (int)__builtin_amdgcn_mbcnt_hi(~0u, __builtin_amdgcn_mbcnt_lo(~0u, (unsigned)opaque_v(0))); c.tid = c.wave * 64 + c.lane;
    c.G = opaque_s((int)gridDim.x); c.bx = opaque_s((int)blockIdx.x); c.gw = c.bx * NWAVES + c.wave; c.ngw = c.G * NWAVES;
    c.v = (c.G % 8 == 0) ? (c.bx % 8) * (c.G / 8) + (c.bx / 8) : c.bx;
    return c;
}
#define GRID_SYNC() do { const Ctx cb_ = make_ctx(wave0); xcd_barrier((unsigned*)(opaque_p(ka.ws) + O_CTL) + CW_BAR, (volatile LAS unsigned*)(lds + LDS_MISC), cb_.tid == 0); } while (0)
__global__ void __launch_bounds__(NTHR, 2) mega(KArgs ka) {
    extern __shared__ __attribute__((aligned(16))) unsigned char lds_raw[];
    LAS unsigned char* lds = (LAS unsigned char*)lds_raw;
    const int wave0 = __builtin_amdgcn_readfirstlane((int)threadIdx.x >> 6);
    if (threadIdx.x < 64) ((LAS unsigned*)(lds + LDS_MISC))[threadIdx.x] = 0u;
    __syncthreads();
    xcd_barrier_post((unsigned*)(ka.ws + O_CTL) + CW_BAR, threadIdx.x == 0);
    { const Params pp = make_params(ka, true);
      { const Ctx c = make_ctx(wave0); phase_prologue(pp, ka, lds, c.gw, c.ngw, c.wave, c.lane); s5m::build_a(pp, c.gw, c.ngw, c.lane); }
      cg::this_grid().sync();
      { const Ctx c = make_ctx(wave0); s5m::build_b(pp, c.gw, c.ngw, c.lane); phase_rows(pp, -1, 0, c.gw, c.ngw, c.lane); } }
    GRID_SYNC();
#pragma nounroll
    for (int l = 0; l < NL; ++l) {
        { const Ctx c = make_ctx(wave0); const Params p = make_params(ka, false); ph_inproj(p, l, lds, c.G, c.bx, c.tid); }
        GRID_SYNC();
        { const Ctx c = make_ctx(wave0); const Params p = make_params(ka, false); const att::LayerConst lc = att::make_lc(p, l);
          for (int u = c.v; u < 256; u += c.G) att::unit_a(p, lc, u, lds, c.tid); }
        { const Ctx c = make_ctx(wave0); const Params p = make_params(ka, false); const att::LayerConst lc = att::make_lc(p, l);
          for (int u = c.v; u < 256; u += c.G) att::unit_b(p, lc, u, lds, c.tid); }
#define QUEUE_POP(word, idxvar) do { const Ctx cq_ = make_ctx(wave0); volatile LAS unsigned* qw_ = (volatile LAS unsigned*)(lds + LDS_MISC + 64); \
            if (cq_.tid == 0) qw_[0] = __hip_atomic_fetch_add((unsigned*)(opaque_p(ka.ws) + O_CTL) + (word), 1u, __ATOMIC_RELAXED, __HIP_MEMORY_SCOPE_AGENT); \
            __syncthreads(); idxvar = __builtin_amdgcn_readfirstlane((int)qw_[0]); __syncthreads(); } while (0)
#pragma nounroll
        for (;;) { int idx; QUEUE_POP(CW_QUEUE + 128 * l, idx); if (idx >= NB * 16) break;
            const Ctx c = make_ctx(wave0); const Params p = make_params(ka, false); s5m::unit(p, l, idx >> 4, idx & 15, lds, c.tid); }
#pragma nounroll
        for (;;) { int idx; QUEUE_POP(CW_QUEUE + 128 * l + 64, idx); if (idx >= 256 + (l < NL - 1 ? 48 : 0)) break;
            const Ctx c = make_ctx(wave0); const Params p = make_params(ka, false); const att::LayerConst lc = att::make_lc(p, l);
            if (idx < 256) att::unit_c(p, lc, idx, lds, c.tid); else att::unit_ctx(p, lc, idx - 256, lds, c.tid); }
        GRID_SYNC();
        { const Ctx c = make_ctx(wave0); const Params p = make_params(ka, false); ph_glu(p, l, lds, c.G, c.bx, c.tid); }
        GRID_SYNC();
        { const Ctx c = make_ctx(wave0); const Params p = make_params(ka, false); ph_outproj(p, l, lds, c.G, c.bx, c.tid); }
        GRID_SYNC();
        { const Ctx c = make_ctx(wave0); const Params p = make_params(ka, false); phase_rows(p, l, l + 1, c.gw, c.ngw, c.lane); }
        if (l + 1 < NL) GRID_SYNC();
    }
}

extern "C" void kernel_launch(void* const* d_in, const int* in_sizes, int n_in, void* d_out, int out_size, void* d_ws, size_t ws_size, hipStream_t stream) {
    static int grid = 0;
    if (grid == 0) {
        int dev = 0, cus = 0, per_cu = 0;
        (void)hipGetDevice(&dev); (void)hipDeviceGetAttribute(&cus, hipDeviceAttributeMultiprocessorCount, dev);
        (void)hipFuncSetAttribute((const void*)mega, hipFuncAttributeMaxDynamicSharedMemorySize, LDS_BYTES);
        if (hipOccupancyMaxActiveBlocksPerMultiprocessor(&per_cu, (const void*)mega, NTHR, LDS_BYTES) != hipSuccess || per_cu < 1) { per_cu = 1; (void)hipGetLastError(); }
        if (per_cu > 1) per_cu = 1;
        grid = (cus > 0 ? cus : 256) * per_cu;
    }
    KArgs ka{};
    for (int i = 0; i < 27; ++i) ka.in[i] = (const float*)d_in[i];
    ka.out = (float*)d_out; ka.ws = (unsigned char*)d_ws;
    if (O_END > ws_size) { fprintf(stderr, "kernel_launch: workspace too small: need %zu have %zu\n", (size_t)O_END, ws_size); return; }
    (void)hipMemsetAsync((unsigned char*)d_ws + O_CTL, 0, CTL_ZERO_BYTES, stream);
    void* args[] = {&ka};
    hipError_t e = hipLaunchCooperativeKernel((const void*)mega, dim3(grid), dim3(NTHR), args, LDS_BYTES, stream);
    if (e != hipSuccess) fprintf(stderr, "cooperative launch failed: %s (grid %d)\n", hipGetErrorString(e), grid);
}
```

```cpp
#include <hip/hip_runtime.h>
#include <hip/hip_cooperative_groups.h>
#include <cstdint>
#include <cstdio>
#include <math.h>
namespace cg = cooperative_groups;

constexpr int D = 1024, NB = 4, S = 4096, NL = 4, GW = 64, CT = 256;
constexpr int T = S + CT;
constexpr int MT = NB * T;
constexpr int NP = 3328;
constexpr int AQ = 0, AK = 256, AV = 384, AG = 512, BQ = 768, BK = 1024, BV = 1280, BG = 1536, CQ = 1792, CK = 2048, CV = 2304, CG = 2560, DU = 2816, DG = 3072;
constexpr float RMS_EPS = 1e-6f, LN_EPS = 1e-5f;
constexpr float ALPHA = 1.681792830507429f;
constexpr float LOG2E = 1.4426950408889634f;
constexpr float C2A = 0.125f * LOG2E;
constexpr float C2B = 0.17677669529663687f * LOG2E;
constexpr int NCH = T / 64;
constexpr int NWAVES = 8, NTHR = 512;

typedef unsigned short bf16_t;
typedef float f32x4 __attribute__((ext_vector_type(4)));
typedef unsigned u32x4 __attribute__((ext_vector_type(4)));
typedef unsigned u32x2 __attribute__((ext_vector_type(2)));
#define LAS __attribute__((address_space(3)))
__device__ __forceinline__ float bf2f(bf16_t v) { return __uint_as_float(((unsigned)v) << 16); }
__device__ __forceinline__ unsigned f2bf_u(float f) { unsigned u = __float_as_uint(f); return (u + 0x7fffu + ((u >> 16) & 1u)) >> 16; }
__device__ __forceinline__ bf16_t f2bf(float f) { return (bf16_t)f2bf_u(f); }
__device__ __forceinline__ unsigned pk2(float lo, float hi) { return f2bf_u(lo) | (f2bf_u(hi) << 16); }
__device__ __forceinline__ float silu_f(float v) { return v / (1.f + __expf(-v)); }
__device__ __forceinline__ float sigm_f(float v) { return 1.f / (1.f + __expf(-v)); }
__device__ __forceinline__ float gelu_tanh(float v) { return 0.5f * v * (1.f + tanhf(0.7978845608028654f * (v + 0.044715f * v * v * v))); }

__device__ __forceinline__ int opaque_v(int x) { asm volatile("" : "+v"(x)); return x; }
__device__ __forceinline__ int opaque_s(int x) { asm volatile("" : "+s"(x)); return x; }
struct Params {
    const float *x, *c, *ctx, *c_ctx, *w_ada, *b_ada, *w_in, *w_out, *ln_g, *ln_b, *qn_g, *kn_g, *lq1, *lk1, *lq2, *lk2, *subln_g, *rpb;
    const float *a_re, *a_im, *log_dt, *b_re, *b_im, *c_re, *c_im, *s5_d, *w_glu;
    float* xl;
    float* xc;
    float* mod;
    float* tabA;
    float* tabB;
    bf16_t* Win_t;
    bf16_t* Wout_t;
    bf16_t* Wglu_t;
    bf16_t* A;
    bf16_t* P;
    bf16_t* ys5;
    float* Sbuf;
    bf16_t* Hinb;
    bf16_t* Ttab; bf16_t* Etab; bf16_t* Ftab; float* apow; float* lampow;
    unsigned* ctl;
    float* disc;
    float* lamv;
};
struct KArgs { const float* in[27]; float* out; unsigned char* ws; };
constexpr size_t al256(size_t x) { return (x + 255) & ~(size_t)255; }
constexpr size_t O_CTL = 0, O_XC = O_CTL + (1 << 20), O_MOD = O_XC + al256((size_t)NB * CT * D * 4), O_TABA = O_MOD + al256((size_t)NL * 5 * 3 * D * 4), O_TABB = O_TABA + 8192,
    O_WIN = O_TABB + 4096, O_WOUT = O_WIN + al256((size_t)NL * NP * D * 2), O_WGLU = O_WOUT + al256((size_t)NL * D * D * 2), O_A = O_WGLU + al256((size_t)NL * 512 * 256 * 2),
    O_P = O_A + al256((size_t)MT * D * 2), O_YS5 = O_P + al256((size_t)MT * NP * 2), O_SBUF = O_YS5 + al256((size_t)MT * 256 * 2), O_HINB = O_SBUF + al256((size_t)NB * 16 * 272 * 256 * 4), O_TTAB = O_HINB + al256((size_t)NB * 16 * 272 * 256 * 2),
    O_ETAB = O_TTAB + al256((size_t)NL * 16 * 31 * 256 * 2), O_FTAB = O_ETAB + al256((size_t)NL * 16 * 2 * 128 * 256 * 2), O_LAM16 = O_FTAB + al256((size_t)NL * 16 * 2 * 256 * 128 * 2),
    O_LAMPOW = O_LAM16 + al256((size_t)NL * 2 * 16 * 64 * 32 * 4), O_SMALL = O_LAMPOW + al256((size_t)NL * 2 * 16 * 64 * 34 * 4);
constexpr int SM_N[18] = {NL * D, NL * D, NL * 64, NL * 64, NL * 32, NL * 32, NL * 32, NL * 32, NL * 64, NL * 4 * 15 * 31, NL * 2 * 16 * 64, NL * 2 * 16 * 64, NL * 2 * 16, NL * 2 * 16 * 64 * 16, NL * 2 * 16 * 64 * 16, NL * 2 * 16 * 16 * 64, NL * 2 * 16 * 16 * 64, NL * 256};
constexpr int sm_off(int i) { int o = 0; for (int k = 0; k < i; ++k) o += (SM_N[k] + 63) & ~63; return o; }
constexpr size_t O_DISC = O_SMALL + al256((size_t)sm_off(18) * 4);
constexpr size_t O_LAMV = O_DISC + al256((size_t)NL * 2 * 16 * 64 * 34 * 4);
constexpr size_t O_END = O_LAMV + 256;
template <class Tp> __device__ __forceinline__ Tp* opaque_p(Tp* x) { long z = 0; asm volatile("" : "+s"(z)); return (Tp*)((char*)x + z); }
__device__ __forceinline__ Params make_params(const KArgs& ka, bool prologue) {
    Params p;
    const float** f = (const float**)&p;
    if (prologue) { for (int i = 0; i < 27; ++i) f[i] = ka.in[i]; }
    else {
        for (int i = 0; i < 27; ++i) f[i] = nullptr;
        const float* sm = (const float*)(opaque_p(ka.ws) + O_SMALL);
        p.ln_g = sm + sm_off(0); p.ln_b = sm + sm_off(1); p.qn_g = sm + sm_off(2); p.kn_g = sm + sm_off(3); p.lq1 = sm + sm_off(4); p.lk1 = sm + sm_off(5); p.lq2 = sm + sm_off(6); p.lk2 = sm + sm_off(7);
        p.subln_g = sm + sm_off(8); p.rpb = sm + sm_off(9); p.a_re = sm + sm_off(10); p.a_im = sm + sm_off(11); p.log_dt = sm + sm_off(12); p.b_re = sm + sm_off(13); p.b_im = sm + sm_off(14);
        p.c_re = sm + sm_off(15); p.c_im = sm + sm_off(16); p.s5_d = sm + sm_off(17);
    }
    unsigned char* ws = opaque_p(ka.ws);
    p.xl = opaque_p(ka.out); p.xc = (float*)(ws + O_XC); p.mod = (float*)(ws + O_MOD); p.tabA = (float*)(ws + O_TABA); p.tabB = (float*)(ws + O_TABB);
    p.Win_t = (bf16_t*)(ws + O_WIN); p.Wout_t = (bf16_t*)(ws + O_WOUT); p.Wglu_t = (bf16_t*)(ws + O_WGLU); p.A = (bf16_t*)(ws + O_A); p.P = (bf16_t*)(ws + O_P);
    p.ys5 = (bf16_t*)(ws + O_YS5); p.Sbuf = (float*)(ws + O_SBUF); p.Hinb = (bf16_t*)(ws + O_HINB); p.Ttab = (bf16_t*)(ws + O_TTAB); p.Etab = (bf16_t*)(ws + O_ETAB); p.Ftab = (bf16_t*)(ws + O_FTAB); p.apow = (float*)(ws + O_LAM16); p.lampow = (float*)(ws + O_LAMPOW); p.ctl = (unsigned*)(ws + O_CTL); p.disc = (float*)(ws + O_DISC); p.lamv = (float*)(ws + O_LAMV);
    return p;
}
__device__ __forceinline__ float* xrow(const Params& p, int m) { const int b = m / T, t = m - b * T; return t < S ? p.xl + ((size_t)b * S + t) * D : p.xc + ((size_t)b * CT + (t - S)) * D; }
__device__ __forceinline__ int modrow(int m) { const int b = m / T, t = m - b * T; return t < S ? b : 4; }
namespace pg8 {
#define PG8_LAS __attribute__((address_space(3)))
typedef unsigned short bf16_t;
typedef short bf16x8 __attribute__((ext_vector_type(8)));
typedef float f32x4 __attribute__((ext_vector_type(4)));
typedef unsigned u32x4 __attribute__((ext_vector_type(4)));
constexpr int BM = 256, BK = 64, HALF = 128, HTB = HALF * BK * 2  , STAGE_BYTES = 8 * HTB, NXCD = 8, WGM = 8;

__host__ __device__ __forceinline__ int lds_byte(int r, int c) { const int st = (r >> 4) * 2 + (c >> 5), rr = r & 15, cc = c & 31, ob = rr * 64 + cc * 2; return st * 1024 + (ob ^ (((ob >> 9) & 1) << 5)); }
__host__ __device__ __forceinline__ void stage_rc(int b, int& R, int& C) { const int st = b / 1024, sb = b % 1024, swz = sb ^ (((sb >> 9) & 1) << 5); R = (st >> 1) * 16 + swz / 64; C = (st & 1) * 32 + (swz % 64) / 2; }
__host__ __device__ __forceinline__ int perm32(int rho) { const int n = rho >> 4, i = rho & 15; return 8 * (i >> 2) + 4 * n + (i & 3); }

struct Unit { int pm, pn; };
struct Gemm { const bf16_t* A; const bf16_t* Bt; int M, N, K; };

struct StaticOrder {
    int nM, nN, nwg, G, c;
    __host__ __device__ void init(int M, int N, int G_, int c_) { nM = M / BM; nN = N / BM; nwg = nM * nN; G = G_; c = c_; }
    __host__ __device__ bool next(int i, Unit& u) const {
        const long L = (long)i * G + c; if (L >= nwg) return false;
        int wgid = (int)L; { const int q = nwg / NXCD, r = nwg % NXCD, xcd = wgid % NXCD, off = wgid / NXCD; wgid = (xcd < r ? xcd * (q + 1) : r * (q + 1) + (xcd - r) * q) + off; }
        const int nig = WGM * nN, gid = wgid / nig, fm = gid * WGM, gsz = (nM - fm) < WGM ? (nM - fm) : WGM;
        u.pm = fm + ((wgid % nig) % gsz); u.pn = (wgid % nig) / gsz; return true;
    }
    __device__ __forceinline__ void a_ready(const Unit&) const {}
    __device__ __forceinline__ void done(const Unit&) const {}
};

__device__ __forceinline__ unsigned cvt_pk_bf16(float lo, float hi) { unsigned r; asm volatile("v_cvt_pk_bf16_f32 %0, %1, %2" : "=v"(r) : "v"(lo), "v"(hi)); return r; }
typedef float f32x2 __attribute__((ext_vector_type(2)));
template <class Epi, class Sched, bool ALIGN_EPI = false, bool SP2 = false>
__device__ __forceinline__ void gemm_phase(PG8_LAS unsigned char* lds, const Gemm g, const Sched& S, const Epi& E, int tid_in) {
    const int tid = tid_in, wid = __builtin_amdgcn_readfirstlane(tid >> 6), lane = tid & 63, wr = wid >> 2, wc = wid & 3, fr = lane & 15, fq = lane >> 4;
    const int K = g.K, nt = K / BK;
    unsigned voffA[2], voffB[2];
#pragma unroll
    for (int i = 0; i < 2; ++i) { int R, C; stage_rc(tid * 16 + i * 8192, R, C); const int Rb = Epi::PERM ? ((R & ~31) + perm32(R & 31)) : R;
        voffA[i] = (unsigned)(R * K + C) * 2u; voffB[i] = (unsigned)(Rb * K + C) * 2u; }
    const size_t kstep = (size_t)(BK * 2);
    const size_t hstep = (size_t)HALF * K * 2;
    const size_t tstep = 2 * hstep;
    const unsigned ldsw = (unsigned)wid * 1024u;
    const int aoff = lds_byte(wr * 64 + fr, fq * 8), boff = lds_byte(wc * 32 + fr, fq * 8);
#define PG8_SA(b, h) (((b) * 2 + (h)) * HTB)
#define PG8_SB(b, h) ((4 + (b) * 2 + (h)) * HTB)
#define PG8_STAGE(bufoff, gbase, voff) do { _Pragma("unroll") for (int _i = 0; _i < 2; ++_i) \
        __builtin_amdgcn_global_load_lds((const unsigned*)((const char*)(gbase) + (voff)[_i]), (PG8_LAS unsigned*)(lds + (bufoff) + ldsw + _i * 8192), 16, 0, 0); } while (0)
#define PG8_LDA(dst, b, h) do { _Pragma("unroll") for (int m = 0; m < 4; ++m) _Pragma("unroll") for (int k = 0; k < 2; ++k) dst[m][k] = *(const PG8_LAS bf16x8*)(lds + PG8_SA(b, h) + aoff + m * 2048 + k * 1024); } while (0)
#define PG8_LDB(dst, b, h) do { _Pragma("unroll") for (int n = 0; n < 2; ++n) _Pragma("unroll") for (int k = 0; k < 2; ++k) dst[n][k] = *(const PG8_LAS bf16x8*)(lds + PG8_SB(b, h) + boff + n * 2048 + k * 1024); } while (0)
#define PG8_MMA(ai, bj, At, Bt) do { __builtin_amdgcn_s_setprio(1); _Pragma("unroll") for (int m = 0; m < 4; ++m) _Pragma("unroll") for (int n = 0; n < 2; ++n) _Pragma("unroll") for (int k = 0; k < 2; ++k) \
        acc[ai][bj][m][n] = __builtin_amdgcn_mfma_f32_16x16x32_bf16(Bt[n][k], At[m][k], acc[ai][bj][m][n], 0, 0, 0); __builtin_amdgcn_s_setprio(0); } while (0)
#define PG8_WAIT_V(n) asm volatile("s_waitcnt vmcnt(" #n ")" ::: "memory")
#define PG8_WAIT_L(n) asm volatile("s_waitcnt lgkmcnt(" #n ")" ::: "memory")
#define PG8_BAR __builtin_amdgcn_s_barrier()
#define PG8_SCHED __builtin_amdgcn_sched_barrier(0)
    Unit cur, nxt; int ui = 0;
    if (!S.next(0, cur)) return;
    f32x4 acc[2][2][4][2];
#pragma unroll
    for (int a = 0; a < 2; ++a)
#pragma unroll
        for (int b = 0; b < 2; ++b)
#pragma unroll
            for (int m = 0; m < 4; ++m)
#pragma unroll
                for (int n = 0; n < 2; ++n) acc[a][b][m][n] = (f32x4){0.f, 0.f, 0.f, 0.f};
    bf16x8 At[4][2], B0[2][2], B1[2][2];
    const char* cA = (const char*)g.A + (size_t)cur.pm * tstep; const char* cB = (const char*)g.Bt + (size_t)cur.pn * tstep;
    S.a_ready(cur);
    if constexpr (SP2) {
        PG8_STAGE(PG8_SB(0, 0), cB, voffB); PG8_STAGE(PG8_SB(0, 1), cB + hstep, voffB); PG8_STAGE(PG8_SA(0, 0), cA, voffA); PG8_STAGE(PG8_SA(0, 1), cA + hstep, voffA);
        if (wr == 1) PG8_BAR;
        PG8_WAIT_V(2); PG8_BAR;
        PG8_STAGE(PG8_SB(1, 0), cB + kstep, voffB); PG8_STAGE(PG8_SA(1, 0), cA + kstep, voffA); PG8_STAGE(PG8_SB(1, 1), cB + hstep + kstep, voffB);
        PG8_WAIT_V(6); PG8_BAR;
    } else {
        PG8_STAGE(PG8_SB(0, 0), cB, voffB); PG8_STAGE(PG8_SA(0, 0), cA, voffA); PG8_STAGE(PG8_SB(0, 1), cB + hstep, voffB); PG8_STAGE(PG8_SA(0, 1), cA + hstep, voffA);
        if (wr == 1) PG8_BAR;
        PG8_WAIT_V(4); PG8_BAR;
        PG8_STAGE(PG8_SB(1, 0), cB + kstep, voffB); PG8_STAGE(PG8_SA(1, 0), cA + kstep, voffA); PG8_STAGE(PG8_SB(1, 1), cB + hstep + kstep, voffB);
        PG8_WAIT_V(6); PG8_BAR;
    }
    for (;;) {
        const bool has_next = S.next(ui + 1, nxt);
        const char* nA = has_next ? (const char*)g.A + (size_t)nxt.pm * tstep : cA; const char* nB = has_next ? (const char*)g.Bt + (size_t)nxt.pn * tstep : cB;
        for (int t = 0; t < nt; t += 2) {
            const bool last = (t == nt - 2);
            const char* a1 = cA + (size_t)(t + 1) * kstep;
            const char* a2 = last ? nA : cA + (size_t)(t + 2) * kstep; const char* b2 = last ? nB : cB + (size_t)(t + 2) * kstep;
            const char* a3 = a2 + kstep; const char* b3 = b2 + kstep;
            if (last && has_next) S.a_ready(nxt);
            if constexpr (SP2) {
            PG8_LDB(B0, 0, 0); PG8_LDB(B1, 0, 1); PG8_SCHED; PG8_LDA(At, 0, 0); PG8_STAGE(PG8_SA(1, 1), a1 + hstep, voffA);
            PG8_WAIT_V(8); PG8_WAIT_L(0); PG8_BAR; PG8_MMA(0, 0, At, B0); PG8_MMA(0, 1, At, B1); PG8_BAR; PG8_SCHED;
            PG8_LDA(At, 0, 1); PG8_STAGE(PG8_SB(0, 0), b2, voffB); PG8_STAGE(PG8_SB(0, 1), b2 + hstep, voffB); PG8_STAGE(PG8_SA(0, 0), a2, voffA);
            PG8_WAIT_V(8); PG8_WAIT_L(0); PG8_BAR; PG8_MMA(1, 0, At, B0); PG8_MMA(1, 1, At, B1); PG8_BAR; PG8_SCHED;
            PG8_LDB(B0, 1, 0); PG8_LDB(B1, 1, 1); PG8_SCHED; PG8_LDA(At, 1, 0); PG8_STAGE(PG8_SA(0, 1), a2 + hstep, voffA);
            PG8_WAIT_V(8); PG8_WAIT_L(0); PG8_BAR; PG8_MMA(0, 0, At, B0); PG8_MMA(0, 1, At, B1); PG8_BAR; PG8_SCHED;
            PG8_LDA(At, 1, 1); PG8_STAGE(PG8_SB(1, 0), b3, voffB); PG8_STAGE(PG8_SB(1, 1), b3 + hstep, voffB); PG8_STAGE(PG8_SA(1, 0), a3, voffA);
            PG8_WAIT_V(8); PG8_WAIT_L(0); PG8_BAR; PG8_MMA(1, 0, At, B0); PG8_MMA(1, 1, At, B1); PG8_BAR; PG8_SCHED;
            } else {
            PG8_LDB(B0, 0, 0); PG8_SCHED; PG8_LDA(At, 0, 0); PG8_STAGE(PG8_SA(1, 1), a1 + hstep, voffA);
            PG8_WAIT_L(8); PG8_BAR; PG8_WAIT_L(0); PG8_MMA(0, 0, At, B0); PG8_BAR; PG8_SCHED;
            PG8_LDB(B1, 0, 1); PG8_STAGE(PG8_SB(0, 0), b2, voffB);
            PG8_BAR; PG8_WAIT_L(0); PG8_MMA(0, 1, At, B1); PG8_BAR;
            PG8_LDA(At, 0, 1); PG8_STAGE(PG8_SA(0, 0), a2, voffA);
            PG8_BAR; PG8_WAIT_L(0); PG8_MMA(1, 0, At, B0); PG8_BAR; PG8_SCHED;
            PG8_STAGE(PG8_SB(0, 1), b2 + hstep, voffB);
            PG8_WAIT_V(6); PG8_BAR; PG8_MMA(1, 1, At, B1); PG8_BAR;
            PG8_LDB(B0, 1, 0); PG8_SCHED; PG8_LDA(At, 1, 0); PG8_STAGE(PG8_SA(0, 1), a2 + hstep, voffA);
            PG8_WAIT_L(8); PG8_BAR; PG8_WAIT_L(0); PG8_MMA(0, 0, At, B0); PG8_BAR; PG8_SCHED;
            PG8_LDB(B1, 1, 1); PG8_STAGE(PG8_SB(1, 0), b3, voffB);
            PG8_BAR; PG8_WAIT_L(0); PG8_MMA(0, 1, At, B1); PG8_BAR;
            PG8_LDA(At, 1, 1); PG8_STAGE(PG8_SA(1, 0), a3, voffA);
            PG8_BAR; PG8_WAIT_L(0); PG8_MMA(1, 0, At, B0); PG8_BAR; PG8_SCHED;
            PG8_STAGE(PG8_SB(1, 1), b3 + hstep, voffB);
            PG8_WAIT_V(6); PG8_BAR; PG8_MMA(1, 1, At, B1); PG8_BAR;
            }
        }
        if constexpr (ALIGN_EPI) { if (wr == 0) PG8_BAR; }
        if constexpr (!Epi::AFTER_DRAIN) { E(acc, cur, wr, wc, fr, fq); S.done(cur); }
        if (!has_next) break;
#pragma unroll
        for (int a = 0; a < 2; ++a)
#pragma unroll
            for (int b = 0; b < 2; ++b)
#pragma unroll
                for (int m = 0; m < 4; ++m)
#pragma unroll
                    for (int n = 0; n < 2; ++n) acc[a][b][m][n] = (f32x4){0.f, 0.f, 0.f, 0.f};
        cur = nxt; cA = nA; cB = nB; ++ui;
        if constexpr (ALIGN_EPI) { if (wr == 1) PG8_BAR; }
    }
    PG8_WAIT_V(0);
    if constexpr (!ALIGN_EPI) { if (wr == 0) PG8_BAR; }
    PG8_BAR;
    if constexpr (Epi::AFTER_DRAIN) { E.fused(acc, cur, wr, wc, fr, fq, lds, wid, lane); S.done(cur); }
#undef PG8_SA
#undef PG8_SB
#undef PG8_STAGE
#undef PG8_LDA
#undef PG8_LDB
#undef PG8_MMA
#undef PG8_WAIT_V
#undef PG8_WAIT_L
#undef PG8_BAR
#undef PG8_SCHED
}
}
namespace pg8 {
struct EpiInProj {
    static constexpr bool PERM = true, AFTER_DRAIN = false;
    ::bf16_t* P; const float* tabA; const float* tabB; const float* qn_g; const float* kn_g;
    __device__ __forceinline__ void operator()(const f32x4 (&acc)[2][2][4][2], const Unit& u, int wr_, int wc_, int fr_, int fq_) const {
        const int fr = opaque_v(fr_), fq = opaque_v(fq_), wr = opaque_s(wr_), wc = opaque_s(wc_);
        const int pn = u.pn, m0 = u.pm * BM; const int t0 = m0 % T; const bool lat = t0 < S;
        int type = 0; float qs = 1.f; const float* g = nullptr;
        if (pn == 0) { type = 3; qs = C2A; g = qn_g; }
        else if (pn == 1) { if (wc < 2) { type = 3; g = kn_g; } }
        else if (pn == 2 || pn == 6 || pn == 10 || pn == 12) type = 1;
        else if (pn == 3) { type = 4; qs = C2B; }
        else if (pn == 4) type = 4;
        else if (pn == 7) { type = 2; qs = C2A; }
        ::bf16_t* base = P + (size_t)(m0 + wr * 64 + fr) * NP + 256 * pn + 64 * wc + 8 * fq;
        f32x4 gv[2][2];
        if (type == 3) {
#pragma unroll
            for (int bj = 0; bj < 2; ++bj)
#pragma unroll
                for (int n = 0; n < 2; ++n) gv[bj][n] = *(const f32x4*)(g + 32 * bj + 16 * n + 4 * fq);
        }
#pragma unroll
        for (int ai = 0; ai < 2; ++ai) {
            const int prow = (t0 >> 6) + 2 * ai + wr;
#pragma unroll
            for (int m = 0; m < 4; ++m) {
                f32x4 v[2][2];
#pragma unroll
                for (int bj = 0; bj < 2; ++bj)
#pragma unroll
                    for (int n = 0; n < 2; ++n) v[bj][n] = acc[ai][bj][m][n];
                const int pcol = 16 * m + fr;
                if (type == 1) {
#pragma unroll
                    for (int bj = 0; bj < 2; ++bj)
#pragma unroll
                        for (int n = 0; n < 2; ++n)
#pragma unroll
                            for (int e = 0; e < 4; ++e) v[bj][n][e] = silu_f(v[bj][n][e]);
                } else if (type == 2) {
#pragma unroll
                    for (int bj = 0; bj < 2; ++bj)
#pragma unroll
                        for (int n = 0; n < 2; ++n) v[bj][n] = v[bj][n] * qs;
                } else if (type == 3) {
                    float ss = 0.f;
#pragma unroll
                    for (int bj = 0; bj < 2; ++bj)
#pragma unroll
                        for (int n = 0; n < 2; ++n) ss += (v[bj][n][0] * v[bj][n][0] + v[bj][n][1] * v[bj][n][1]) + (v[bj][n][2] * v[bj][n][2] + v[bj][n][3] * v[bj][n][3]);
                    ss += __shfl_xor(ss, 16); ss += __shfl_xor(ss, 32);
                    const float rs = rsqrtf(ss * (1.f / 64.f) + RMS_EPS);
#pragma unroll
                    for (int bj = 0; bj < 2; ++bj)
#pragma unroll
                        for (int n = 0; n < 2; ++n) v[bj][n] = v[bj][n] * rs * gv[bj][n];
                    if (lat) {
#pragma unroll
                        for (int bj = 0; bj < 2; ++bj) {
                            const int pos = bj == 0 ? prow : pcol;
                            const f32x4 t0v = *(const f32x4*)(tabA + (pos * 16 + 4 * fq) * 2), t1v = *(const f32x4*)(tabA + (pos * 16 + 4 * fq) * 2 + 4);
                            const float cs[4] = {t0v[0], t0v[2], t1v[0], t1v[2]}, sn[4] = {t0v[1], t0v[3], t1v[1], t1v[3]};
#pragma unroll
                            for (int e = 0; e < 4; ++e) { const float x1 = v[bj][0][e], x2 = v[bj][1][e]; v[bj][0][e] = x1 * cs[e] - x2 * sn[e]; v[bj][1][e] = x1 * sn[e] + x2 * cs[e]; }
                        }
                    }
                    if (qs != 1.f) {
#pragma unroll
                        for (int bj = 0; bj < 2; ++bj)
#pragma unroll
                            for (int n = 0; n < 2; ++n) v[bj][n] = v[bj][n] * qs;
                    }
                } else if (type == 4) {
                    if (lat) {
                        const int pos = (fq >> 1) == 0 ? prow : pcol;
                        const f32x4 t0v = *(const f32x4*)(tabB + (pos * 8 + 4 * (fq & 1)) * 2), t1v = *(const f32x4*)(tabB + (pos * 8 + 4 * (fq & 1)) * 2 + 4);
                        const float cs[4] = {t0v[0], t0v[2], t1v[0], t1v[2]}, sn[4] = {t0v[1], t0v[3], t1v[1], t1v[3]};
#pragma unroll
                        for (int bj = 0; bj < 2; ++bj)
#pragma unroll
                            for (int e = 0; e < 4; ++e) { const float x1 = v[bj][0][e], x2 = v[bj][1][e]; v[bj][0][e] = x1 * cs[e] - x2 * sn[e]; v[bj][1][e] = x1 * sn[e] + x2 * cs[e]; }
                    }
                    if (qs != 1.f) {
#pragma unroll
                        for (int bj = 0; bj < 2; ++bj)
#pragma unroll
                            for (int n = 0; n < 2; ++n) v[bj][n] = v[bj][n] * qs;
                    }
                }
                ::bf16_t* rowp = base + (size_t)(ai * HALF + m * 16) * NP;
#pragma unroll
                for (int bj = 0; bj < 2; ++bj) {
                    u32x4 w; w.x = cvt_pk_bf16(v[bj][0][0], v[bj][0][1]); w.y = cvt_pk_bf16(v[bj][0][2], v[bj][0][3]); w.z = cvt_pk_bf16(v[bj][1][0], v[bj][1][1]); w.w = cvt_pk_bf16(v[bj][1][2], v[bj][1][3]);
                    *(u32x4*)(rowp + 32 * bj) = w;
                }
            }
        }
    }
};
struct EpiOutProj {
    static constexpr bool PERM = false, AFTER_DRAIN = false;
    float* xl; float* xc; const float* mod_l;
    __device__ __forceinline__ void operator()(const f32x4 (&acc)[2][2][4][2], const Unit& u, int wr_, int wc_, int fr_, int fq_) const {
        const int fr = opaque_v(fr_), fq = opaque_v(fq_), wr = opaque_s(wr_), wc = opaque_s(wc_);
        const int m0 = u.pm * BM; const int b = m0 / T, t0 = m0 - b * T;
        float* xb = t0 < S ? xl + ((size_t)b * S + t0) * D : xc + ((size_t)b * CT + (t0 - S)) * D;
        const float* gate = mod_l + (size_t)(t0 < S ? b : 4) * 3 * D + 2 * D;
        const int col0 = u.pn * BM + wc * 32 + 4 * fq;
        f32x4 gv[2][2];
#pragma unroll
        for (int bj = 0; bj < 2; ++bj)
#pragma unroll
            for (int n = 0; n < 2; ++n) gv[bj][n] = *(const f32x4*)(gate + col0 + bj * HALF + n * 16);
#pragma unroll
        for (int ai = 0; ai < 2; ++ai)
#pragma unroll
            for (int m = 0; m < 4; ++m) {
                float* xr = xb + (size_t)(ai * HALF + wr * 64 + m * 16 + fr) * D + col0;
#pragma unroll
                for (int bj = 0; bj < 2; ++bj)
#pragma unroll
                    for (int n = 0; n < 2; ++n) { const f32x4 xv = *(const f32x4*)(xr + bj * HALF + n * 16); *(f32x4*)(xr + bj * HALF + n * 16) = xv * ALPHA + gv[bj][n] * acc[ai][bj][m][n]; }
            }
    }
};
struct EpiGlu {
    static constexpr bool PERM = true, AFTER_DRAIN = false;
    ::bf16_t* Y; const ::bf16_t* P;
    __device__ __forceinline__ void operator()(const f32x4 (&acc)[2][2][4][2], const Unit& u, int wr_, int wc_, int fr_, int fq_) const {
        const int fr = opaque_v(fr_), fq = opaque_v(fq_), wr = opaque_s(wr_), wc = opaque_s(wc_);
        const int m0 = u.pm * BM, col8 = 128 * u.pn + 32 * wc + 8 * fq;
#pragma unroll
        for (int ai = 0; ai < 2; ++ai)
#pragma unroll
            for (int m = 0; m < 4; ++m) {
                const size_t row = (size_t)(m0 + ai * HALF + wr * 64 + m * 16 + fr);
                const u32x4 gt = *(const u32x4*)(P + row * NP + DG + col8);
                float o[8];
#pragma unroll
                for (int n = 0; n < 2; ++n)
#pragma unroll
                    for (int e = 0; e < 4; ++e) { const float v = acc[ai][0][m][n][e], g = acc[ai][1][m][n][e]; o[4 * n + e] = v * sigm_f(g); }
                u32x4 w;
#pragma unroll
                for (int e = 0; e < 4; ++e) { const float ga = __uint_as_float(gt[e] << 16), gb = __uint_as_float(gt[e] & 0xffff0000u); w[e] = cvt_pk_bf16(o[2 * e] * ga, o[2 * e + 1] * gb); }
                *(u32x4*)(Y + row * D + 768 + col8) = w;
            }
    }
};
}
__device__ __forceinline__ float wave_sum(float v) {
#pragma unroll
    for (int o = 1; o < 64; o <<= 1) v += __shfl_xor(v, o);
    return v;
}
__device__ __forceinline__ void transpose_item(const float* W, int K, int N, bf16_t* WT, int kb, int nphys0, int lbase, int pt, LAS float* scr, int lane) {
    const int k0 = 64 * kb;
#pragma unroll 8
    for (int i = 0; i < 32; ++i) { const int kk = 2 * i + (lane >> 5); scr[kk * 33 + (lane & 31)] = W[(size_t)(k0 + kk) * N + lbase + (lane & 31)]; }
    asm volatile("s_waitcnt lgkmcnt(0)" ::: "memory");
    const int c = lane & 7;
#pragma unroll
    for (int j = 0; j < 4; ++j) {
        const int n = (lane >> 3) + 8 * j; const int fq = n >> 3, nn = (n >> 2) & 1, e = n & 3;
        const int lo = pt == 0 ? n : pt == 1 ? 16 * nn + 4 * fq + e : 16 * (fq >> 1) + 8 * nn + 4 * (fq & 1) + e;
        const LAS float* s = scr + (8 * c) * 33 + lo;
        u32x4 o; o.x = pk2(s[0 * 33], s[1 * 33]); o.y = pk2(s[2 * 33], s[3 * 33]); o.z = pk2(s[4 * 33], s[5 * 33]); o.w = pk2(s[6 * 33], s[7 * 33]);
        *(u32x4*)(WT + (size_t)(nphys0 + n) * K + k0 + 8 * c) = o;
    }
    asm volatile("s_waitcnt lgkmcnt(0)" ::: "memory");
}
__device__ __forceinline__ void phase_prologue(const Params& p, const KArgs& ka, LAS unsigned char* lds, int gw, int ngw, int wave, int lane) {
    {
        float* sm = (float*)(ka.ws + O_SMALL);
#pragma unroll
        for (int i = 0; i < 18; ++i) { const float* src = ka.in[8 + i]; float* dst = sm + sm_off(i); for (int e = gw * 64 + lane; e < SM_N[i]; e += ngw * 64) dst[e] = src[e]; }
    }
    LAS float* sc5 = (LAS float*)lds;
    LAS float* scr = (LAS float*)(lds + 20480 + wave * 9216);
    for (int i = threadIdx.x; i < 5 * D; i += NTHR) { const float v = i < 4 * D ? p.c[i] : p.c_ctx[i - 4 * D]; sc5[i] = v / (1.f + expf(-v)); }
    __syncthreads();
    {
        LAS float* red = (LAS float*)(lds + 20480 + 8 * 9216);
        const int bx = gw >> 3, G = ngw >> 3;
        for (int it = bx; it < NL * 48; it += G) {
            const int l = it / 48, j = (it % 48) * 64 + lane;
            const float* w = p.w_ada + (size_t)l * D * 3 * D + j;
            float a0 = 0.f, a1 = 0.f, a2 = 0.f, a3 = 0.f, a4 = 0.f;
#pragma unroll 8
            for (int k = wave * 128; k < wave * 128 + 128; ++k) { const float wv = w[(size_t)k * 3 * D]; a0 += sc5[k] * wv; a1 += sc5[D + k] * wv; a2 += sc5[2 * D + k] * wv; a3 += sc5[3 * D + k] * wv; a4 += sc5[4 * D + k] * wv; }
            red[(wave * 5 + 0) * 64 + lane] = a0; red[(wave * 5 + 1) * 64 + lane] = a1; red[(wave * 5 + 2) * 64 + lane] = a2; red[(wave * 5 + 3) * 64 + lane] = a3; red[(wave * 5 + 4) * 64 + lane] = a4;
            __syncthreads();
            if (wave < 5) {
                float s = p.b_ada[l * 3 * D + j];
#pragma unroll
                for (int w8 = 0; w8 < 8; ++w8) s += red[(w8 * 5 + wave) * 64 + lane];
                p.mod[((size_t)l * 5 + wave) * 3 * D + j] = s;
            }
            __syncthreads();
        }
    }
    if (gw == 0 && lane < NL) {
        float d1 = 0.f, d2 = 0.f;
        for (int i = 0; i < 32; ++i) { d1 += p.lq1[lane * 32 + i] * p.lk1[lane * 32 + i]; d2 += p.lq2[lane * 32 + i] * p.lk2[lane * 32 + i]; }
        p.lamv[lane] = expf(d1) - expf(d2) + (0.8f - 0.6f * expf(-0.3f * (float)lane));
    }
    for (int i = gw * 64 + lane; i < 64 * 16 + 64 * 8; i += ngw * 64) {
        if (i < 1024) { const int pos = i >> 4, k = i & 15; const float an = (float)pos * powf(10000.f, -(float)k / 16.f); p.tabA[2 * i] = cosf(an); p.tabA[2 * i + 1] = sinf(an); }
        else { const int j = i - 1024, pos = j >> 3, k = j & 7; const float an = (float)pos * powf(10000.f, -(float)k / 8.f); p.tabB[2 * j] = cosf(an); p.tabB[2 * j + 1] = sinf(an); }
    }
    constexpr int I_IN = 16 * 104, I_OUT = 16 * 32, I_GLU = 4 * 16, I_L = I_IN + I_OUT + I_GLU;
    for (int it = gw; it < NL * I_L; it += ngw) {
        const int l = it / I_L; int r = it % I_L;
        if (r < I_IN) {
            const int kb = r / 104, nb = r % 104, c = 32 * nb, pn = c >> 8, bj = (c >> 7) & 1, wc = (c >> 5) & 3;
            const int pt = (pn == 0 || (pn == 1 && wc < 2)) ? 1 : (pn == 3 || pn == 4) ? 2 : 0;
            transpose_item(p.w_in + (size_t)l * D * NP, D, NP, p.Win_t + (size_t)l * NP * D, kb, c, 256 * pn + 64 * wc + 32 * bj, pt, scr, lane);
        } else if ((r -= I_IN) < I_OUT) {
            const int kb = r / 32, nb = r % 32;
            transpose_item(p.w_out + (size_t)l * D * D, D, D, p.Wout_t + (size_t)l * D * D, kb, 32 * nb, 32 * nb, 0, scr, lane);
        } else {
            r -= I_OUT; const int kb = r / 16, nb = r % 16, c = 32 * nb, pn = c >> 8, bj = (c >> 7) & 1, wc = (c >> 5) & 3;
            transpose_item(p.w_glu + (size_t)l * 256 * 512, 256, 512, p.Wglu_t + (size_t)l * 512 * 256, kb, c, 256 * bj + 128 * pn + 32 * wc, 0, scr, lane);
        }
    }
}
__device__ __forceinline__ void phase_rows(const Params& p, int l_prev, int l_next, int gw, int ngw, int lane) {
    for (int m = gw; m < MT; m += ngw) {
        const int b = m / T, t = m - b * T; const bool lat = t < S;
        if (l_next == NL && !lat) continue;
        float* xr = lat ? p.xl + ((size_t)b * S + t) * D : p.xc + ((size_t)b * CT + (t - S)) * D;
        f32x4 v[4];
        if (l_prev < 0) {
            const float* src = lat ? p.x + ((size_t)b * S + t) * D : p.ctx + ((size_t)b * CT + (t - S)) * D;
#pragma unroll
            for (int j = 0; j < 4; ++j) { v[j] = *(const f32x4*)(src + 4 * lane + 256 * j); *(f32x4*)(xr + 4 * lane + 256 * j) = v[j]; }
        } else {
            float s = 0.f;
#pragma unroll
            for (int j = 0; j < 4; ++j) { v[j] = *(const f32x4*)(xr + 4 * lane + 256 * j); s += (v[j][0] + v[j][1]) + (v[j][2] + v[j][3]); }
            const float mean = wave_sum(s) * (1.f / D); float q = 0.f;
#pragma unroll
            for (int j = 0; j < 4; ++j) { v[j] = v[j] - mean; q += (v[j][0] * v[j][0] + v[j][1] * v[j][1]) + (v[j][2] * v[j][2] + v[j][3] * v[j][3]); }
            const float rstd = rsqrtf(wave_sum(q) * (1.f / D) + LN_EPS);
#pragma unroll
            for (int j = 0; j < 4; ++j) {
                const f32x4 g = *(const f32x4*)(p.ln_g + l_prev * D + 4 * lane + 256 * j), be = *(const f32x4*)(p.ln_b + l_prev * D + 4 * lane + 256 * j);
                v[j] = v[j] * rstd * g + be; *(f32x4*)(xr + 4 * lane + 256 * j) = v[j];
            }
        }
        if (l_next < NL) {
            const float* md = p.mod + ((size_t)l_next * 5 + (lat ? b : 4)) * 3 * D;
            bf16_t* ar = p.A + (size_t)m * D;
#pragma unroll
            for (int j = 0; j < 4; ++j) {
                const f32x4 sh = *(const f32x4*)(md + 4 * lane + 256 * j), sc = *(const f32x4*)(md + D + 4 * lane + 256 * j);
                const f32x4 h = v[j] * (sc + 1.f) + sh;
                u32x2 w; w.x = pk2(h[0], h[1]); w.y = pk2(h[2], h[3]); *(u32x2*)(ar + 4 * lane + 256 * j) = w;
            }
        }
    }
}
namespace att2 {
typedef unsigned short bf16;
using bf16x8=__attribute__((ext_vector_type(8)))short;
using s16x4=__attribute__((ext_vector_type(4)))short;
using f32x16=__attribute__((ext_vector_type(16)))float;
#define SBAR() __builtin_amdgcn_sched_barrier(0)
__device__ __forceinline__ int crow(int r,int hi){return (r&3)+8*(r>>2)+4*hi;}
#define SBAR() __builtin_amdgcn_sched_barrier(0)
__device__ __forceinline__ void cmask(f32x16&p0,f32x16&p1,int jb,int qrel,int hi){
  const float NEG=-INFINITY; int kb=64*jb+4*hi;
  #pragma unroll
  for(int r=0;r<16;++r){int kv=kb+(r&3)+8*(r>>2); if(kv>qrel)p0[r]=NEG; if(kv+32>qrel)p1[r]=NEG;}
}

constexpr int NW=8,QBLK=32,QB=256,KVBLK=64,DM=NP;
constexpr int NSLOT=3, SLOTB=8192;
constexpr int LDS_K=0, LDS_V=NSLOT*SLOTB, LDS_WS=2*NSLOT*SLOTB, LDS_OST=LDS_WS+NW*64*4, LDS_BYTES=LDS_OST+NW*8192;
constexpr float C2=0.125f*1.4426950408889634f;
__device__ __forceinline__ void glds16(const void*gsrc,unsigned lds_dst){unsigned keep;
  asm volatile("s_mov_b32 %0, m0\n\ts_mov_b32 m0, %2\n\ts_nop 0\n\tglobal_load_lds_dwordx4 %1, off\n\ts_mov_b32 m0, %0":"=&s"(keep):"v"(gsrc),"s"(lds_dst):"memory");}
__device__ __forceinline__ float max3f(float a,float b,float c){float r;asm("v_max3_f32 %0, %1, %2, %3":"=v"(r):"v"(a),"v"(b),"v"(c));return r;}
__device__ __forceinline__ float max2f(float a,float b){float r;asm("v_max_f32_e32 %0, %1, %2":"=v"(r):"v"(a),"v"(b));return r;}
__device__ __forceinline__ float fadd_s(float a,float b){float r;asm("v_add_f32_e32 %0, %1, %2":"=v"(r):"v"(a),"v"(b));return r;}
__device__ __forceinline__ float fsub_s(float a,float b){float r;asm("v_sub_f32_e32 %0, %1, %2":"=v"(r):"v"(a),"v"(b));return r;}
typedef float f32x2_t __attribute__((ext_vector_type(2))); typedef __bf16 bf16x2_t __attribute__((ext_vector_type(2)));
__device__ __forceinline__ unsigned cvtpk_s(float lo,float hi){f32x2_t v={lo,hi};bf16x2_t b=__builtin_convertvector(v,bf16x2_t);return __builtin_bit_cast(unsigned,b);}
#define WAIT_BAR(N) asm volatile("s_waitcnt vmcnt(" #N ") lgkmcnt(0)\n\ts_barrier":::"memory")

typedef __attribute__((address_space(3))) const char* lds_cptr;
__device__ __forceinline__ void qkt(f32x16&p0,f32x16&p1,lds_cptr Kslot,const bf16x8*qr,const f32x16&negm,int r32,int hi){
  const lds_cptr kb=Kslot+hi*1024+r32*16;
  #pragma unroll
  for(int d0=0;d0<4;++d0){
    const bf16x8 b0=*(const __attribute__((address_space(3))) bf16x8*)(kb+d0*2048);
    const bf16x8 b1=*(const __attribute__((address_space(3))) bf16x8*)(kb+d0*2048+512);
    if(d0==0){p0=__builtin_amdgcn_mfma_f32_32x32x16_bf16(b0,qr[0],negm,0,0,0);p1=__builtin_amdgcn_mfma_f32_32x32x16_bf16(b1,qr[0],negm,0,0,0);}
    else{p0=__builtin_amdgcn_mfma_f32_32x32x16_bf16(b0,qr[d0],p0,0,0,0);p1=__builtin_amdgcn_mfma_f32_32x32x16_bf16(b1,qr[d0],p1,0,0,0);}}
}
typedef short v4i16_t __attribute__((ext_vector_type(4)));
__device__ __forceinline__ void kload8(bf16x8*kf,lds_cptr kp){
  kf[0]=*(const __attribute__((address_space(3))) bf16x8*)(kp);      kf[1]=*(const __attribute__((address_space(3))) bf16x8*)(kp+512);
  kf[2]=*(const __attribute__((address_space(3))) bf16x8*)(kp+2048); kf[3]=*(const __attribute__((address_space(3))) bf16x8*)(kp+2560);
  kf[4]=*(const __attribute__((address_space(3))) bf16x8*)(kp+4096); kf[5]=*(const __attribute__((address_space(3))) bf16x8*)(kp+4608);
  kf[6]=*(const __attribute__((address_space(3))) bf16x8*)(kp+6144); kf[7]=*(const __attribute__((address_space(3))) bf16x8*)(kp+6656);
}
__device__ __forceinline__ void kload2(bf16x8*kf,lds_cptr kp,int j){ kf[2*j]=*(const __attribute__((address_space(3))) bf16x8*)(kp+j*2048); kf[2*j+1]=*(const __attribute__((address_space(3))) bf16x8*)(kp+j*2048+512); }
__device__ __forceinline__ s16x4 vtr(lds_cptr p){ return __builtin_bit_cast(s16x4,__builtin_amdgcn_ds_read_tr16_b64_v4i16((__attribute__((address_space(3))) v4i16_t*)p)); }
__device__ __forceinline__ float rowmax(const f32x16&p0,const f32x16&p1){
  float a=max3f(p0[0],p0[1],p1[0]),b=max3f(p0[2],p0[3],p1[1]);a=max3f(a,p1[2],p1[3]);
  #pragma unroll
  for(int r=4;r<16;r+=4){a=max3f(a,p0[r],p0[r+1]);b=max3f(b,p0[r+2],p0[r+3]);a=max3f(a,p1[r],p1[r+1]);b=max3f(b,p1[r+2],p1[r+3]);}
  const float m=max2f(a,b);
  auto rr=__builtin_amdgcn_permlane32_swap(__float_as_uint(m),__float_as_uint(m),false,false);
  return max2f(__uint_as_float(rr[0]),__uint_as_float(rr[1]));
}
__device__ __forceinline__ void pv(f32x16*o,int vb,bf16x8 pa0,bf16x8 pa1,bf16x8 pa2,bf16x8 pa3){
  #pragma unroll
  for(int d0=0;d0<2;++d0){s16x4 lo[4],hi[4];
    #pragma unroll
    for(int ks=0;ks<4;++ks){
      asm volatile("ds_read_b64_tr_b16 %0,%1 offset:%c2":"=&v"(lo[ks]):"v"(vb),"i"(d0*4096+ks*1024):"memory");
      asm volatile("ds_read_b64_tr_b16 %0,%1 offset:%c2":"=&v"(hi[ks]):"v"(vb),"i"(d0*4096+ks*1024+512):"memory");}
    asm volatile("s_waitcnt lgkmcnt(0)":::"memory");SBAR();
    #define PK(k) (bf16x8){lo[k][0],lo[k][1],lo[k][2],lo[k][3],hi[k][0],hi[k][1],hi[k][2],hi[k][3]}
    o[d0]=__builtin_amdgcn_mfma_f32_32x32x16_bf16(pa0,PK(0),o[d0],0,0,0);
    o[d0]=__builtin_amdgcn_mfma_f32_32x32x16_bf16(pa1,PK(1),o[d0],0,0,0);
    o[d0]=__builtin_amdgcn_mfma_f32_32x32x16_bf16(pa2,PK(2),o[d0],0,0,0);
    o[d0]=__builtin_amdgcn_mfma_f32_32x32x16_bf16(pa3,PK(3),o[d0],0,0,0);
    #undef PK
  }
}

template<int THRL> __device__ __forceinline__ void attn_unit(const bf16*Qw0,const bf16*__restrict__ Kh,const bf16*__restrict__ Vh,int NT,const bf16*Gw0,bf16*Yw0,LAS unsigned char*ldsp,int tid_in){
  const int tid=opaque_v(tid_in),lane=tid&63,r32=lane&31,hi=lane>>5; const int wid=__builtin_amdgcn_readfirstlane(tid>>6);
  const bf16*Qw=Qw0+(long)(wid*QBLK)*DM;
  char*shm=(char*)ldsp;
  const unsigned lds0=(unsigned)(uintptr_t)shm;
  LAS float*wsf=(LAS float*)(ldsp+LDS_WS)+wid*64;
  const bf16*ksrc=Kh+(long)lane*DM+wid*8;
  const bf16*vsrc=Vh+(long)(16*(wid&3)+(lane>>2))*DM+(wid>>2)*32+(lane&3)*8;
  const unsigned kdst=lds0+LDS_K+wid*1024, vdst=lds0+LDS_V+wid*1024;
  #define DMA_K(t,slot) glds16(ksrc+(long)(t)*KVBLK*DM,(unsigned)__builtin_amdgcn_readfirstlane(kdst+(slot)))
  #define DMA_V(t,slot) glds16(vsrc+(long)(t)*KVBLK*DM,(unsigned)__builtin_amdgcn_readfirstlane(vdst+(slot)))
  const int vb0=(int)(lds0+LDS_V)+((lane>>4)&1)*32+(lane&3)*8+(4*hi+((lane&15)>>2))*64;
  const lds_cptr Kbase=(lds_cptr)ldsp+LDS_K; bf16x8 kf[8];
  const lds_cptr shm3=(lds_cptr)shm; const lds_cptr kp0=shm3+LDS_K+hi*1024+r32*16; const lds_cptr vp0=shm3+LDS_V+((lane>>4)&1)*32+(lane&3)*8+(4*hi+((lane&15)>>2))*64;
  DMA_K(0,0);DMA_V(0,0);DMA_K(1,SLOTB);
  bf16x8 qr[4];
  #pragma unroll
  for(int d0=0;d0<4;++d0)qr[d0]=*reinterpret_cast<const bf16x8*>(&Qw[(long)r32*DM+d0*16+hi*8]);
  float mhat=0.f,l_reg=0.f;f32x16 o[2];o[0]=f32x16{};o[1]=f32x16{};f32x16 negm=f32x16{};asm volatile("":"+v"(negm));
  #define CMASK(P0,P1,t) do{}while(0)
  bool resc=false;
  #define START(P0,P1) do{ const float rm=rowmax(P0,P1); resc=false; \
    { const float dl=rm; mhat=fadd_s(mhat,dl); \
      _Pragma("unroll") for(int r=0;r<16;++r){P0[r]=fsub_s(P0[r],dl);P1[r]=fsub_s(P1[r],dl);} \
      _Pragma("unroll") for(int r=0;r<16;++r)negm[r]=-mhat; asm volatile("":"+v"(negm)); } \
    _Pragma("unroll") for(int r=0;r<16;++r)P0[r]=__builtin_amdgcn_exp2f(P0[r]); }while(0)
  #define RESC() do{ if(resc){ asm volatile("s_waitcnt lgkmcnt(0)":::"memory"); \
      _Pragma("unroll") for(int d_=0;d_<2;++d_) _Pragma("unroll") for(int r=0;r<16;++r)o[d_][r]*=wsf[crow(r,hi)]; } }while(0)
  f32x16 pA0,pA1,pB0,pB1;
  int sl_prev=0,sl_cur=0,sl_next=SLOTB;
  #define ROT() do{sl_prev=sl_cur;sl_cur=sl_next;sl_next=(sl_next==(NSLOT-1)*SLOTB)?0:sl_next+SLOTB;}while(0)
  DMA_K(2,2*SLOTB);
  WAIT_BAR(3);
  qkt(pA0,pA1,Kbase,qr,negm,r32,hi);asm volatile("s_nop 15\n\ts_nop 7":"+v"(pA0),"+v"(pA1));CMASK(pA0,pA1,0);
  START(pA0,pA1);
  _Pragma("unroll") for(int r=0;r<16;++r)pA1[r]=__builtin_amdgcn_exp2f(pA1[r]);
  WAIT_BAR(0);
  DMA_K(3,0);DMA_V(1,SLOTB);
  ROT();
  kload8(kf,kp0+sl_cur);
  WAIT_BAR(2);
  s16x4 vlo[8],vhi[8]; u32x4 pw0,pw1,pw2,pw3;
  #define PKW(P,B) cvtpk_s(P[B],P[B+1])
  #define PAF(k) __builtin_bit_cast(bf16x8,pw##k)
  #define VFR(i) (bf16x8){vlo[i][0],vlo[i][1],vlo[i][2],vlo[i][3],vhi[i][0],vhi[i][1],vhi[i][2],vhi[i][3]}
  #define PIN(x) asm volatile("":"+v"(x))
  #define MX3(a,b,c) __builtin_fmaxf(__builtin_fmaxf((a),(b)),(c))
  #define GAPA(MF,A0,A1,A2,A3,W0,W1,PW) do{ MF; sacc+=A0; sacc+=A1; sacc+=A2; sacc+=A3; PIN(sacc); W0; W1; PIN(PW); SBAR(); }while(0)
  #define EX(v) __builtin_amdgcn_exp2f(v)
  #define GAPB(MF,X,B) do{ MF; X[B]=EX(X[B]); X[B+1]=EX(X[B+1]); X[B+2]=EX(X[B+2]); X[B+3]=EX(X[B+3]); PIN(X); SBAR(); }while(0)
  #define VRD(i) do{ vlo[i]=vtr(vp_+(((i)>>2)*4096+((i)&3)*1024)); vhi[i]=vtr(vp_+(((i)>>2)*4096+((i)&3)*1024+512)); }while(0)
  #define KRD(G,j) do{ if(G){ kload2(kf,kp0+sl_next,j); SBAR(); } }while(0)
  #define STEP(C0,C1,P0,P1,t,GK,GV,GL) do{ SBAR(); \
    const lds_cptr vp_=vp0+sl_prev; \
    VRD(0); SBAR(); float sacc=(P0[0]+P0[1]); \
    GAPA(C0=__builtin_amdgcn_mfma_f32_32x32x16_bf16(kf[0],qr[0],negm,0,0,0), P0[2],P0[3],P0[4],P0[5],     pw0[0]=PKW(P0,0), pw0[1]=PKW(P0,2), pw0); \
    VRD(4); SBAR(); GAPA(C1=__builtin_amdgcn_mfma_f32_32x32x16_bf16(kf[1],qr[0],negm,0,0,0), P0[6],P0[7],P0[8],P0[9],     pw0[2]=PKW(P0,4), pw0[3]=PKW(P0,6), pw0); \
    VRD(1); SBAR(); GAPA(C0=__builtin_amdgcn_mfma_f32_32x32x16_bf16(kf[2],qr[1],C0,0,0,0),   P0[10],P0[11],P0[12],P0[13], pw1[0]=PKW(P0,8), pw1[1]=PKW(P0,10), pw1); \
    VRD(5); SBAR(); GAPA(C1=__builtin_amdgcn_mfma_f32_32x32x16_bf16(kf[3],qr[1],C1,0,0,0),   P0[14],P0[15],P1[0],P1[1],   pw1[2]=PKW(P0,12),pw1[3]=PKW(P0,14), pw1); \
    VRD(2); SBAR(); GAPA(C0=__builtin_amdgcn_mfma_f32_32x32x16_bf16(kf[4],qr[2],C0,0,0,0),   P1[2],P1[3],P1[4],P1[5],     pw2[0]=PKW(P1,0), pw2[1]=PKW(P1,2), pw2); \
    VRD(6); SBAR(); GAPA(C1=__builtin_amdgcn_mfma_f32_32x32x16_bf16(kf[5],qr[2],C1,0,0,0),   P1[6],P1[7],P1[8],P1[9],     pw2[2]=PKW(P1,4), pw2[3]=PKW(P1,6), pw2); \
    VRD(3); SBAR(); GAPA(C0=__builtin_amdgcn_mfma_f32_32x32x16_bf16(kf[6],qr[3],C0,0,0,0),   P1[10],P1[11],P1[12],P1[13], pw3[0]=PKW(P1,8), pw3[1]=PKW(P1,10), pw3); \
    VRD(7); SBAR(); GAPA(C1=__builtin_amdgcn_mfma_f32_32x32x16_bf16(kf[7],qr[3],C1,0,0,0),   P1[14],P1[15],0.f,0.f,       pw3[2]=PKW(P1,12),pw3[3]=PKW(P1,14), pw3); \
    l_reg+=sacc; \
    if(GK){DMA_K((t)+3,sl_cur);} if(GV){DMA_V((t)+1,sl_next);} \
    CMASK(C0,C1,t); \
    { float a=MX3(C0[0],C0[1],C1[0]),b=MX3(C0[2],C0[3],C1[1]); a=MX3(a,C1[2],C1[3]); \
      _Pragma("unroll") for(int r=4;r<16;r+=4){a=MX3(a,C0[r],C0[r+1]);b=MX3(b,C0[r+2],C0[r+3]);a=MX3(a,C1[r],C1[r+1]);b=MX3(b,C1[r+2],C1[r+3]);} \
      float rm=__builtin_fmaxf(a,b); { auto rr=__builtin_amdgcn_permlane32_swap(__float_as_uint(rm),__float_as_uint(rm),false,false); rm=__builtin_fmaxf(__uint_as_float(rr[0]),__uint_as_float(rr[1])); } \
      resc=false; \
      if(__builtin_expect(__any(rm>(float)THRL),0)){ const float dl=__builtin_fmaxf(rm,0.f); mhat+=dl; \
        _Pragma("unroll") for(int r=0;r<16;++r){C0[r]-=dl;C1[r]-=dl;} \
        _Pragma("unroll") for(int r=0;r<16;++r)negm[r]=-mhat; asm volatile("":"+v"(negm)); \
        const float f=__builtin_amdgcn_exp2f(-dl); l_reg*=f; if(hi==0)wsf[r32]=f; resc=true; } } \
    SBAR(); \
    GAPB(o[0]=__builtin_amdgcn_mfma_f32_32x32x16_bf16(PAF(0),VFR(0),o[0],0,0,0), C0,0); \
    GAPB(o[1]=__builtin_amdgcn_mfma_f32_32x32x16_bf16(PAF(0),VFR(4),o[1],0,0,0), C0,4); \
    KRD(GL,0); GAPB(o[0]=__builtin_amdgcn_mfma_f32_32x32x16_bf16(PAF(1),VFR(1),o[0],0,0,0), C0,8); \
    KRD(GL,1); GAPB(o[1]=__builtin_amdgcn_mfma_f32_32x32x16_bf16(PAF(1),VFR(5),o[1],0,0,0), C0,12); \
    KRD(GL,2); GAPB(o[0]=__builtin_amdgcn_mfma_f32_32x32x16_bf16(PAF(2),VFR(2),o[0],0,0,0), C1,0); \
    KRD(GL,3); GAPB(o[1]=__builtin_amdgcn_mfma_f32_32x32x16_bf16(PAF(2),VFR(6),o[1],0,0,0), C1,4); \
    GAPB(o[0]=__builtin_amdgcn_mfma_f32_32x32x16_bf16(PAF(3),VFR(3),o[0],0,0,0), C1,8); \
    GAPB(o[1]=__builtin_amdgcn_mfma_f32_32x32x16_bf16(PAF(3),VFR(7),o[1],0,0,0), C1,12); \
    }while(0)
  int t=1;
  #undef CMASK
  #define CMASK(P0,P1,t) do{}while(0)
  for(;t+5<NT;t+=2){
    STEP(pB0,pB1,pA0,pA1,t,true,true,true);     WAIT_BAR(2); RESC(); ROT();
    STEP(pA0,pA1,pB0,pB1,t+1,true,true,true);   WAIT_BAR(2); RESC(); ROT();
  }
  #undef CMASK
  #define CMASK(P0,P1,t) do{}while(0)
  #define ENDW(tt) do{ if((tt)+3<NT){WAIT_BAR(2);} else if((tt)+2<NT){WAIT_BAR(1);} else {WAIT_BAR(0);} }while(0)
  for(;t+1<NT;t+=2){
    STEP(pB0,pB1,pA0,pA1,t,(t+3<NT),(t+1<NT),(t+1<NT));       ENDW(t);   RESC(); ROT();
    STEP(pA0,pA1,pB0,pB1,t+1,(t+4<NT),(t+2<NT),(t+2<NT));     ENDW(t+1); RESC(); ROT();
  }
  STEP(pB0,pB1,pA0,pA1,NT-1,false,false,false); RESC();
  { float sacc=pB0[0]+pB0[1]; _Pragma("unroll") for(int r=2;r<16;++r)sacc+=pB0[r]; _Pragma("unroll") for(int r=0;r<16;++r)sacc+=pB1[r]; l_reg+=sacc;
    pw0=(u32x4){PKW(pB0,0),PKW(pB0,2),PKW(pB0,4),PKW(pB0,6)};pw1=(u32x4){PKW(pB0,8),PKW(pB0,10),PKW(pB0,12),PKW(pB0,14)};pw2=(u32x4){PKW(pB1,0),PKW(pB1,2),PKW(pB1,4),PKW(pB1,6)};pw3=(u32x4){PKW(pB1,8),PKW(pB1,10),PKW(pB1,12),PKW(pB1,14)};
    SBAR(); pv(o,vb0+sl_cur,PAF(0),PAF(1),PAF(2),PAF(3)); }
  #undef PKW
  #undef PAF
  #undef VFR
  #undef PIN
  #undef MX3
  #undef GAPA
  #undef GAPB
  #undef EX
  #undef VRD
  #undef KRD
  #undef STEP
  #undef ENDW
  {auto rr=__builtin_amdgcn_permlane32_swap(__float_as_uint(l_reg),__float_as_uint(l_reg),false,false);l_reg=__uint_as_float(rr[0])+__uint_as_float(rr[1]);}
  if(hi==0)wsf[32+r32]=1.f/l_reg;
  { LAS float*ost=(LAS float*)(ldsp+LDS_OST)+wid*2048;
    #pragma unroll
    for(int r=0;r<16;++r){const int orow=crow(r,hi); const float a1=wsf[32+orow]; ost[orow*64+r32]=o[0][r]*a1; ost[orow*64+32+r32]=o[1][r]*a1;}
    asm volatile("s_waitcnt lgkmcnt(0)":::"memory");
    #pragma unroll
    for(int i=0;i<4;++i){const int row=i*8+(lane>>3),ch=lane&7;
      const f32x4 x0=*(const LAS f32x4*)(ost+row*64+ch*8),x1=*(const LAS f32x4*)(ost+row*64+ch*8+4);
      const u32x4 gt=*(const u32x4*)(Gw0+(long)(wid*QBLK+row)*DM+ch*8);
      const float v[8]={x0[0],x0[1],x0[2],x0[3],x1[0],x1[1],x1[2],x1[3]};
      u32x4 w;
      #pragma unroll
      for(int e=0;e<4;++e){const float ga=__uint_as_float(gt[e]<<16),gb=__uint_as_float(gt[e]&0xffff0000u); w[e]=cvtpk_s(v[2*e]*ga,v[2*e+1]*gb);}
      *(u32x4*)(Yw0+(long)(wid*QBLK+row)*D+ch*8)=w;} }
  asm volatile("s_waitcnt lgkmcnt(0)\n\ts_barrier":::"memory");
  #undef DMA_K
  #undef DMA_V
  #undef CMASK
  #undef START
  #undef RESC
  #undef ROT
}
#undef SBAR
#undef WAIT_BAR
}
namespace att {
typedef short bf16x8 __attribute__((ext_vector_type(8)));
typedef short s16x4 __attribute__((ext_vector_type(4)));
typedef float f32x16 __attribute__((ext_vector_type(16)));
typedef float f32x2_t __attribute__((ext_vector_type(2)));
typedef __bf16 bf16x2_t __attribute__((ext_vector_type(2)));
constexpr int SLOT = 16384, L_RING = 0, L_OST = 49152, L_WSF = L_OST + 8 * 8192, L_RPB = L_WSF + 8 * 256, L_END = L_RPB + 2048;
constexpr float THR = 6.f;
#define ATT_MFMA(a, b, c) __builtin_amdgcn_mfma_f32_32x32x16_bf16(a, b, c, 0, 0, 0)
#define ATT_WAIT_BAR(N) asm volatile("s_waitcnt vmcnt(" #N ") lgkmcnt(0)\n\ts_barrier" ::: "memory")
__device__ __forceinline__ int crow(int r, int hi) { return (r & 3) + 8 * (r >> 2) + 4 * hi; }
__device__ __forceinline__ unsigned cvtpk(float lo, float hi) { f32x2_t v = {lo, hi}; bf16x2_t b = __builtin_convertvector(v, bf16x2_t); return __builtin_bit_cast(unsigned, b); }
__device__ __forceinline__ void glds16(const void* g, unsigned lds_base) {
    unsigned sv; asm volatile("s_mov_b32 %0, m0\n\ts_mov_b32 m0, %2\n\ts_nop 0\n\tglobal_load_lds_dwordx4 %1, off\n\ts_mov_b32 m0, %0" : "=&s"(sv) : "v"(g), "s"(lds_base) : "memory"); }
#define ATT_MX3(a, b, c) __builtin_fmaxf(__builtin_fmaxf((a), (b)), (c))
__device__ __forceinline__ float rowmax(const f32x16& p0, const f32x16& p1) {
    float a = ATT_MX3(p0[0], p0[1], p1[0]), b = ATT_MX3(p0[2], p0[3], p1[1]); a = ATT_MX3(a, p1[2], p1[3]);
#pragma unroll
    for (int r = 4; r < 16; r += 4) { a = ATT_MX3(a, p0[r], p0[r + 1]); b = ATT_MX3(b, p0[r + 2], p0[r + 3]); a = ATT_MX3(a, p1[r], p1[r + 1]); b = ATT_MX3(b, p1[r + 2], p1[r + 3]); }
    float m = __builtin_fmaxf(a, b); auto rr = __builtin_amdgcn_permlane32_swap(__float_as_uint(m), __float_as_uint(m), false, false);
    return __builtin_fmaxf(__uint_as_float(rr[0]), __uint_as_float(rr[1])); }
__device__ __forceinline__ float rowsum(const f32x16& p0, const f32x16& p1) {
    float a = 0.f, b = 0.f;
#pragma unroll
    for (int r = 0; r < 16; r += 2) { a += p0[r] + p1[r]; b += p0[r + 1] + p1[r + 1]; }
    return a + b; }
__device__ __forceinline__ void vfrags(bf16x8 (&vf)[4], int vb, int d0) {
    s16x4 lo[4], hi[4];
    if (d0 == 0) {
#pragma unroll
        for (int ks = 0; ks < 4; ++ks) {
            asm volatile("ds_read_b64_tr_b16 %0,%1 offset:%c2" : "=&v"(lo[ks]) : "v"(vb), "i"(ks * 1024) : "memory");
            asm volatile("ds_read_b64_tr_b16 %0,%1 offset:%c2" : "=&v"(hi[ks]) : "v"(vb), "i"(ks * 1024 + 512) : "memory"); }
    } else {
#pragma unroll
        for (int ks = 0; ks < 4; ++ks) {
            asm volatile("ds_read_b64_tr_b16 %0,%1 offset:%c2" : "=&v"(lo[ks]) : "v"(vb), "i"(4096 + ks * 1024) : "memory");
            asm volatile("ds_read_b64_tr_b16 %0,%1 offset:%c2" : "=&v"(hi[ks]) : "v"(vb), "i"(4096 + ks * 1024 + 512) : "memory"); }
    }
    asm volatile("s_waitcnt lgkmcnt(0)" : "+v"(lo[0]), "+v"(lo[1]), "+v"(lo[2]), "+v"(lo[3]), "+v"(hi[0]), "+v"(hi[1]), "+v"(hi[2]), "+v"(hi[3]) :: "memory");
#pragma unroll
    for (int ks = 0; ks < 4; ++ks) vf[ks] = (bf16x8){lo[ks][0], lo[ks][1], lo[ks][2], lo[ks][3], hi[ks][0], hi[ks][1], hi[ks][2], hi[ks][3]};
}
struct PW { u32x4 w[4]; };
__device__ __forceinline__ void packp(PW& pw, const f32x16& p0, const f32x16& p1) {
#pragma unroll
    for (int i = 0; i < 4; ++i) { pw.w[0][i] = cvtpk(p0[2 * i], p0[2 * i + 1]); pw.w[1][i] = cvtpk(p0[8 + 2 * i], p0[9 + 2 * i]); pw.w[2][i] = cvtpk(p1[2 * i], p1[2 * i + 1]); pw.w[3][i] = cvtpk(p1[8 + 2 * i], p1[9 + 2 * i]); }
}
__device__ __forceinline__ bool softmax_tile(f32x16& p0, f32x16& p1, float& mhat, float& l_reg, float& f, bool first) {
    const float rm = rowmax(p0, p1);
    bool resc = false; f = 1.f;
    if (first || __any(rm > THR)) {
        const float dl = first ? rm : __builtin_fmaxf(rm, 0.f); mhat += dl;
#pragma unroll
        for (int r = 0; r < 16; ++r) { p0[r] -= dl; p1[r] -= dl; }
        if (!first) { f = __builtin_amdgcn_exp2f(-dl); l_reg *= f; resc = true; }
    }
#pragma unroll
    for (int r = 0; r < 16; ++r) { p0[r] = __builtin_amdgcn_exp2f(p0[r]); p1[r] = __builtin_amdgcn_exp2f(p1[r]); }
    l_reg += rowsum(p0, p1);
    return resc;
}
struct UnitDesc { int var, b, h, kvh, qrow0, f0, n0, f1, n1; };
struct LayerConst { int l; float lam, one_m_lam_init; };

template <int VAR> __device__ __forceinline__ void attn_unit(const Params& p, const UnitDesc& u, const LayerConst& lc, LAS unsigned char* lds, int tid_in) {
    const int tid = opaque_v(tid_in), lane = tid & 63, r32 = lane & 31, hi = lane >> 5; const int wid = __builtin_amdgcn_readfirstlane(tid >> 6);
    constexpr int QOFF = VAR == 0 ? AQ : VAR == 1 ? BQ : CQ, KOFF = VAR == 0 ? AK : VAR == 1 ? BK : CK, VOFF = VAR == 0 ? AV : VAR == 1 ? BV : CV, GOFF = VAR == 0 ? AG : VAR == 1 ? BG : CG, YOFF = VAR * 256;
    const size_t rowb = (size_t)u.b * T;
    const unsigned lds0 = (unsigned)(uintptr_t)lds;
    LAS float* wsf = (LAS float*)(lds + L_WSF) + wid * 64;
    LAS float* ost = (LAS float*)(lds + L_OST) + wid * 2048;
    LAS float* rpbL = (LAS float*)(lds + L_RPB);
    const int NT = u.n0 + u.n1;
    const bf16_t* kbase = p.P + (rowb + lane) * NP + KOFF + u.kvh * 64 + wid * 8;
    const bf16_t* vbase = p.P + (rowb + 16 * (wid & 3) + (lane >> 2)) * NP + VOFF + u.kvh * 64 + (wid >> 2) * 32 + (lane & 3) * 8;
#define ATT_TROW(j) (((j) < u.n0 ? u.f0 + (j) : u.f1 + ((j) - u.n0)) * 64)
#define ATT_DMA(j, slot) do { const size_t ro_ = (size_t)ATT_TROW(j) * NP; \
        glds16(kbase + ro_, (unsigned)__builtin_amdgcn_readfirstlane(lds0 + L_RING + (slot) * SLOT + wid * 1024)); \
        glds16(vbase + ro_, (unsigned)__builtin_amdgcn_readfirstlane(lds0 + L_RING + (slot) * SLOT + 8192 + wid * 1024)); } while (0)
    ATT_DMA(0, 0);
    if (NT > 1) ATT_DMA(1, 1);
    if (VAR == 2) { for (int i = tid; i < 15 * 31; i += NTHR) rpbL[i] = p.rpb[((size_t)lc.l * 4 + u.h) * 15 * 31 + i] * LOG2E; }
    const bf16_t* qp = p.P + (rowb + u.qrow0 + wid * 32 + r32) * NP + QOFF + u.h * 64 + hi * 8;
    bf16x8 qr[4];
#pragma unroll
    for (int d0 = 0; d0 < 4; ++d0) qr[d0] = *(const bf16x8*)(qp + d0 * 16);
    const int qt = u.qrow0 + wid * 32 + r32; const int gr = qt >> 6, gwc = qt & 63;
    const int rs0 = min(max(gr - 4, 0), 56), cs0 = min(max(gwc - 8, 0), 48);
    const bool latq = u.qrow0 < S;
    f32x16 o[2], o2[2]; o[0] = f32x16{}; o[1] = f32x16{}; o2[0] = f32x16{}; o2[1] = f32x16{};
    float mhat = 0.f, l_reg = 0.f, mhat2 = 0.f, l_reg2 = 0.f;
    f32x16 negm = f32x16{}, negm2 = f32x16{};
    bool started = false;
    for (int j = 0; j < NT; ++j) {
        if (j + 1 < NT) ATT_WAIT_BAR(2); else ATT_WAIT_BAR(0);
        if (j + 2 < NT) { const int s2 = (j + 2) % 3; ATT_DMA(j + 2, s2); }
        const int sl = (j % 3) * SLOT;
        const int trow = ATT_TROW(j);
        bool active = true; const bool wintile = (VAR == 2) && latq && trow < S;
        if (wintile) { const int kr = trow >> 6; active = (kr >= rs0) && (kr < rs0 + 8); }
        if (!active) continue;
        const LAS unsigned char* kp = lds + L_RING + sl + hi * 1024 + r32 * 16;
        const int vb = (int)(lds0 + L_RING + sl + 8192) + ((lane >> 4) & 1) * 32 + (lane & 3) * 8 + (4 * hi + ((lane & 15) >> 2)) * 64;
        if (VAR != 1) {
            f32x16 p0, p1;
#pragma unroll
            for (int d0 = 0; d0 < 4; ++d0) {
                const bf16x8 b0 = *(const LAS bf16x8*)(kp + d0 * 2048), b1 = *(const LAS bf16x8*)(kp + d0 * 2048 + 512);
                p0 = ATT_MFMA(b0, qr[d0], d0 == 0 ? negm : p0); p1 = ATT_MFMA(b1, qr[d0], d0 == 0 ? negm : p1);
            }
            if (wintile) {
                const int kr = trow >> 6; const LAS float* brow = rpbL + (kr - gr + 7) * 31 + 15 - gwc;
#pragma unroll
                for (int r = 0; r < 16; ++r) {
                    const int kc = crow(r, hi);
                    p0[r] = ((unsigned)(kc - cs0) < 16u) ? p0[r] + brow[kc] : -INFINITY;
                    p1[r] = ((unsigned)(kc + 32 - cs0) < 16u) ? p1[r] + brow[kc + 32] : -INFINITY;
                }
            }
            float f; const bool resc = softmax_tile(p0, p1, mhat, l_reg, f, !started);
            if (resc || !started) {
#pragma unroll
                for (int r = 0; r < 16; ++r) negm[r] = -mhat;
            }
            if (resc) {
                if (hi == 0) wsf[r32] = f;
#pragma unroll
                for (int d_ = 0; d_ < 2; ++d_)
#pragma unroll
                    for (int r = 0; r < 16; ++r) o[d_][r] *= wsf[crow(r, hi)];
            }
            started = true;
            PW pw; packp(pw, p0, p1);
#pragma unroll
            for (int d0 = 0; d0 < 2; ++d0) {
                bf16x8 vf[4]; vfrags(vf, vb, d0);
#pragma unroll
                for (int ks = 0; ks < 4; ++ks) o[d0] = ATT_MFMA(__builtin_bit_cast(bf16x8, pw.w[ks]), vf[ks], o[d0]);
            }
        } else {
            PW pw, pw2; float f = 1.f, f2 = 1.f; bool resc = false;
            {
                f32x16 p0 = f32x16{}, p1 = f32x16{};
#pragma unroll
                for (int d0 = 0; d0 < 2; ++d0) {
                    const bf16x8 b0 = *(const LAS bf16x8*)(kp + d0 * 2048), b1 = *(const LAS bf16x8*)(kp + d0 * 2048 + 512);
                    p0 = ATT_MFMA(b0, qr[d0], p0); p1 = ATT_MFMA(b1, qr[d0], p1);
                }
                const float rm = rowmax(p0, p1);
                if (!started) mhat = rm;
                else if (__any(rm - mhat > THR)) { const float mn = __builtin_fmaxf(mhat, rm); f = __builtin_amdgcn_exp2f(mhat - mn); mhat = mn; l_reg *= f; resc = true; }
#pragma unroll
                for (int r = 0; r < 16; ++r) { p0[r] = __builtin_amdgcn_exp2f(p0[r] - mhat); p1[r] = __builtin_amdgcn_exp2f(p1[r] - mhat); }
                l_reg += rowsum(p0, p1);
                packp(pw, p0, p1);
            }
            {
                f32x16 q0 = f32x16{}, q1 = f32x16{};
#pragma unroll
                for (int d0 = 2; d0 < 4; ++d0) {
                    const bf16x8 b0 = *(const LAS bf16x8*)(kp + d0 * 2048), b1 = *(const LAS bf16x8*)(kp + d0 * 2048 + 512);
                    q0 = ATT_MFMA(b0, qr[d0], q0); q1 = ATT_MFMA(b1, qr[d0], q1);
                }
                const float rm = rowmax(q0, q1);
                if (!started) mhat2 = rm;
                else if (__any(rm - mhat2 > THR)) { const float mn = __builtin_fmaxf(mhat2, rm); f2 = __builtin_amdgcn_exp2f(mhat2 - mn); mhat2 = mn; l_reg2 *= f2; resc = true; }
#pragma unroll
                for (int r = 0; r < 16; ++r) { q0[r] = __builtin_amdgcn_exp2f(q0[r] - mhat2); q1[r] = __builtin_amdgcn_exp2f(q1[r] - mhat2); }
                l_reg2 += rowsum(q0, q1);
                packp(pw2, q0, q1);
            }
            if (resc) {
                if (hi == 0) { wsf[r32] = f; wsf[32 + r32] = f2; }
#pragma unroll
                for (int d_ = 0; d_ < 2; ++d_)
#pragma unroll
                    for (int r = 0; r < 16; ++r) { o[d_][r] *= wsf[crow(r, hi)]; o2[d_][r] *= wsf[32 + crow(r, hi)]; }
            }
            started = true;
#pragma unroll
            for (int d0 = 0; d0 < 2; ++d0) {
                bf16x8 vf[4]; vfrags(vf, vb, d0);
#pragma unroll
                for (int ks = 0; ks < 4; ++ks) { o[d0] = ATT_MFMA(__builtin_bit_cast(bf16x8, pw.w[ks]), vf[ks], o[d0]); o2[d0] = ATT_MFMA(__builtin_bit_cast(bf16x8, pw2.w[ks]), vf[ks], o2[d0]); }
            }
        }
    }
    { auto rr = __builtin_amdgcn_permlane32_swap(__float_as_uint(l_reg), __float_as_uint(l_reg), false, false); l_reg = __uint_as_float(rr[0]) + __uint_as_float(rr[1]); }
    if (VAR == 1) { auto rr = __builtin_amdgcn_permlane32_swap(__float_as_uint(l_reg2), __float_as_uint(l_reg2), false, false); l_reg2 = __uint_as_float(rr[0]) + __uint_as_float(rr[1]); }
    if (hi == 0) { wsf[r32] = 1.f / l_reg; if (VAR == 1) wsf[32 + r32] = lc.lam / l_reg2; }
#pragma unroll
    for (int r = 0; r < 16; ++r) {
        const int orow = crow(r, hi); const float a1 = wsf[orow];
        if (VAR == 1) { const float a2 = wsf[32 + orow]; ost[orow * 64 + r32] = o[0][r] * a1 - o2[0][r] * a2; ost[orow * 64 + 32 + r32] = o[1][r] * a1 - o2[1][r] * a2; }
        else { ost[orow * 64 + r32] = o[0][r] * a1; ost[orow * 64 + 32 + r32] = o[1][r] * a1; }
    }
    asm volatile("s_waitcnt lgkmcnt(0)" ::: "memory");
    const size_t mrow0 = rowb + u.qrow0 + wid * 32;
#pragma unroll
    for (int i = 0; i < 4; ++i) {
        const int row = i * 8 + (lane >> 3), ch = lane & 7;
        const f32x4 x0 = *(const LAS f32x4*)(ost + row * 64 + ch * 8), x1 = *(const LAS f32x4*)(ost + row * 64 + ch * 8 + 4);
        float v[8] = {x0[0], x0[1], x0[2], x0[3], x1[0], x1[1], x1[2], x1[3]};
        if (VAR == 1) {
            float ss = 0.f;
#pragma unroll
            for (int e = 0; e < 8; ++e) ss += v[e] * v[e];
            ss += __shfl_xor(ss, 1); ss += __shfl_xor(ss, 2); ss += __shfl_xor(ss, 4);
            const float rs = rsqrtf(ss * (1.f / 64.f) + RMS_EPS) * lc.one_m_lam_init;
            const f32x4 g0 = *(const f32x4*)(p.subln_g + lc.l * 64 + ch * 8), g1 = *(const f32x4*)(p.subln_g + lc.l * 64 + ch * 8 + 4);
            const float gg[8] = {g0[0], g0[1], g0[2], g0[3], g1[0], g1[1], g1[2], g1[3]};
#pragma unroll
            for (int e = 0; e < 8; ++e) v[e] *= rs * gg[e];
        }
        const u32x4 gt = *(const u32x4*)(p.P + (mrow0 + row) * NP + GOFF + u.h * 64 + ch * 8);
        u32x4 w;
#pragma unroll
        for (int e = 0; e < 4; ++e) { const float ga = __uint_as_float(gt[e] << 16), gb = __uint_as_float(gt[e] & 0xffff0000u); w[e] = cvtpk(v[2 * e] * ga, v[2 * e + 1] * gb); }
        *(u32x4*)(p.A + (mrow0 + row) * D + YOFF + u.h * 64 + ch * 8) = w;
    }
    asm volatile("s_waitcnt lgkmcnt(0)\n\ts_barrier" ::: "memory");
#undef ATT_TROW
#undef ATT_DMA
}

__device__ __forceinline__ LayerConst make_lc(const Params& p, int l) {
    const float lam_init = 0.8f - 0.6f * __expf(-0.3f * (float)l);
    return LayerConst{l, p.lamv[l], 1.f - lam_init};
}
__device__ __forceinline__ void unit_a(const Params& p, const LayerConst& lc, int uidx, LAS unsigned char* lds, int tid_in) {
    const int b = uidx >> 6, kvh = (uidx >> 5) & 1, h = kvh * 2 + ((uidx >> 4) & 1), qb = uidx & 15; const size_t r0 = (size_t)b * T, rq = r0 + qb * 256;
    att2::attn_unit<8>(p.P + rq * NP + AQ + h * 64, p.P + r0 * NP + AK + kvh * 64, p.P + r0 * NP + AV + kvh * 64, 68, p.P + rq * NP + AG + h * 64, p.A + rq * D + h * 64, lds, tid_in);
}
__device__ __forceinline__ void unit_b(const Params& p, const LayerConst& lc, int uidx, LAS unsigned char* lds, int tid_in) {
    UnitDesc u; u.var = 1; u.b = uidx >> 6; u.h = (uidx >> 4) & 3; u.kvh = u.h; u.qrow0 = (uidx & 15) * 256; u.f0 = 0; u.n0 = 68; u.f1 = 0; u.n1 = 0; attn_unit<1>(p, u, lc, lds, tid_in); }
__device__ __forceinline__ void unit_c(const Params& p, const LayerConst& lc, int uidx, LAS unsigned char* lds, int tid_in) {
    UnitDesc u; u.var = 2; u.b = uidx >> 6; u.h = (uidx >> 4) & 3; u.kvh = u.h; const int qb = uidx & 15; u.qrow0 = qb * 256;
    const int ra = min(max(4 * qb - 4, 0), 56), rb = min(max(4 * qb + 3 - 4, 0), 56) + 8; u.f0 = 64; u.n0 = 4; u.f1 = ra; u.n1 = rb - ra; attn_unit<2>(p, u, lc, lds, tid_in); }
__device__ __forceinline__ void unit_ctx(const Params& p, const LayerConst& lc, int uidx, LAS unsigned char* lds, int tid_in) {
    const int var = uidx >> 4, b = (uidx >> 2) & 3, h = uidx & 3;
    UnitDesc u; u.var = var; u.b = b; u.h = h; u.kvh = var == 0 ? (h >> 1) : h; u.qrow0 = S; u.f0 = 64; u.n0 = 4; u.f1 = 0; u.n1 = 0;
    if (var == 0) { const size_t rq = (size_t)b * T + S; att2::attn_unit<8>(p.P + rq * NP + AQ + h * 64, p.P + rq * NP + AK + (h >> 1) * 64, p.P + rq * NP + AV + (h >> 1) * 64, 4, p.P + rq * NP + AG + h * 64, p.A + rq * D + h * 64, lds, tid_in); }
    else if (var == 1) attn_unit<1>(p, u, lc, lds, tid_in); else attn_unit<2>(p, u, lc, lds, tid_in);
}
}
namespace s5m {
typedef short bf16x8 __attribute__((ext_vector_type(8)));
constexpr int NCK = T / 16;
constexpr int TT_SZ = 31 * 256, E_SZ = 2 * 128 * 256, F_SZ = 2 * 256 * 128;
#define S5_MFMA(a, b, c) __builtin_amdgcn_mfma_f32_16x16x32_bf16(a, b, c, 0, 0, 0)
__device__ __forceinline__ void build_a(const Params& p, int gw, int ngw, int lane) {
    for (int it = gw * 64 + lane; it < NL * 2 * 16 * 64; it += ngw * 64) {
        const size_t ip = (size_t)it; const int ig = it >> 6;
        float* dsc = p.disc + ip * 34;
        const double ar = p.a_re[ip], ai = p.a_im[ip], dt = exp((double)p.log_dt[ig]);
        const double e = exp(ar * dt), lr = e * cos(ai * dt), li = e * sin(ai * dt);
        const double nr = lr - 1.0, ni = li, den = ar * ar + ai * ai; const double cr = (nr * ar + ni * ai) / den, ci = (ni * ar - nr * ai) / den;
        dsc[0] = (float)lr; dsc[1] = (float)li;
        for (int c = 0; c < 16; ++c) { const double br = p.b_re[ip * 16 + c], bi = p.b_im[ip * 16 + c]; dsc[2 + c] = (float)(cr * br - ci * bi); dsc[18 + c] = (float)(cr * bi + ci * br); }
        double pr = 1.0, pi = 0.0; float* lp = p.lampow + ((size_t)ig * 17 * 64 + (it & 63)) * 2;
        for (int k = 0; k <= 16; ++k) { lp[(size_t)k * 128] = (float)pr; lp[(size_t)k * 128 + 1] = (float)pi; if (k < 16) { const double tr = pr * lr - pi * li, ti = pr * li + pi * lr; pr = tr; pi = ti; } }
        const double a_r = pr, a_i = pi; double qr = pr, qi = pi; float* ap = p.apow + ip * 32;
        for (int j = 1; j <= 16; ++j) { ap[2 * (j - 1)] = (float)qr; ap[2 * (j - 1) + 1] = (float)qi; const double tr = qr * a_r - qi * a_i, ti = qr * a_i + qi * a_r; qr = tr; qi = ti; }
    }
}
__device__ __forceinline__ void build_b(const Params& p, int gw, int ngw, int lane) {
    constexpr int NE = NL * 16 * 2 * 128 * 32;
    for (int it = gw * 64 + lane; it < NE; it += ngw * 64) {
        {
            const int half = it & 1, s = (it >> 1) & 15, row = (it >> 5) & 127, dir = (it >> 12) & 1, lg = it >> 13, g = lg & 15, l = lg >> 4;
            const int part = row & 1, st = row >> 1; const size_t ig = (size_t)((l * 2 + dir) * 16 + g), ip = ig * 64 + st;
            const int k = dir == 0 ? 15 - s : s; const float wr = p.lampow[((ig * 17 + k) * 64 + st) * 2], wi = p.lampow[((ig * 17 + k) * 64 + st) * 2 + 1];
            const f32x4 b0 = *(const f32x4*)(p.disc + ip * 34 + 2 + half * 8), b1 = *(const f32x4*)(p.disc + ip * 34 + 2 + half * 8 + 4), c0 = *(const f32x4*)(p.disc + ip * 34 + 18 + half * 8), c1 = *(const f32x4*)(p.disc + ip * 34 + 18 + half * 8 + 4);
            const float br[8] = {b0[0], b0[1], b0[2], b0[3], b1[0], b1[1], b1[2], b1[3]}, bi[8] = {c0[0], c0[1], c0[2], c0[3], c1[0], c1[1], c1[2], c1[3]};
            float v[8];
#pragma unroll
            for (int c = 0; c < 8; ++c) v[c] = part == 0 ? wr * br[c] - wi * bi[c] : wr * bi[c] + wi * br[c];
            u32x4 o; o.x = pk2(v[0], v[1]); o.y = pk2(v[2], v[3]); o.z = pk2(v[4], v[5]); o.w = pk2(v[6], v[7]);
            *(u32x4*)(p.Etab + (size_t)it * 8) = o;
        }
        {
            const int k8 = it & 15, row = (it >> 4) & 255, dir = (it >> 12) & 1, lg = it >> 13, g = lg & 15, l = lg >> 4;
            const int st0 = k8 * 4, t = row >> 4, c = row & 15; const size_t ig = (size_t)((l * 2 + dir) * 16 + g);
            const int k = dir == 0 ? t + 1 : 16 - t;
            const f32x4 w0 = *(const f32x4*)(p.lampow + ((ig * 17 + k) * 64 + st0) * 2), w1 = *(const f32x4*)(p.lampow + ((ig * 17 + k) * 64 + st0) * 2 + 4);
            const f32x4 cr = *(const f32x4*)(p.c_re + (ig * 16 + c) * 64 + st0), ci = *(const f32x4*)(p.c_im + (ig * 16 + c) * 64 + st0);
            const float wr[4] = {w0[0], w0[2], w1[0], w1[2]}, wi[4] = {w0[1], w0[3], w1[1], w1[3]};
            float v[8];
#pragma unroll
            for (int j = 0; j < 4; ++j) { v[2 * j] = cr[j] * wr[j] - ci[j] * wi[j]; v[2 * j + 1] = -(cr[j] * wi[j] + ci[j] * wr[j]); }
            u32x4 o; o.x = pk2(v[0], v[1]); o.y = pk2(v[2], v[3]); o.z = pk2(v[4], v[5]); o.w = pk2(v[6], v[7]);
            *(u32x4*)(p.Ftab + (size_t)it * 8) = o;
        }
    }
    for (int it = gw * 64 + lane; it < NL * 16 * 256; it += ngw * 64) {
        const int cc = it & 15, c = (it >> 4) & 15, lg = it >> 8, g = lg & 15, l = lg >> 4;
        float kf[16], kb[16];
#pragma unroll
        for (int t = 0; t < 16; ++t) { kf[t] = 0.f; kb[t] = 0.f; }
#pragma unroll
        for (int dir = 0; dir < 2; ++dir) {
            const size_t ig = (size_t)((l * 2 + dir) * 16 + g);
            const float* cre = p.c_re + (ig * 16 + c) * 64; const float* cim = p.c_im + (ig * 16 + c) * 64;
            for (int st = 0; st < 64; ++st) {
                const size_t ip = ig * 64 + st;
                const float lr = p.disc[ip * 34], li = p.disc[ip * 34 + 1], br = p.disc[ip * 34 + 2 + cc], bi = p.disc[ip * 34 + 18 + cc];
                float wr = cre[st] * br - cim[st] * bi, wi = cre[st] * bi + cim[st] * br;
#pragma unroll
                for (int t = 0; t < 16; ++t) { if (dir == 0) kf[t] += wr; else kb[t] += wr; const float nr = wr * lr - wi * li, ni = wr * li + wi * lr; wr = nr; wi = ni; }
            }
        }
        bf16_t* o = p.Ttab + (size_t)lg * TT_SZ + c * 16 + cc;
#pragma unroll
        for (int t = 1; t < 16; ++t) { o[(15 + t) * 256] = f2bf(kf[t]); o[(15 - t) * 256] = f2bf(kb[t]); }
        o[15 * 256] = f2bf(kf[0] + kb[0]);
    }
}
constexpr int L_HIN = 0, L_UT = NCK * 512, L_S5END = L_UT + 2 * 8192;
template <int CTRL> __device__ __forceinline__ float dppf(float x) { return __int_as_float(__builtin_amdgcn_update_dpp(0, __float_as_int(x), CTRL, 0xf, 0xf, true)); }
template <int CTRL> __device__ __forceinline__ void hs_stage(f32x4& X, float a0r, float a0i, float a1r, float a1i) {
    const float y0 = dppf<CTRL>(X[0]), y1 = dppf<CTRL>(X[1]), y2 = dppf<CTRL>(X[2]), y3 = dppf<CTRL>(X[3]);
    X[0] += a0r * y0 - a0i * y1; X[1] += a0r * y1 + a0i * y0; X[2] += a1r * y2 - a1i * y3; X[3] += a1r * y3 + a1i * y2;
}
template <int DIR> __device__ __forceinline__ void scan_tile(f32x4& X, f32x4& Cin, const float (&a1)[2][2], const float (&apos)[2][2], int lane, int nn) {
    constexpr int B = DIR == 0 ? 0x110 : 0x100;
    float p0r = a1[0][0], p0i = a1[0][1], p1r = a1[1][0], p1i = a1[1][1];
    hs_stage<B + 1>(X, p0r, p0i, p1r, p1i);
    { const float t0 = p0r * p0r - p0i * p0i, t1 = 2.f * p0r * p0i, t2 = p1r * p1r - p1i * p1i, t3 = 2.f * p1r * p1i; p0r = t0; p0i = t1; p1r = t2; p1i = t3; }
    hs_stage<B + 2>(X, p0r, p0i, p1r, p1i);
    { const float t0 = p0r * p0r - p0i * p0i, t1 = 2.f * p0r * p0i, t2 = p1r * p1r - p1i * p1i, t3 = 2.f * p1r * p1i; p0r = t0; p0i = t1; p1r = t2; p1i = t3; }
    hs_stage<B + 4>(X, p0r, p0i, p1r, p1i);
    { const float t0 = p0r * p0r - p0i * p0i, t1 = 2.f * p0r * p0i, t2 = p1r * p1r - p1i * p1i, t3 = 2.f * p1r * p1i; p0r = t0; p0i = t1; p1r = t2; p1i = t3; }
    hs_stage<B + 8>(X, p0r, p0i, p1r, p1i);
    f32x4 Tt;
    Tt[0] = X[0] + apos[0][0] * Cin[0] - apos[0][1] * Cin[1]; Tt[1] = X[1] + apos[0][0] * Cin[1] + apos[0][1] * Cin[0];
    Tt[2] = X[2] + apos[1][0] * Cin[2] - apos[1][1] * Cin[3]; Tt[3] = X[3] + apos[1][0] * Cin[3] + apos[1][1] * Cin[2];
    f32x4 Ex; const bool first = DIR == 0 ? nn == 0 : nn == 15;
#pragma unroll
    for (int i = 0; i < 4; ++i) { const float sh = dppf<B + 1>(Tt[i]); Ex[i] = first ? Cin[i] : sh; }
    const int src = DIR == 0 ? ((lane & 48) | 15) : (lane & 48);
#pragma unroll
    for (int i = 0; i < 4; ++i) Cin[i] = __shfl(Tt[i], src);
    X = Ex;
}
__device__ __forceinline__ void unit(const Params& p, int l, int b, int g, LAS unsigned char* lds, int tid_in) {
    const int tid = opaque_v(tid_in), lane = tid & 63, wave = __builtin_amdgcn_readfirstlane(tid >> 6), nn = lane & 15, kg = lane >> 4;
    const size_t rowb = (size_t)b * T;
    LAS unsigned char* HIN = lds + L_HIN; LAS unsigned char* UT = lds + L_UT;
    const int sj = tid >> 5, sq = tid & 31;
    const bf16_t* usrc = p.P + (rowb + sj * 16 + (sq >> 1)) * NP + DU + g * 16 + (sq & 1) * 8;
    const int udst = sj * 512 + ((sq ^ sj) * 16);
#define S5_ULOAD(cb) (*(const u32x4*)(usrc + (size_t)(cb) * 256 * NP))
#define S5_UWRITE(cb, r) (*(LAS u32x4*)(UT + ((cb) & 1) * 8192 + udst) = (r))
#define S5_UFRAG(cb, kb) (*(const LAS bf16x8*)(UT + ((cb) & 1) * 8192 + nn * 512 + ((((2 * (kb) + (kg >> 1)) * 2 + (kg & 1)) ^ nn) * 16)))
    const int kbase = 32 * wave + 4 * kg;
#define S5_SHADDR(cb, rb) (HIN + ((cb) * 16 + nn) * 512 + ((((kbase + 16 * (rb)) >> 3) ^ nn) * 16) + ((kbase + 16 * (rb)) & 7) * 2)
    {
        const bf16_t* E = p.Etab + (size_t)(l * 16 + g) * E_SZ;
        bf16x8 af[2][8];
#pragma unroll
        for (int rb = 0; rb < 2; ++rb)
#pragma unroll
            for (int kb = 0; kb < 8; ++kb) af[rb][kb] = *(const bf16x8*)(E + (size_t)(wave * 32 + rb * 16 + nn) * 256 + kb * 32 + kg * 8);
        u32x4 r1, r2;
        { const u32x4 r0 = S5_ULOAD(0); r1 = S5_ULOAD(1); S5_UWRITE(0, r0); } __syncthreads();
#pragma unroll 1
        for (int cb = 0; cb < 17; ++cb) {
            if (cb + 2 < 17) r2 = S5_ULOAD(cb + 2);
            f32x4 a0 = {0.f, 0.f, 0.f, 0.f}, a1 = {0.f, 0.f, 0.f, 0.f};
#pragma unroll
            for (int kb = 0; kb < 8; ++kb) { const bf16x8 bfr = S5_UFRAG(cb, kb); a0 = S5_MFMA(af[0][kb], bfr, a0); a1 = S5_MFMA(af[1][kb], bfr, a1); }
            { u32x2 w; w.x = pk2(a0[0], a0[1]); w.y = pk2(a0[2], a0[3]); *(LAS u32x2*)S5_SHADDR(cb, 0) = w; w.x = pk2(a1[0], a1[1]); w.y = pk2(a1[2], a1[3]); *(LAS u32x2*)S5_SHADDR(cb, 1) = w; }
            if (cb + 1 < 17) S5_UWRITE(cb + 1, r1);
            __syncthreads();
            r1 = r2;
        }
    }
    {
        const int dir = wave >> 2;
        float ap[2][2][2], apos[2][2][2];
#pragma unroll
        for (int rb = 0; rb < 2; ++rb)
#pragma unroll
            for (int j = 0; j < 2; ++j) {
                const int st = 16 * (wave & 3) + 8 * rb + 2 * kg + j; const float* t = p.apow + ((size_t)((l * 2 + dir) * 16 + g) * 64 + st) * 32;
                ap[rb][j][0] = t[0]; ap[rb][j][1] = t[1];
                const int e = dir == 0 ? nn : 15 - nn; apos[rb][j][0] = t[2 * e]; apos[rb][j][1] = t[2 * e + 1];
            }
        f32x4 C0 = {0.f, 0.f, 0.f, 0.f}, C1 = {0.f, 0.f, 0.f, 0.f};
#pragma unroll 1
        for (int i = 0; i < 17; ++i) {
            const int cb = i == 0 ? 16 : (dir == 0 ? i - 1 : 16 - i);
            LAS u32x2* q0 = (LAS u32x2*)S5_SHADDR(cb, 0); LAS u32x2* q1 = (LAS u32x2*)S5_SHADDR(cb, 1);
            const u32x2 s0 = *q0, s1 = *q1;
            f32x4 x0 = {__uint_as_float(s0.x << 16), __uint_as_float(s0.x & 0xffff0000u), __uint_as_float(s0.y << 16), __uint_as_float(s0.y & 0xffff0000u)};
            f32x4 x1 = {__uint_as_float(s1.x << 16), __uint_as_float(s1.x & 0xffff0000u), __uint_as_float(s1.y << 16), __uint_as_float(s1.y & 0xffff0000u)};
            if (dir == 0) { scan_tile<0>(x0, C0, ap[0], apos[0], lane, nn); scan_tile<0>(x1, C1, ap[1], apos[1], lane, nn); }
            else { scan_tile<1>(x0, C0, ap[0], apos[0], lane, nn); scan_tile<1>(x1, C1, ap[1], apos[1], lane, nn); }
            u32x2 w; w.x = pk2(x0[0], x0[1]); w.y = pk2(x0[2], x0[3]); *q0 = w; w.x = pk2(x1[0], x1[1]); w.y = pk2(x1[2], x1[3]); *q1 = w;
        }
    }
    __syncthreads();
    {
        const bf16_t* Tt = p.Ttab + (size_t)(l * 16 + g) * TT_SZ; const bf16_t* F = p.Ftab + (size_t)(l * 16 + g) * F_SZ;
        bf16x8 at[2][8], afq[2][8];
#pragma unroll
        for (int rb = 0; rb < 2; ++rb) {
            const int t = wave * 2 + rb;
#pragma unroll
            for (int kb = 0; kb < 8; ++kb) {
                const int s = 2 * kb + (kg >> 1), half = kg & 1, ti = t - s + 15;
                at[rb][kb] = *(const bf16x8*)(Tt + (size_t)(ti * 16 + nn) * 16 + half * 8);
                afq[rb][kb] = *(const bf16x8*)(F + (size_t)((kb >> 2) * 256 + t * 16 + nn) * 128 + (kb & 3) * 32 + kg * 8);
            }
        }
        const float* dsk = p.s5_d + l * 256 + g * 16 + kg * 4;
        const float d0 = dsk[0], d1 = dsk[1], d2 = dsk[2], d3 = dsk[3];
        u32x4 r0 = S5_ULOAD(0), r1 = S5_ULOAD(1), r2 = S5_ULOAD(2);
        S5_UWRITE(0, r0); __syncthreads();
#pragma unroll
        for (int cb = 0; cb < 17; ++cb) {
            if (cb + 3 < 17) r0 = S5_ULOAD(cb + 3);
            const int n = cb * 16 + nn;
            f32x4 a0 = {0.f, 0.f, 0.f, 0.f}, a1 = {0.f, 0.f, 0.f, 0.f};
#pragma unroll
            for (int kb = 0; kb < 8; ++kb) { const bf16x8 bfr = S5_UFRAG(cb, kb); a0 = S5_MFMA(at[0][kb], bfr, a0); a1 = S5_MFMA(at[1][kb], bfr, a1); }
#pragma unroll
            for (int kb = 0; kb < 8; ++kb) { const bf16x8 hf = *(const LAS bf16x8*)(HIN + n * 512 + (((kb * 4 + kg) ^ nn) * 16)); a0 = S5_MFMA(afq[0][kb], hf, a0); a1 = S5_MFMA(afq[1][kb], hf, a1); }
#pragma unroll
            for (int rb = 0; rb < 2; ++rb) {
                const int t = wave * 2 + rb; const f32x4 a = rb == 0 ? a0 : a1;
                const u32x2 uu = *(const LAS u32x2*)(UT + (cb & 1) * 8192 + nn * 512 + (((t * 2 + (kg >> 1)) ^ nn) * 16) + (kg & 1) * 8);
                const float u0 = __uint_as_float(uu.x << 16), u1 = __uint_as_float(uu.x & 0xffff0000u), u2 = __uint_as_float(uu.y << 16), u3 = __uint_as_float(uu.y & 0xffff0000u);
                u32x2 w; w.x = pk2(gelu_tanh(a[0] + d0 * u0), gelu_tanh(a[1] + d1 * u1)); w.y = pk2(gelu_tanh(a[2] + d2 * u2), gelu_tanh(a[3] + d3 * u3));
                *(u32x2*)(p.ys5 + (rowb + n * 16 + t) * 256 + g * 16 + kg * 4) = w;
            }
            if (cb + 1 < 17) S5_UWRITE(cb + 1, r1);
            __syncthreads();
            r1 = r2; r2 = r0;
        }
    }
#undef S5_ULOAD
#undef S5_UWRITE
#undef S5_UFRAG
#undef S5_SHADDR
}
}
#define XB_TMO      128
#define XB_XCNT(j)  (256  + 64 * (j))
#define XB_XSUB(j)  (1280 + 64 * (j))
#define XB_XGEN(j)  (2304 + 64 * (j))
#define XB_TOP      3328
#define XB_TOPGEN   3392
#define XCD_BAR_WORDS 3456
#define XB_SPIN_CAP (1u << 18)
constexpr int CW_BAR = 4096;
constexpr int CTL_ZERO_BYTES = 65536;
constexpr int CW_QUEUE = 8192;
__device__ __forceinline__ unsigned xb_ld(unsigned* p)              { return __hip_atomic_load(p, __ATOMIC_RELAXED, __HIP_MEMORY_SCOPE_AGENT); }
__device__ __forceinline__ unsigned xb_add(unsigned* p, unsigned v) { return __hip_atomic_fetch_add(p, v, __ATOMIC_RELAXED, __HIP_MEMORY_SCOPE_AGENT); }
__device__ __forceinline__ unsigned xb_xcc_id() { return (unsigned)__builtin_amdgcn_s_getreg((3 << 11) | 20) & 0xFu; }
#define XB_SPIN(cond, bar) do { unsigned _sp = 0; while (cond) { __builtin_amdgcn_s_sleep(1); \
    if ((++_sp & 255u) == 0u) { if (xb_ld(&(bar)[XB_TMO])) break; if (_sp > XB_SPIN_CAP) { atomicAdd(&(bar)[XB_TMO], 1u); break; } } } } while (0)
__device__ __forceinline__ void xcd_barrier_post(unsigned* bar, bool leader) { if (leader) (void)xb_add(&bar[XB_XCNT(xb_xcc_id())], 1u); }
__device__ __forceinline__ void xcd_barrier_complete(unsigned* bar, unsigned x, unsigned& nloc, unsigned& nx) {
    const unsigned G = gridDim.x * gridDim.y * gridDim.z;
    unsigned sum, cnt, mine, sp = 0u;
    for (;;) {
        sum = 0u; cnt = 0u; mine = 0u;
#pragma unroll
        for (unsigned j = 0; j < 16; ++j) { const unsigned c = xb_ld(&bar[XB_XCNT(j)]); sum += c; cnt += (c > 0u) ? 1u : 0u; mine = (j == x) ? c : mine; }
        if (sum == G) break;
        __builtin_amdgcn_s_sleep(1);
        if ((++sp & 255u) == 0u) { if (xb_ld(&bar[XB_TMO])) break; if (sp > XB_SPIN_CAP) { atomicAdd(&bar[XB_TMO], 1u); break; } }
    }
    nloc = mine > 0u ? mine : 1u; nx = cnt > 0u ? cnt : 1u;
}
__device__ __forceinline__ void xcd_barrier(unsigned* bar, volatile LAS unsigned* st, bool leader) {
    asm volatile("s_waitcnt vmcnt(0)" ::: "memory");
    __syncthreads();
    if (leader) {
        const unsigned x = xb_xcc_id();
        __builtin_amdgcn_s_waitcnt(0);
        unsigned nloc = st[0], nx = st[1];
        if (nloc == 0u) { xcd_barrier_complete(bar, x, nloc, nx); st[0] = nloc; st[1] = nx; }
        const unsigned old = xb_add(&bar[XB_XSUB(x)], 1u);
        const unsigned gen = old / nloc;
        if (old + 1u == (gen + 1u) * nloc) {
            __builtin_amdgcn_fence(__ATOMIC_RELEASE, "agent");
            asm volatile("s_waitcnt vmcnt(0)" ::: "memory");
            const unsigned og = xb_add(&bar[XB_TOP], 1u);
            const unsigned tg = og / nx;
            if (og + 1u == (tg + 1u) * nx) xb_add(&bar[XB_TOPGEN], 1u);
            else XB_SPIN(xb_ld(&bar[XB_TOPGEN]) == tg, bar);
            __builtin_amdgcn_fence(__ATOMIC_ACQUIRE, "agent");
            xb_add(&bar[XB_XGEN(x)], 1u);
            asm volatile("s_waitcnt vmcnt(0)" ::: "memory");
        } else {
            XB_SPIN(xb_ld(&bar[XB_XGEN(x)]) == gen, bar);
            __builtin_amdgcn_fence(__ATOMIC_ACQUIRE, "agent");
            asm volatile("s_waitcnt vmcnt(0)" ::: "memory");
        }
    }
    __syncthreads();
}
constexpr int LDS_MISC = 155648;
constexpr int LDS_BYTES = 155648 + 256;
__device__ __forceinline__ void ph_inproj(const Params& p, int l, LAS unsigned char* lds, int G, int bx, int tid) {
    pg8::Gemm g{p.A, p.Win_t + (size_t)l * NP * D, MT, NP, D}; pg8::StaticOrder So; So.init(MT, NP, G, bx);
    pg8::EpiInProj E{p.P, p.tabA, p.tabB, p.qn_g + l * 64, p.kn_g + l * 64};
    pg8::gemm_phase<pg8::EpiInProj, pg8::StaticOrder, true, true>(lds, g, So, E, tid);
}
__device__ __forceinline__ void ph_outproj(const Params& p, int l, LAS unsigned char* lds, int G, int bx, int tid) {
    const int M = l == NL - 1 ? MT : MT;
    pg8::Gemm g{p.A, p.Wout_t + (size_t)l * D * D, M, D, D}; pg8::StaticOrder So; So.init(M, D, G, bx);
    pg8::EpiOutProj E{p.xl, p.xc, p.mod + (size_t)l * 5 * 3 * D};
    pg8::gemm_phase<pg8::EpiOutProj, pg8::StaticOrder, true, true>(lds, g, So, E, tid);
}
__device__ __forceinline__ void ph_glu(const Params& p, int l, LAS unsigned char* lds, int G, int bx, int tid) {
    pg8::Gemm g{p.ys5, p.Wglu_t + (size_t)l * 512 * 256, MT, 512, 256}; pg8::StaticOrder So; So.init(MT, 512, G, bx);
    pg8::EpiGlu E{p.A, p.P};
    pg8::gemm_phase<pg8::EpiGlu, pg8::StaticOrder, true, true>(lds, g, So, E, tid);
}
struct Ctx { int tid, lane, wave, G, bx, gw, gv, ngw, v; };
__device__ __forceinline__ Ctx make_ctx(int wave0) {
    Ctx c; c.wave = opaque_s(wave0); c.lane = (int)__builtin_amdgcn_mbcnt_hi(~0u, __builtin_amdgcn_mbcnt_lo(~0u, (unsigned)opaque_v(0))); c.tid = c.wave * 64 + c.lane;
    c.G = opaque_s((int)gridDim.x); c.bx = opaque_s((int)blockIdx.x); c.gw = c.bx * NWAVES + c.wave; c.gv = c.wave * c.G + c.bx; c.ngw = c.G * NWAVES;
    c.v = (c.G % 8 == 0) ? (c.bx % 8) * (c.G / 8) + (c.bx / 8) : c.bx;
    return c;
}
#define GRID_SYNC() do { const Ctx cb_ = make_ctx(wave0); xcd_barrier((unsigned*)(opaque_p(ka.ws) + O_CTL) + CW_BAR, (volatile LAS unsigned*)(lds + LDS_MISC), cb_.tid == 0); } while (0)
__global__ void __launch_bounds__(NTHR, 2) mega(KArgs ka) {
    extern __shared__ __attribute__((aligned(16))) unsigned char lds_raw[];
    LAS unsigned char* lds = (LAS unsigned char*)lds_raw;
    const int wave0 = __builtin_amdgcn_readfirstlane((int)threadIdx.x >> 6);
    if (threadIdx.x < 64) ((LAS unsigned*)(lds + LDS_MISC))[threadIdx.x] = 0u;
    __syncthreads();
    xcd_barrier_post((unsigned*)(ka.ws + O_CTL) + CW_BAR, threadIdx.x == 0);
    { const Params pp = make_params(ka, true);
      { const Ctx c = make_ctx(wave0); phase_prologue(pp, ka, lds, c.gw, c.ngw, c.wave, c.lane); s5m::build_a(pp, c.gv, c.ngw, c.lane); }
      cg::this_grid().sync();
      { const Ctx c = make_ctx(wave0); s5m::build_b(pp, c.gv, c.ngw, c.lane); phase_rows(pp, -1, 0, c.gw, c.ngw, c.lane); } }
    GRID_SYNC();
#pragma nounroll
    for (int l = 0; l < NL; ++l) {
        { const Ctx c = make_ctx(wave0); const Params p = make_params(ka, false); ph_inproj(p, l, lds, c.G, c.bx, c.tid); }
        GRID_SYNC();
        { const Ctx c = make_ctx(wave0); const Params p = make_params(ka, false); const att::LayerConst lc = att::make_lc(p, l);
          for (int u = c.v; u < 256; u += c.G) att::unit_a(p, lc, u, lds, c.tid); }
        { const Ctx c = make_ctx(wave0); const Params p = make_params(ka, false); const att::LayerConst lc = att::make_lc(p, l);
          for (int u = c.v; u < 256; u += c.G) att::unit_b(p, lc, u, lds, c.tid); }
#define QUEUE_POP(word, idxvar) do { const Ctx cq_ = make_ctx(wave0); volatile LAS unsigned* qw_ = (volatile LAS unsigned*)(lds + LDS_MISC + 64); \
            if (cq_.tid == 0) qw_[0] = __hip_atomic_fetch_add((unsigned*)(opaque_p(ka.ws) + O_CTL) + (word), 1u, __ATOMIC_RELAXED, __HIP_MEMORY_SCOPE_AGENT); \
            __syncthreads(); idxvar = __builtin_amdgcn_readfirstlane((int)qw_[0]); __syncthreads(); } while (0)
#pragma nounroll
        for (;;) { int idx; QUEUE_POP(CW_QUEUE + 128 * l, idx); if (idx >= NB * 16) break;
            const Ctx c = make_ctx(wave0); const Params p = make_params(ka, false); s5m::unit(p, l, idx >> 4, idx & 15, lds, c.tid); }
#pragma nounroll
        for (;;) { int idx; QUEUE_POP(CW_QUEUE + 128 * l + 64, idx); if (idx >= 256 + (l < NL - 1 ? 48 : 0)) break;
            const Ctx c = make_ctx(wave0); const Params p = make_params(ka, false); const att::LayerConst lc = att::make_lc(p, l);
            if (idx < 256) att::unit_c(p, lc, idx, lds, c.tid); else att::unit_ctx(p, lc, idx - 256, lds, c.tid); }
        GRID_SYNC();
        { const Ctx c = make_ctx(wave0); const Params p = make_params(ka, false); ph_glu(p, l, lds, c.G, c.bx, c.tid); }
        GRID_SYNC();
        { const Ctx c = make_ctx(wave0); const Params p = make_params(ka, false); ph_outproj(p, l, lds, c.G, c.bx, c.tid); }
        GRID_SYNC();
        { const Ctx c = make_ctx(wave0); const Params p = make_params(ka, false); phase_rows(p, l, l + 1, c.gw, c.ngw, c.lane); }
        if (l + 1 < NL) GRID_SYNC();
    }
}

extern "C" void kernel_launch(void* const* d_in, const int* in_sizes, int n_in, void* d_out, int out_size, void* d_ws, size_t ws_size, hipStream_t stream) {
    static int grid = 0;
    if (grid == 0) {
        int dev = 0, cus = 0, per_cu = 0;
        (void)hipGetDevice(&dev); (void)hipDeviceGetAttribute(&cus, hipDeviceAttributeMultiprocessorCount, dev);
        (void)hipFuncSetAttribute((const void*)mega, hipFuncAttributeMaxDynamicSharedMemorySize, LDS_BYTES);
        if (hipOccupancyMaxActiveBlocksPerMultiprocessor(&per_cu, (const void*)mega, NTHR, LDS_BYTES) != hipSuccess || per_cu < 1) { per_cu = 1; (void)hipGetLastError(); }
        if (per_cu > 1) per_cu = 1;
        grid = (cus > 0 ? cus : 256) * per_cu;
    }
    KArgs ka{};
    for (int i = 0; i < 27; ++i) ka.in[i] = (const float*)d_in[i];
    ka.out = (float*)d_out; ka.ws = (unsigned char*)d_ws;
    if (O_END > ws_size) { fprintf(stderr, "kernel_launch: workspace too small: need %zu have %zu\n", (size_t)O_END, ws_size); return; }
    (void)hipMemsetAsync((unsigned char*)d_ws + O_CTL, 0, CTL_ZERO_BYTES, stream);
    void* args[] = {&ka};
    hipError_t e = hipLaunchCooperativeKernel((const void*)mega, dim3(grid), dim3(NTHR), args, LDS_BYTES, stream);
    if (e != hipSuccess) fprintf(stderr, "cooperative launch failed: %s (grid %d)\n", hipGetErrorString(e), grid);
}
```
